# Optimizing an MI355X kernel written in HIP

```python
import jax, jax.numpy as jnp
from jax import lax
import numpy as np

D_MODEL = 1024
BATCH = 8
SEQ = 2048
DEPTH = 2

GRID_W = 64
CTX_LEN = 256

N_HEADS = 8
QK_NOPE = 64
QK_ROPE = 32
V_DIM = 64
Q_RANK = 384
KV_RANK = 256
QK_DIM = QK_NOPE + QK_ROPE
ROPE_BASE = 10000.0
Q_BLOCK = 128
CONV_WIDTH = 512
CONV_K = 3
FOURIER_GROUPS = 4
FOURIER_GROUP_CH = 128
FOURIER_WIDTH = FOURIER_GROUPS * FOURIER_GROUP_CH
N_EXPERTS = 32
TOP_K = 4
F_EXPERT = 256
F_SHARED = 256
ROUTED_SCALE = 2.5
N_BRANCHES = 3
EPS = 1e-6

KV_END = KV_RANK + QK_ROPE
Q_END = KV_END + Q_RANK
CB_END = Q_END + CONV_WIDTH
CC_END = CB_END + CONV_WIDTH
CX_END = CC_END + CONV_WIDTH
FOUR_END = CX_END + FOURIER_WIDTH
PROJ_WIDTH = FOUR_END + N_BRANCHES * D_MODEL

kernel_name = "hybrid_mla_conv_fourier_moe_dit"


def rms_norm(x, g):
    xf = x.astype(jnp.float32)
    y = xf * lax.rsqrt(jnp.mean(xf * xf, axis=-1, keepdims=True) + EPS)
    return (y * g.astype(jnp.float32)).astype(x.dtype)


def modulate(h, shift, scale):
    return h * (1 + scale) + shift


def rope_tables(n):
    rows = n // GRID_W
    r, col = jnp.meshgrid(jnp.arange(rows), jnp.arange(GRID_W), indexing="ij")
    r = r.reshape(-1).astype(jnp.float32)
    col = col.reshape(-1).astype(jnp.float32)
    pairs = QK_ROPE // 4
    inv = ROPE_BASE ** (-jnp.arange(pairs, dtype=jnp.float32) / pairs)
    ang = jnp.concatenate([r[:, None] * inv, col[:, None] * inv], axis=-1)
    return jnp.cos(ang), jnp.sin(ang)


def apply_rope(x, cos, sin):
    half = QK_ROPE // 2
    xf = x.astype(jnp.float32)
    x1, x2 = xf[..., :half], xf[..., half:]
    return jnp.concatenate([x1 * cos - x2 * sin, x2 * cos + x1 * sin], axis=-1).astype(x.dtype)


def mla_kv(p_kv, g_kv, w_ukv, rope):
    B, N, _ = p_kv.shape
    ckv = rms_norm(p_kv[..., :KV_RANK], g_kv)
    k_pe = p_kv[..., KV_RANK:]
    if rope is not None:
        k_pe = apply_rope(k_pe, rope[0], rope[1])
    kv = (ckv @ w_ukv).reshape(B, N, N_HEADS, QK_NOPE + V_DIM)
    k_nope, v = kv[..., :QK_NOPE], kv[..., QK_NOPE:]
    k_pe = jnp.broadcast_to(k_pe[:, :, None, :], (B, N, N_HEADS, QK_ROPE))
    return jnp.concatenate([k_nope, k_pe], axis=-1), v


def mla_q(p_q, g_q, w_uq, rope):
    B, N, _ = p_q.shape
    cq = rms_norm(p_q, g_q)
    q = (cq @ w_uq).reshape(B, N, N_HEADS, QK_DIM)
    if rope is not None:
        q_pe = apply_rope(q[..., QK_NOPE:], rope[0][:, None, :], rope[1][:, None, :])
        q = jnp.concatenate([q[..., :QK_NOPE], q_pe], axis=-1)
    return q


def attention(q, k, v):
    B, N, H, _ = q.shape
    nb = N // Q_BLOCK
    qb = q.reshape(B, nb, Q_BLOCK, H, QK_DIM).swapaxes(0, 1)
    scale = QK_DIM ** -0.5

    def one_block(qblk):
        s = jnp.einsum("bqhd,bkhd->bhqk", qblk, k).astype(jnp.float32) * scale
        p = jax.nn.softmax(s, axis=-1)
        return jnp.einsum("bhqk,bkhv->bqhv", p.astype(v.dtype), v)

    o = lax.map(one_block, qb)
    return o.swapaxes(0, 1).reshape(B, N, H * V_DIM)


def short_conv(b_gate, c_gate, u, w_conv):
    N = u.shape[1]
    pad = CONV_K // 2
    inner = jnp.pad(c_gate * u, ((0, 0), (pad, pad), (0, 0)))
    y = sum(inner[:, j:j + N] * w_conv[j] for j in range(CONV_K))
    return b_gate * y


def fourier_mix(u):
    B, N, _ = u.shape
    ug = u.astype(jnp.float32).reshape(B, N, FOURIER_GROUPS, FOURIER_GROUP_CH)
    f = jnp.fft.fft2(ug, axes=(1, 3), norm="ortho").real
    return f.reshape(B, N, FOURIER_WIDTH).astype(u.dtype)


def mix_stream(proj, k_read, v_read, rope, prm):
    q = mla_q(proj[..., KV_END:Q_END], prm["g_q"], prm["w_uq"], rope)
    y_attn = attention(q, k_read, v_read) @ prm["w_mla_out"]
    y_conv = short_conv(proj[..., Q_END:CB_END], proj[..., CB_END:CC_END],
                        proj[..., CC_END:CX_END], prm["conv_w"]) @ prm["w_conv_out"]
    y_four = fourier_mix(proj[..., CX_END:FOUR_END]) @ prm["w_four_out"]
    gates = jax.nn.sigmoid(proj[..., FOUR_END:] + prm["b_gate"])
    g_a, g_c, g_f = jnp.split(gates, N_BRANCHES, axis=-1)
    return (g_a * y_attn + g_c * y_conv + g_f * y_four) @ prm["w_out"]


def moe(h, prm):
    B, N, D = h.shape
    t = h.reshape(B * N, D)
    scores = jax.nn.sigmoid((t @ prm["w_router"]).astype(jnp.float32))
    _, idx = lax.top_k(scores + prm["b_router"].astype(jnp.float32), TOP_K)
    sel = jnp.take_along_axis(scores, idx, axis=-1)
    w = sel / jnp.sum(sel, axis=-1, keepdims=True) * ROUTED_SCALE
    comb = jnp.sum(jax.nn.one_hot(idx, N_EXPERTS, dtype=jnp.float32) * w[..., None], axis=1)
    gate = jnp.einsum("td,edf->tef", t, prm["w_gate_e"])
    up = jnp.einsum("td,edf->tef", t, prm["w_up_e"])
    act = jax.nn.silu(gate) * up * comb[..., None].astype(t.dtype)
    routed = jnp.einsum("tef,efd->td", act, prm["w_down_e"])
    shared = (jax.nn.silu(t @ prm["w_gate_s"]) * (t @ prm["w_up_s"])) @ prm["w_down_s"]
    return (routed + shared).reshape(B, N, D)


def layer(x, ctx, ada_x, ada_c, prm, rope, ctx_out):
    sh1x, sc1x, g1x, sh2x, sc2x, g2x = jnp.split(ada_x[:, None, :], 6, axis=-1)
    sh1c, sc1c, g1c, sh2c, sc2c, g2c = jnp.split(ada_c, 6, axis=-1)
    hx = modulate(rms_norm(x, prm["g_pre_mix"]), sh1x, sc1x)
    hc = modulate(rms_norm(ctx, prm["g_pre_mix"]), sh1c, sc1c)
    px = hx @ prm["w_in"]
    if ctx_out:
        pc = hc @ prm["w_in"]
        pc_kv = pc[..., :KV_END]
    else:
        pc_kv = hc @ prm["w_in"][:, :KV_END]
    kc, vc = mla_kv(pc_kv, prm["g_kv"], prm["w_ukv"], None)
    kx, vx = mla_kv(px[..., :KV_END], prm["g_kv"], prm["w_ukv"], rope)
    k_all = jnp.concatenate([kc, kx], axis=1)
    v_all = jnp.concatenate([vc, vx], axis=1)
    yx = mix_stream(px, k_all, v_all, rope, prm)
    x = x + g1x * rms_norm(yx, prm["g_post_mix"])
    hx2 = modulate(rms_norm(x, prm["g_pre_ffn"]), sh2x, sc2x)
    x = x + g2x * rms_norm(moe(hx2, prm), prm["g_post_ffn"])
    if ctx_out:
        yc = mix_stream(pc, kc, vc, None, prm)
        ctx = ctx + g1c * rms_norm(yc, prm["g_post_mix"])
        hc2 = modulate(rms_norm(ctx, prm["g_pre_ffn"]), sh2c, sc2c)
        ctx = ctx + g2c * rms_norm(moe(hc2, prm), prm["g_post_ffn"])
    return x, ctx


def setup_inputs(seed: int = 0) -> dict:
    key = jax.random.key(seed)
    ks = jax.random.split(key, 29)
    f32 = jnp.float32

    def nrm(k, shape, scale):
        return jax.random.normal(k, shape, f32) * scale

    D, L = D_MODEL, DEPTH
    return {
        "x": nrm(ks[0], (BATCH, SEQ, D), 1.0),
        "c": nrm(ks[1], (BATCH, D), 1.0),
        "ctx": nrm(ks[2], (BATCH, CTX_LEN, D), 1.0),
        "c_ctx": nrm(ks[3], (D,), 1.0),
        "w_ada": nrm(ks[4], (L, D, 6 * D), 0.5 * D ** -0.5),
        "b_ada": nrm(ks[5], (L, 6 * D), 0.02),
        "g_pre_mix": 1.0 + nrm(ks[6], (L, D), 0.02),
        "g_post_mix": 1.0 + nrm(ks[7], (L, D), 0.02),
        "g_pre_ffn": 1.0 + nrm(ks[8], (L, D), 0.02),
        "g_post_ffn": 1.0 + nrm(ks[9], (L, D), 0.02),
        "w_in": nrm(ks[10], (L, D, PROJ_WIDTH), D ** -0.5),
        "b_gate": nrm(ks[11], (L, N_BRANCHES * D), 0.02),
        "g_q": 1.0 + nrm(ks[12], (L, Q_RANK), 0.02),
        "w_uq": nrm(ks[13], (L, Q_RANK, N_HEADS * QK_DIM), Q_RANK ** -0.5),
        "g_kv": 1.0 + nrm(ks[14], (L, KV_RANK), 0.02),
        "w_ukv": nrm(ks[15], (L, KV_RANK, N_HEADS * (QK_NOPE + V_DIM)), KV_RANK ** -0.5),
        "w_mla_out": nrm(ks[16], (L, N_HEADS * V_DIM, D), (N_HEADS * V_DIM) ** -0.5),
        "conv_w": nrm(ks[17], (L, CONV_K, CONV_WIDTH), CONV_K ** -0.5),
        "w_conv_out": nrm(ks[18], (L, CONV_WIDTH, D), CONV_WIDTH ** -0.5),
        "w_four_out": nrm(ks[19], (L, FOURIER_WIDTH, D), FOURIER_WIDTH ** -0.5),
        "w_out": nrm(ks[20], (L, D, D), D ** -0.5),
        "w_router": nrm(ks[21], (L, D, N_EXPERTS), D ** -0.5),
        "b_router": nrm(ks[22], (L, N_EXPERTS), 0.01),
        "w_gate_e": nrm(ks[23], (L, N_EXPERTS, D, F_EXPERT), D ** -0.5),
        "w_up_e": nrm(ks[24], (L, N_EXPERTS, D, F_EXPERT), D ** -0.5),
        "w_down_e": nrm(ks[25], (L, N_EXPERTS, F_EXPERT, D), F_EXPERT ** -0.5),
        "w_gate_s": nrm(ks[26], (L, D, F_SHARED), D ** -0.5),
        "w_up_s": nrm(ks[27], (L, D, F_SHARED), D ** -0.5),
        "w_down_s": nrm(ks[28], (L, F_SHARED, D), F_SHARED ** -0.5),
    }


def reference(x, c, ctx, c_ctx, w_ada, b_ada, g_pre_mix, g_post_mix, g_pre_ffn, g_post_ffn,
              w_in, b_gate, g_q, w_uq, g_kv, w_ukv, w_mla_out, conv_w, w_conv_out, w_four_out,
              w_out, w_router, b_router, w_gate_e, w_up_e, w_down_e, w_gate_s, w_up_s, w_down_s):
    rope = rope_tables(x.shape[1])
    for l in range(DEPTH):
        prm = {
            "g_pre_mix": g_pre_mix[l], "g_post_mix": g_post_mix[l],
            "g_pre_ffn": g_pre_ffn[l], "g_post_ffn": g_post_ffn[l],
            "w_in": w_in[l], "b_gate": b_gate[l],
            "g_q": g_q[l], "w_uq": w_uq[l], "g_kv": g_kv[l], "w_ukv": w_ukv[l],
            "w_mla_out": w_mla_out[l], "conv_w": conv_w[l], "w_conv_out": w_conv_out[l],
            "w_four_out": w_four_out[l], "w_out": w_out[l],
            "w_router": w_router[l], "b_router": b_router[l],
            "w_gate_e": w_gate_e[l], "w_up_e": w_up_e[l], "w_down_e": w_down_e[l],
            "w_gate_s": w_gate_s[l], "w_up_s": w_up_s[l], "w_down_s": w_down_s[l],
        }
        ada_x = jax.nn.silu(c) @ w_ada[l] + b_ada[l]
        ada_c = jax.nn.silu(c_ctx) @ w_ada[l] + b_ada[l]
        x, ctx = layer(x, ctx, ada_x, ada_c, prm, rope, l < DEPTH - 1)
    return x
```

```cpp
#include <hip/hip_runtime.h>
#include <stdint.h>
#include <stdio.h>

typedef unsigned short bf16_t;
typedef unsigned char u8;

constexpr int DM = 1024, NB = 8, SEQ = 2048, CTX = 256, NH = 8;
constexpr int RX = NB * SEQ, RC = NB * CTX, RT = RX + RC;
constexpr int QK_NOPE = 64, QK_ROPE = 32, V_DIM = 64, Q_RANK = 384, KV_RANK = 256, QK_DIM = 96;
constexpr int CONVW = 512, FW = 512, NE = 32, TOPK = 4, FE = 256;
constexpr int KV_END = 288, Q_END = 672, CB_END = 1184, CC_END = 1696, CX_END = 2208, FOUR_END = 2720, PROJ_W = 5792;
constexpr float EPS = 1e-6f;
constexpr float QSCALE = 0.10206207261596575f * 1.4426950408889634f;
constexpr int SLOTS = 73728 + 32 * 256;

__device__ __forceinline__ bf16_t f2bf(float f) { unsigned u = __float_as_uint(f); u += 0x7FFFu + ((u >> 16) & 1u); return (bf16_t)(u >> 16); }
__device__ __forceinline__ float bf2f(bf16_t b) { return __uint_as_float(((unsigned)b) << 16); }
__device__ __forceinline__ float sigmoidf_(float x) { return 1.f / (1.f + __expf(-x)); }
template <int K> __device__ __forceinline__ float lane_xor(float v) { return __int_as_float(__builtin_amdgcn_ds_swizzle(__float_as_int(v), (K << 10) | 0x1f)); }
__device__ __forceinline__ float lane_xor32_sum(float v) { auto rr = __builtin_amdgcn_permlane32_swap(__float_as_uint(v), __float_as_uint(v), false, false); return __uint_as_float(rr[0]) + __uint_as_float(rr[1]); }
__device__ __forceinline__ float lane_xor32_max(float v) { auto rr = __builtin_amdgcn_permlane32_swap(__float_as_uint(v), __float_as_uint(v), false, false); return fmaxf(__uint_as_float(rr[0]), __uint_as_float(rr[1])); }
__device__ __forceinline__ float wave_sum(float v) { v += lane_xor<1>(v); v += lane_xor<2>(v); v += lane_xor<4>(v); v += lane_xor<8>(v); v += lane_xor<16>(v); return lane_xor32_sum(v); }
__device__ __forceinline__ float wave_max(float v) { v = fmaxf(v, lane_xor<1>(v)); v = fmaxf(v, lane_xor<2>(v)); v = fmaxf(v, lane_xor<4>(v)); v = fmaxf(v, lane_xor<8>(v)); v = fmaxf(v, lane_xor<16>(v)); return lane_xor32_max(v); }
__device__ __forceinline__ int row_arow(int row) { return row < RX ? row / SEQ : NB; }
__device__ __forceinline__ int pe_pos(int half, int i) { return 8 * (i >> 2) + 4 * half + (i & 3); }

constexpr size_t al256(size_t x) { return (x + 255) / 256 * 256; }
constexpr size_t OFF_ADA = 0;
constexpr size_t OFF_ROPE = OFF_ADA + al256(2 * 9 * 6144 * 4);
constexpr size_t OFF_CTXRES = OFF_ROPE + al256(2048 * 16 * 2 * 4);
constexpr size_t OFF_SS = OFF_CTXRES + al256((size_t)RC * DM * 4);
constexpr size_t OFF_CNT = OFF_SS + al256((size_t)3 * RT * 4);
constexpr size_t OFF_BASE = OFF_CNT + 256;
constexpr size_t OFF_TOKLIST = OFF_BASE + 256;
constexpr size_t OFF_WLIST = OFF_TOKLIST + al256((size_t)NE * RT * 4);
constexpr size_t OFF_TOKINFO = OFF_WLIST + al256((size_t)NE * RT * 4);
constexpr size_t OFF_PERSIST_END = OFF_TOKINFO + al256((size_t)RT * 4 * 8);
constexpr size_t WMIX_W1 = 0;
constexpr size_t WMIX_WZ = WMIX_W1 + (size_t)2304 * 1024 * 2;
constexpr size_t WMIX_WUKV = WMIX_WZ + (size_t)1024 * 1024 * 2;
constexpr size_t WMIX_WUQ = WMIX_WUKV + (size_t)1024 * 256 * 2;
constexpr size_t WMIX_WA = WMIX_WUQ + (size_t)768 * 384 * 2;
constexpr size_t WMIX_WO = WMIX_WA + (size_t)3 * 1024 * 512 * 2;
constexpr size_t WMIX_BYTES = WMIX_WO + (size_t)1024 * 1024 * 2;
constexpr size_t OFF_WMIX = OFF_PERSIST_END;
constexpr size_t OFF_MA = OFF_WMIX + 2 * WMIX_BYTES;
constexpr size_t OFF_MB = OFF_MA + 256 * 128 * 2;
constexpr size_t OFF_TW = OFF_MB + 256 * 128 * 2;
constexpr size_t OFF_W1G8 = OFF_TW + 32 * 64 * 2 * 4;
constexpr size_t OFF_H8 = OFF_W1G8 + (size_t)2 * 3072 * 1024;
constexpr size_t OFF_TC = OFF_H8 + (size_t)RT * DM;
constexpr size_t OFF_SSP = OFF_TC + (size_t)256 * 512 * 2;
constexpr size_t OFF_SSPQ = OFF_SSP + (size_t)RT * 4 * 4;
constexpr size_t OFF_SSPY = OFF_SSPQ + (size_t)RT * 8 * 4;
constexpr size_t OFF_IDL = OFF_SSPY + (size_t)RT * 16 * 4;
constexpr size_t OFF_WR = OFF_IDL + (size_t)RT * 4;
constexpr size_t OFF_CTL = OFF_WR + (size_t)2 * 2 * NE * DM * 2;
constexpr size_t CTL_BYTES = 16384;
constexpr size_t OFF_CNT2 = OFF_CTL + 14336;
constexpr size_t OFF_FAST_END = OFF_CTL + CTL_BYTES;
constexpr size_t OFF_H = al256(OFF_FAST_END);
constexpr size_t OFF_CKV = OFF_H + al256((size_t)RT * DM * 2);
constexpr size_t OFF_CQ = OFF_CKV + al256((size_t)RT * 256 * 2);
constexpr size_t OFF_CB = OFF_CQ + al256((size_t)RT * 384 * 2);
constexpr size_t OFF_INNER = OFF_CB + al256((size_t)RT * 512 * 2);
constexpr size_t OFF_GATES = OFF_INNER + al256((size_t)RT * 512 * 2);
constexpr size_t OFF_ZT = OFF_GATES + al256((size_t)RT * 3072);
constexpr size_t OFF_ZTC = OFF_ZT + (size_t)NB * 512 * 4096 * 2;
constexpr size_t OFF_K = OFF_ZT + al256((size_t)RT * DM * 2);
constexpr size_t OFF_V = OFF_K + al256((size_t)RT * 768 * 2);
constexpr size_t OFF_Q = OFF_V + al256((size_t)RT * 512 * 2);
constexpr size_t OFF_ATT = OFF_Q + al256((size_t)RT * 768 * 2);
constexpr size_t OFF_CONV = OFF_ATT + al256((size_t)RT * 512 * 2);
constexpr size_t OFF_FOUR = OFF_CONV + al256((size_t)RT * 512 * 2);
constexpr size_t OFF_END_MIX = OFF_FOUR + al256((size_t)RT * 512 * 2);
constexpr size_t OFF_ZA = OFF_ZT;
constexpr size_t OFF_ZB = OFF_H;
constexpr size_t OFF_X1B = OFF_WMIX;
static_assert(OFF_X1B + (size_t)RX * DM * 2 <= OFF_TC, "X1B must stay inside the dead weight area");
constexpr size_t OFF_YX = OFF_ZT;
constexpr size_t OFF_MERGED = OFF_K;
constexpr size_t OFF_U32 = OFF_ATT;
constexpr size_t OFF_ACT = OFF_CKV;
constexpr size_t OFF_ACTS = OFF_ACT + al256((size_t)SLOTS * 256 * 2);
constexpr size_t OFF_Y = OFF_ACTS + al256((size_t)RT * 256 * 2);
constexpr size_t OFF_YS = OFF_Y + (size_t)SLOTS * DM;
constexpr size_t OFF_END_MOE = OFF_Y + al256((size_t)SLOTS * DM * 2);
static_assert(OFF_END_MOE <= OFF_ATT, "MoE buffers must stay inside regions A+B");
static_assert(OFF_MERGED + (size_t)RT * DM * 2 <= OFF_Q, "MERGED must fit over K,V");
static_assert(OFF_END_MIX < 406000000ull, "workspace too large");

struct Ptrs {
    const float *x, *c, *ctx, *c_ctx, *w_ada, *b_ada, *g_pre_mix, *g_post_mix, *g_pre_ffn, *g_post_ffn, *w_in, *b_gate, *g_q, *w_uq, *g_kv, *w_ukv,
        *w_mla_out, *conv_w, *w_conv_out, *w_four_out, *w_out, *w_router, *b_router, *w_gate_e, *w_up_e, *w_down_e, *w_gate_s, *w_up_s, *w_down_s;
    float* out; char* ws;
};
#define WSP(T, off) ((T*)(P.ws + (off)))

#define LAS __attribute__((address_space(3)))
__device__ __forceinline__ int bid_() { int b = blockIdx.x; asm volatile("" : "+s"(b)); return b; }
typedef short bf16x8 __attribute__((ext_vector_type(8)));
typedef float f32x4 __attribute__((ext_vector_type(4)));
typedef unsigned u32x4 __attribute__((ext_vector_type(4)));
typedef unsigned u32x2 __attribute__((ext_vector_type(2)));
__device__ __forceinline__ unsigned cvt_pk_bf16(float lo, float hi) { unsigned r; asm volatile("v_cvt_pk_bf16_f32 %0, %1, %2" : "=v"(r) : "v"(lo), "v"(hi)); return r; }
__device__ __forceinline__ float bflo(unsigned w) { return __uint_as_float(w << 16); }
__device__ __forceinline__ float bfhi(unsigned w) { return __uint_as_float(w & 0xffff0000u); }

__device__ __forceinline__ int lane_id() { return (int)__builtin_amdgcn_mbcnt_hi(~0u, __builtin_amdgcn_mbcnt_lo(~0u, 0u)); }
__device__ __forceinline__ int uni(int v) { return __builtin_amdgcn_readfirstlane(v); }
__device__ __forceinline__ int hidden_lane() { int lane; asm volatile("v_mbcnt_lo_u32_b32 %0, -1, 0\n\tv_mbcnt_hi_u32_b32 %0, -1, %0" : "=v"(lane)); return lane; }
__device__ __forceinline__ int hidden_tid(int wid) { return wid * 64 + hidden_lane(); }
template <class T> __device__ __forceinline__ T* uni_ptr(T* p) { const unsigned long long v = (unsigned long long)p; const unsigned lo = __builtin_amdgcn_readfirstlane((unsigned)v), hi = __builtin_amdgcn_readfirstlane((unsigned)(v >> 32));
    return (T*)(((unsigned long long)hi << 32) | lo); }
namespace fg {
constexpr int BM = 256, BK = 64, HALF = 128, HTB = HALF * BK * 2, STAGE_BYTES = 8 * HTB, NXCD = 8, WGM = 8;
__host__ __device__ __forceinline__ int lds_byte(int r, int c) { const int st = (r >> 4) * 2 + (c >> 5), rr = r & 15, cc = c & 31, ob = rr * 64 + cc * 2; return st * 1024 + (ob ^ (((ob >> 9) & 1) << 5)); }
__host__ __device__ __forceinline__ void stage_rc(int b, int& R, int& C) { const int st = b / 1024, sb = b % 1024, swz = sb ^ (((sb >> 9) & 1) << 5); R = (st >> 1) * 16 + swz / 64; C = (st & 1) * 32 + (swz % 64) / 2; }
__host__ __device__ __forceinline__ int perm32(int rho) { const int n = rho >> 4, i = rho & 15; return 8 * (i >> 2) + 4 * n + (i & 3); }

struct GU { const char* a; const char* b; const int* gl; int kind, r0, c0, aux, gn; const char* a1; const char* a2; };

__device__ __forceinline__ void tile_order(int L, int nM, int nN, int& pm, int& pn) {
    const int nwg = nM * nN; int wgid = L; { const int q = nwg / NXCD, r = nwg % NXCD, xcd = wgid % NXCD, off = wgid / NXCD; wgid = (xcd < r ? xcd * (q + 1) : r * (q + 1) + (xcd - r) * q) + off; }
    const int nig = WGM * nN, gid = wgid / nig, fm = gid * WGM, gsz = (nM - fm) < WGM ? (nM - fm) : WGM;
    pm = fm + ((wgid % nig) % gsz); pn = (wgid % nig) / gsz;
}

typedef int v8i32 __attribute__((ext_vector_type(8)));
typedef int v4i32 __attribute__((ext_vector_type(4)));
template <class E, class = void> struct NstOf { static constexpr int v = 0; };
template <class E> struct NstOf<E, decltype((void)E::NST)> { static constexpr int v = E::NST; };
template <class Sched, class Epi, int AM, int BM = 0, bool F8 = false, bool SEG = false>
__device__ __forceinline__ void gemm_phase(LAS unsigned char* lds, const int K, const Sched& S, const Epi& E, const int wid) {
    const int lane = hidden_lane();
    const int tid = wid * 64 + lane, wr = wid >> 2, wc = wid & 3, fr = lane & 15, fq = lane >> 4;
    constexpr bool GATHER = (AM == 1); constexpr int EB = F8 ? 1 : 2;
    constexpr int UNR = F8 ? 1 : 4;
    const int nt = K * EB / (BK * 2); const int KR = SEG ? K / 3 : K;
    unsigned voffA[2], voffB[2];
#pragma unroll
    for (int i = 0; i < 2; ++i) { int R, C; stage_rc(tid * 16 + i * 8192, R, C); const int Rb = (R & ~31) + perm32(R & 31);
        voffA[i] = AM == 2 ? (unsigned)(((R & 31) * 512 + (R >> 5)) * 256 + C * 2) : (unsigned)(R * KR * EB + C * 2);
        voffB[i] = BM == 1 ? (unsigned)(((Rb >> 6) + 32 * (Rb & 63)) * K * EB + C * 2) : (BM == 2 ? (unsigned)(((Rb & 31) * 512 + (Rb >> 5)) * 256 + C * 2) : (unsigned)(Rb * KR * EB + C * 2)); }
    const size_t kstep = (size_t)(BK * 2);
    const size_t hstepA = AM == 2 ? (size_t)1024 : (size_t)HALF * KR * EB;
    const size_t hstep = BM == 1 ? (size_t)2 * K * EB : (BM == 2 ? (size_t)1024 : (size_t)HALF * KR * EB);
    const unsigned ldsw = (unsigned)wid * 1024u;
    const int aoff = lds_byte(wr * 64 + fr, fq * 8), boff = lds_byte(wc * 32 + fr, fq * 8);
#define FG_SA(b, h) (((b) * 2 + (h)) * HTB)
#define FG_SB(b, h) ((4 + (b) * 2 + (h)) * HTB)
#define FG_STAGE(bufoff, gbase, voff) do { _Pragma("unroll") for (int _i = 0; _i < 2; ++_i) { unsigned _keep; \
        asm volatile("s_mov_b32 %0, m0\n\ts_mov_b32 m0, %3\n\ts_nop 0\n\tglobal_load_lds_dwordx4 %1, %2\n\ts_mov_b32 m0, %0" : "=&s"(_keep) : "v"((voff)[_i]), "s"((const char*)(gbase)), "s"((unsigned)(size_t)(lds + (bufoff) + ldsw + _i * 8192)) : "memory"); } } while (0)
#define FG_STAGE_A(bufoff, P, H, NX) do { if constexpr (GATHER) { const u32x2 _g = *(const LAS u32x2*)(gofs + ((NX) ? nsel : cset) * 8192 + (H) * 8); unsigned _o[2] = {_g[0], _g[1]}; FG_STAGE(bufoff, P, _o); } \
        else { FG_STAGE(bufoff, (P) + (H) * hstepA, voffA); } } while (0)
#define FG_LD8(p) __builtin_shufflevector(*(const LAS v4i32*)(p), *(const LAS v4i32*)((p) + 1024), 0, 1, 2, 3, 4, 5, 6, 7)
#define FG_LDA(dst, b, h) do { _Pragma("unroll") for (int m = 0; m < 4; ++m) dst[m] = FG_LD8(lds + FG_SA(b, h) + aoff + m * 2048); } while (0)
#define FG_LDB(dst, b, h) do { _Pragma("unroll") for (int n = 0; n < 2; ++n) dst[n] = FG_LD8(lds + FG_SB(b, h) + boff + n * 2048); } while (0)
#define FG_MMA(ai, bj, At, Bt) do { __builtin_amdgcn_s_setprio(1); _Pragma("unroll") for (int m = 0; m < 4; ++m) _Pragma("unroll") for (int n = 0; n < 2; ++n) { \
        if constexpr (F8) acc[ai][bj][m][n] = __builtin_amdgcn_mfma_scale_f32_16x16x128_f8f6f4(Bt[n], At[m], acc[ai][bj][m][n], 0, 0, 0, 0x7f7f7f7f, 0, 0x7f7f7f7f); \
        else { acc[ai][bj][m][n] = __builtin_amdgcn_mfma_f32_16x16x32_bf16((bf16x8)__builtin_shufflevector(Bt[n], Bt[n], 0, 1, 2, 3), (bf16x8)__builtin_shufflevector(At[m], At[m], 0, 1, 2, 3), acc[ai][bj][m][n], 0, 0, 0); \
               acc[ai][bj][m][n] = __builtin_amdgcn_mfma_f32_16x16x32_bf16((bf16x8)__builtin_shufflevector(Bt[n], Bt[n], 4, 5, 6, 7), (bf16x8)__builtin_shufflevector(At[m], At[m], 4, 5, 6, 7), acc[ai][bj][m][n], 0, 0, 0); } } __builtin_amdgcn_s_setprio(0); } while (0)
#define FG_WAIT_V(n) asm volatile("s_waitcnt vmcnt(" #n ")" ::: "memory")
#define FG_WAIT_L(n) asm volatile("s_waitcnt lgkmcnt(" #n ")" ::: "memory")
#define FG_WAIT_VR(rl) do { if (rl) asm volatile("s_waitcnt vmcnt(%0)" :: "n"(8 + NstOf<Epi>::v) : "memory"); else FG_WAIT_V(8); } while (0)
#define FG_BAR __builtin_amdgcn_s_barrier()
#define FG_SCHED __builtin_amdgcn_sched_barrier(0)
#define FG_GOFF(SET, U) do { if constexpr (GATHER) { const int _t = wid * 64 + hidden_lane(); u32x4 _q; _Pragma("unroll") for (int _h = 0; _h < 2; ++_h) _Pragma("unroll") for (int _i = 0; _i < 2; ++_i) { \
        int _R, _C; stage_rc(_t * 16 + _i * 8192, _R, _C); int _r = _h * HALF + _R; _r = _r < (U).gn ? _r : (U).gn - 1; _q[_h * 2 + _i] = (unsigned)(U).gl[_r] * (unsigned)(K * EB) + (unsigned)(_C * 2); } \
        *(LAS u32x4*)(gofs + (SET) * 8192) = _q; } } while (0)
#define FG_UNIFY(U) do { (U).a = uni_ptr((U).a); (U).b = uni_ptr((U).b); (U).gl = uni_ptr((U).gl); if constexpr (SEG) { (U).a1 = uni_ptr((U).a1); (U).a2 = uni_ptr((U).a2); asm volatile("" : "+s"((U).a1), "+s"((U).a2)); } (U).kind = uni((U).kind); (U).r0 = uni((U).r0); (U).c0 = uni((U).c0); (U).aux = uni((U).aux); (U).gn = uni((U).gn); \
        asm volatile("" : "+s"((U).a), "+s"((U).b), "+s"((U).gl), "+s"((U).kind), "+s"((U).r0), "+s"((U).c0), "+s"((U).aux), "+s"((U).gn)); } while (0)
    GU cur{}; int ui = 0;
    if (!S.next(0, cur)) return;
    FG_UNIFY(cur);
    LAS unsigned char* const gofs = lds + STAGE_BYTES + 1024 + tid * 16;
    int cset = 0, nsel = 0;
    FG_GOFF(cset, cur);
    f32x4 acc[2][2][4][2];
#pragma unroll
    for (int a = 0; a < 2; ++a)
#pragma unroll
        for (int b = 0; b < 2; ++b)
#pragma unroll
            for (int m = 0; m < 4; ++m)
#pragma unroll
                for (int n = 0; n < 2; ++n) acc[a][b][m][n] = (f32x4){0.f, 0.f, 0.f, 0.f};
    v8i32 At[4], B0[2], B1[2];
    const char* cA = cur.a; const char* cB = cur.b;
    FG_STAGE(FG_SB(0, 0), cB, voffB); FG_STAGE(FG_SB(0, 1), cB + hstep, voffB); FG_STAGE_A(FG_SA(0, 0), cA, 0, false); FG_STAGE_A(FG_SA(0, 1), cA, 1, false);
    if (wr == 1) FG_BAR;
    FG_WAIT_V(2); FG_BAR;
    FG_STAGE(FG_SB(1, 0), cB + kstep, voffB); FG_STAGE_A(FG_SA(1, 0), cA + kstep, 0, false); FG_STAGE(FG_SB(1, 1), cB + hstep + kstep, voffB);
    FG_WAIT_V(6); FG_BAR;
    for (;;) {
        GU nxt{};
        const bool has_next = S.next(ui + 1, nxt);
        FG_UNIFY(nxt);
        const char* nA = has_next ? nxt.a : cA; const char* nB = has_next ? nxt.b : cB;
        if constexpr (GATHER) { if (has_next) { nsel = cset ^ 1; FG_GOFF(nsel, nxt); } else nsel = cset; }
#pragma unroll UNR
        for (int t = 0; t < nt; t += 2) {
            const bool last = (t == nt - 2);
            const char *a1, *a2, *a3, *b2, *b3;
            if constexpr (SEG) { const int ts = nt / 3;
                const int s1 = t / ts, s2 = (t + 2) / ts; const size_t k1 = (size_t)(t + 1 - s1 * ts) * kstep, k2 = (size_t)(t + 2 - s2 * ts) * kstep;
                a1 = (s1 == 0 ? cA : (s1 == 1 ? cur.a1 : cur.a2)) + k1;
                a2 = last ? nA : (s2 == 0 ? cA : (s2 == 1 ? cur.a1 : cur.a2)) + k2; b2 = last ? nB : cB + (size_t)s2 * Epi::SEGB + k2;
                a3 = a2 + kstep; b3 = b2 + kstep;
                if (t > 0 && t % ts == 0) { const int lz = hidden_lane(); E.rescale(acc, cur, t / ts, wid >> 2, wid & 3, lz & 15, lz >> 4); } }
            else { a1 = cA + (size_t)(t + 1) * kstep; a2 = last ? nA : cA + (size_t)(t + 2) * kstep; b2 = last ? nB : cB + (size_t)(t + 2) * kstep; a3 = a2 + kstep; b3 = b2 + kstep; }
            const bool relax = NstOf<Epi>::v > 0 && t == 0 && ui > 0;
            FG_LDB(B0, 0, 0); FG_LDB(B1, 0, 1); FG_SCHED; FG_LDA(At, 0, 0); FG_STAGE_A(FG_SA(1, 1), a1, 1, false);
            FG_WAIT_VR(relax); FG_WAIT_L(0); FG_BAR; FG_MMA(0, 0, At, B0); FG_MMA(0, 1, At, B1); FG_BAR; FG_SCHED;
            FG_LDA(At, 0, 1); FG_STAGE(FG_SB(0, 0), b2, voffB); FG_STAGE(FG_SB(0, 1), b2 + hstep, voffB); FG_STAGE_A(FG_SA(0, 0), a2, 0, last);
            FG_WAIT_VR(relax); FG_WAIT_L(0); FG_BAR; FG_MMA(1, 0, At, B0); FG_MMA(1, 1, At, B1); FG_BAR; FG_SCHED;
            FG_LDB(B0, 1, 0); FG_LDB(B1, 1, 1); FG_SCHED; FG_LDA(At, 1, 0); FG_STAGE_A(FG_SA(0, 1), a2, 1, last);
            FG_WAIT_V(8); FG_WAIT_L(0); FG_BAR; FG_MMA(0, 0, At, B0); FG_MMA(0, 1, At, B1); FG_BAR; FG_SCHED;
            FG_LDA(At, 1, 1); FG_STAGE(FG_SB(1, 0), b3, voffB); FG_STAGE(FG_SB(1, 1), b3 + hstep, voffB); FG_STAGE_A(FG_SA(1, 0), a3, 0, last);
            FG_WAIT_V(8); FG_WAIT_L(0); FG_BAR; FG_MMA(1, 0, At, B0); FG_MMA(1, 1, At, B1); FG_BAR; FG_SCHED;
        }
        if (wr == 0) FG_BAR;
        {
            const int lz = hidden_lane();
            E(acc, cur, wid >> 2, wid & 3, lz & 15, lz >> 4); }
        if (!has_next) break;
#pragma unroll
        for (int a = 0; a < 2; ++a)
#pragma unroll
            for (int b = 0; b < 2; ++b)
#pragma unroll
                for (int m = 0; m < 4; ++m)
#pragma unroll
                    for (int n = 0; n < 2; ++n) acc[a][b][m][n] = (f32x4){0.f, 0.f, 0.f, 0.f};
        cur = nxt; cA = nA; cB = nB; ++ui;
        if constexpr (GATHER) cset = nsel;
        if (wr == 1) FG_BAR;
    }
    FG_WAIT_V(0);
    FG_BAR;
#undef FG_SA
#undef FG_SB
#undef FG_STAGE
#undef FG_STAGE_A
#undef FG_LDA
#undef FG_LD8
#undef FG_LDB
#undef FG_MMA
#undef FG_WAIT_V
#undef FG_WAIT_L
#undef FG_WAIT_VR
#undef FG_BAR
#undef FG_SCHED
#undef FG_GOFF
#undef FG_UNIFY
}
}

constexpr size_t OFF_WGU = OFF_ATT;
constexpr size_t OFF_WD = OFF_WGU + (size_t)33 * 512 * 1024 * 2;
static_assert(OFF_WD + (size_t)33 * 1024 * 256 * 2 <= OFF_END_MIX, "MoE weights must fit region C");

struct Args { Ptrs P; int ph_lo, ph_hi; };

__device__ __forceinline__ u32x4 pk8(const float* v) { u32x4 w; w[0] = cvt_pk_bf16(v[0], v[1]); w[1] = cvt_pk_bf16(v[2], v[3]); w[2] = cvt_pk_bf16(v[4], v[5]); w[3] = cvt_pk_bf16(v[6], v[7]); return w; }
__device__ __forceinline__ float sat8(float v) { return __builtin_amdgcn_fmed3f(v, -448.f, 448.f); }
__device__ __forceinline__ u32x2 pk8_fp8(const float* v, float sc) { int a = __builtin_amdgcn_cvt_pk_fp8_f32(sat8(v[0] * sc), sat8(v[1] * sc), 0, false); a = __builtin_amdgcn_cvt_pk_fp8_f32(sat8(v[2] * sc), sat8(v[3] * sc), a, true);
    int b = __builtin_amdgcn_cvt_pk_fp8_f32(sat8(v[4] * sc), sat8(v[5] * sc), 0, false); b = __builtin_amdgcn_cvt_pk_fp8_f32(sat8(v[6] * sc), sat8(v[7] * sc), b, true); return (u32x2){(unsigned)a, (unsigned)b}; }
constexpr float W8SC = 32.f;
__device__ __forceinline__ int w1_col(int r) {
    const int ct = r >> 8, j = r & 255;
    if (ct == 0) return j;
    if (ct == 1) return KV_END + j;
    if (ct == 2) { if (j < 128) return KV_END + 256 + j;
        if (j < 160) { const int p = j - 128, a = p >> 3, half = (p >> 2) & 1, rr = p & 3; return KV_RANK + half * 16 + 4 * a + rr; }
        return -1; }
    if (ct <= 4) return Q_END + (ct - 3) * 256 + j;
    if (ct <= 8) { const int t = ct - 5; return j < 128 ? CB_END + t * 128 + j : CC_END + t * 128 + (j - 128); }
    return FOUR_END + (ct - 9) * 256 + j;
}
__device__ __forceinline__ int wuq_col(int n) { const int h = n / 96, j = n % 96; if (j < 64) return n; const int p = j - 64, a = p >> 3, half = (p >> 2) & 1, rr = p & 3; return h * 96 + 64 + half * 16 + 4 * a + rr; }
template <int MAP, bool O8 = false>
__device__ __forceinline__ void tr_tile(float* tile, const float* src, int ld, int c0, const float* kscale, bf16_t* dst, int K, int n0, int k0, int wid) {
    const int tid = hidden_tid(wid);
#pragma unroll
    for (int i = 0; i < 4; ++i) { const int e = tid + 512 * i, kk = e >> 4, n4 = (e & 15) * 4; const int n = n0 + n4; const int col = MAP == 0 ? c0 + n : (MAP == 1 ? w1_col(n) : wuq_col(n));
        f32x4 v = {0.f, 0.f, 0.f, 0.f}; if (col >= 0) { v = *(const f32x4*)(src + (size_t)(k0 + kk) * ld + col); if (kscale) v *= kscale[k0 + kk]; }
        *(f32x4*)(tile + kk * 68 + n4) = v; }
    __syncthreads();
#pragma unroll
    for (int i = 0; i < 2; ++i) { const int e = tid + 512 * i, nn = e & 63, kc = (e >> 6) * 8; float v[8];
#pragma unroll
        for (int j = 0; j < 8; ++j) v[j] = tile[(kc + j) * 68 + nn];
        if constexpr (O8) *(u32x2*)((u8*)dst + (size_t)(n0 + nn) * K + k0 + kc) = pk8_fp8(v, W8SC); else *(u32x4*)(dst + (size_t)(n0 + nn) * K + k0 + kc) = pk8(v); }
    __syncthreads();
}
template <int MAP, bool O8 = false>
__device__ __forceinline__ void tr_job(float* tile, int& tbase, const float* src, int ld, int c0, const float* kscale, bf16_t* dst, int N, int K, int wid, int wg0 = 0) {
    const int nk = K / 128, ntile = (N / 64) * nk, G = (int)gridDim.x - wg0; const int me = bid_() - wg0; if (me < 0) { tbase += ntile; return; }
    int first = (me - tbase % G + G) % G;
    for (int t = first; t < ntile; t += G) tr_tile<MAP, O8>(tile, src, ld, c0, kscale, dst, K, (t / nk) * 64, (t % nk) * 128, wid);
    tbase += ntile;
}
__device__ __forceinline__ void prep_mix(const Ptrs& P, int l, float* tile, int& tbase, int wid, int wg0 = 0) {
    char* wm = P.ws + OFF_WMIX + (size_t)l * WMIX_BYTES;
    tr_job<1>(tile, tbase, P.w_in + (size_t)l * DM * PROJ_W, PROJ_W, 0, nullptr, (bf16_t*)(wm + WMIX_W1), 2304, DM, wid, wg0);
    tr_job<0, true>(tile, tbase, P.w_in + (size_t)l * DM * PROJ_W, PROJ_W, FOUR_END, nullptr, (bf16_t*)(P.ws + OFF_W1G8 + (size_t)l * 3072 * 1024), 3072, DM, wid, wg0);
    tr_job<0>(tile, tbase, P.w_ukv + (size_t)l * KV_RANK * 1024, 1024, 0, P.g_kv + l * KV_RANK, (bf16_t*)(wm + WMIX_WUKV), 1024, KV_RANK, wid, wg0);
    tr_job<2>(tile, tbase, P.w_uq + (size_t)l * Q_RANK * 768, 768, 0, P.g_q + l * Q_RANK, (bf16_t*)(wm + WMIX_WUQ), 768, Q_RANK, wid, wg0);
    tr_job<0>(tile, tbase, P.w_mla_out + (size_t)l * 512 * DM, DM, 0, nullptr, (bf16_t*)(wm + WMIX_WA), 1024, 512, wid, wg0);
    tr_job<0>(tile, tbase, P.w_conv_out + (size_t)l * 512 * DM, DM, 0, nullptr, (bf16_t*)(wm + WMIX_WA) + (size_t)1024 * 512, 1024, 512, wid, wg0);
    tr_job<0>(tile, tbase, P.w_four_out + (size_t)l * 512 * DM, DM, 0, nullptr, (bf16_t*)(wm + WMIX_WA) + (size_t)2 * 1024 * 512, 1024, 512, wid, wg0);
    tr_job<0>(tile, tbase, P.w_out + (size_t)l * DM * DM, DM, 0, nullptr, (bf16_t*)(wm + WMIX_WO), 1024, DM, wid, wg0);
}

struct EpiYX { static constexpr int NST = 16; bf16_t* yx; float* ssp;
    __device__ __forceinline__ void operator()(const f32x4 (&acc)[2][2][4][2], const fg::GU& u, int wr, int wc, int fr, int fq) const {
#pragma unroll
        for (int ai = 0; ai < 2; ++ai)
#pragma unroll
            for (int m = 0; m < 4; ++m) { const int row = u.r0 + ai * 128 + wr * 64 + m * 16 + fr; float ss = 0.f;
#pragma unroll
                for (int bj = 0; bj < 2; ++bj) { const f32x4 v0 = acc[ai][bj][m][0], v1 = acc[ai][bj][m][1];
                    ss += v0[0] * v0[0] + v0[1] * v0[1] + v0[2] * v0[2] + v0[3] * v0[3] + v1[0] * v1[0] + v1[1] * v1[1] + v1[2] * v1[2] + v1[3] * v1[3];
                    u32x4 w; w[0] = cvt_pk_bf16(v0[0], v0[1]); w[1] = cvt_pk_bf16(v0[2], v0[3]); w[2] = cvt_pk_bf16(v1[0], v1[1]); w[3] = cvt_pk_bf16(v1[2], v1[3]);
                    *(u32x4*)(yx + (size_t)row * DM + u.c0 + bj * 128 + wc * 32 + 8 * fq) = w; }
                ss += lane_xor<16>(ss); ss = lane_xor32_sum(ss);
                if (fq == 0) ssp[(size_t)row * 16 + (u.c0 >> 8) * 4 + wc] = ss; }
    }
};
struct EpiMerge { static constexpr int NST = 16; static constexpr size_t SEGB = (size_t)1024 * 512 * 2;
    bf16_t* merged; const u8* gates;
    __device__ __forceinline__ static float gv(unsigned w, int j) { return (float)((w >> (8 * j)) & 0xffu); }
    __device__ __forceinline__ void rescale(f32x4 (&acc)[2][2][4][2], const fg::GU& u, int seg, int wr, int wc, int fr, int fq) const {
#pragma unroll
        for (int ai = 0; ai < 2; ++ai) { u32x2 gp[4][2], gn[4][2];
#pragma unroll
            for (int m = 0; m < 4; ++m)
#pragma unroll
                for (int bj = 0; bj < 2; ++bj) { const u8* g = gates + (size_t)(u.r0 + ai * 128 + wr * 64 + m * 16 + fr) * 3072 + (seg - 1) * 1024 + u.c0 + bj * 128 + wc * 32 + 8 * fq;
                    gp[m][bj] = *(const u32x2*)g; gn[m][bj] = *(const u32x2*)(g + 1024); }
#pragma unroll
            for (int m = 0; m < 4; ++m)
#pragma unroll
                for (int bj = 0; bj < 2; ++bj)
#pragma unroll
                    for (int j = 0; j < 8; ++j) acc[ai][bj][m][j >> 2][j & 3] *= gv(gp[m][bj][j >> 2], j & 3) * __builtin_amdgcn_rcpf(gv(gn[m][bj][j >> 2], j & 3)); }
    }
    __device__ __forceinline__ void operator()(const f32x4 (&acc)[2][2][4][2], const fg::GU& u, int wr, int wc, int fr, int fq) const {
#pragma unroll
        for (int ai = 0; ai < 2; ++ai) { u32x2 g[4][2];
#pragma unroll
            for (int m = 0; m < 4; ++m)
#pragma unroll
                for (int bj = 0; bj < 2; ++bj) g[m][bj] = *(const u32x2*)(gates + (size_t)(u.r0 + ai * 128 + wr * 64 + m * 16 + fr) * 3072 + 2048 + u.c0 + bj * 128 + wc * 32 + 8 * fq);
#pragma unroll
            for (int m = 0; m < 4; ++m)
#pragma unroll
                for (int bj = 0; bj < 2; ++bj) { const int row = u.r0 + ai * 128 + wr * 64 + m * 16 + fr, col = u.c0 + bj * 128 + wc * 32 + 8 * fq; float v[8];
#pragma unroll
                    for (int j = 0; j < 8; ++j) v[j] = acc[ai][bj][m][j >> 2][j & 3] * (gv(g[m][bj][j >> 2], j & 3) * (1.f / 255.f));
                    *(u32x4*)(merged + (size_t)row * DM + col) = pk8(v); } }
    }
};

struct SchedPlain { const char* A; const char* Bt; int nM, nN, K;
    __device__ __forceinline__ bool next(int i, fg::GU& u) const { const int L = i * (int)gridDim.x + bid_(); if (L >= nM * nN) return false; int pm, pn; fg::tile_order(L, nM, nN, pm, pn);
        u.a = A + (size_t)pm * 256 * K * 2; u.b = Bt + (size_t)pn * 256 * K * 2; u.r0 = pm * 256; u.c0 = pn * 256; u.kind = 0; u.aux = 0; u.gl = nullptr; u.gn = 256; return true; } };
struct SchedMerge { const char *A0, *A1, *A2; const char* W3; int nM;
    __device__ __forceinline__ bool next(int i, fg::GU& u) const { const int tl = i * (int)gridDim.x + bid_(); if (tl >= nM * 4) return false; int pm, pn; fg::tile_order(tl, nM, 4, pm, pn);
        const size_t ao = (size_t)pm * 256 * 512 * 2; u.a = A0 + ao; u.a1 = A1 + ao; u.a2 = A2 + ao; u.b = W3 + (size_t)pn * 256 * 512 * 2; u.r0 = pm * 256; u.c0 = pn * 256; u.kind = 0; u.aux = 0; u.gl = nullptr; u.gn = 256; return true; } };

__device__ __forceinline__ u32x4 pk8_sw(const float* v) { u32x4 w;
#pragma unroll
    for (int i = 0; i < 4; ++i) w[i] = (unsigned)f2bf(v[2 * i]) | ((unsigned)f2bf(v[2 * i + 1]) << 16);
    return w; }
__device__ __forceinline__ void prep_wz(const Ptrs& P, int l, float* ldsf, int& tbase, int wid, int wg0 = 0) {
    const int G = (int)gridDim.x - wg0, tid = hidden_tid(wid), lane = tid & 63, fr = lane & 15, fq = lane >> 4; float* wt = ldsf;
    const int ntile = 4 * 32;
    const int me = bid_() - wg0; if (me < 0) { tbase += ntile; return; }
    const int first = (me - tbase % G + G) % G;
    u8* WZ = (u8*)(P.ws + OFF_WMIX + (size_t)l * WMIX_BYTES + WMIX_WZ);
    if (first < ntile) {
        bf16x8 bh[2][4], bl[2][4];
#pragma unroll
        for (int j = 0; j < 2; ++j) { const int n = 32 * wid + 16 * j + fr, part = n >> 7, cp = n & 127;
#pragma unroll
            for (int kb = 0; kb < 4; ++kb) { float v[8], lo[8];
#pragma unroll
                for (int e = 0; e < 8; ++e) { const int c = 32 * kb + 8 * fq + e; const float ph = 2.f * (float)((c * cp) & 127) / 128.f;
                    v[e] = (part ? -sinpif(ph) : cospif(ph)) * 0.08838834764831845f; lo[e] = v[e] - bf2f(f2bf(v[e])); }
                const u32x4 ph8 = pk8_sw(v), pl8 = pk8_sw(lo); bh[j][kb] = *reinterpret_cast<const bf16x8*>(&ph8); bl[j][kb] = *reinterpret_cast<const bf16x8*>(&pl8); } }
        for (int t = first; t < ntile; t += G) { const int g = t >> 5, k0 = (t & 31) * 32;
            for (int e = tid; e < 32 * 128; e += 512) { const int kk = e >> 7, c = e & 127; wt[kk * 129 + c] = P.w_in[(size_t)l * DM * PROJ_W + (size_t)(k0 + kk) * PROJ_W + CX_END + g * 128 + c]; }
            __syncthreads();
            f32x4 acc[2][2];
#pragma unroll
            for (int m = 0; m < 2; ++m)
#pragma unroll
                for (int j = 0; j < 2; ++j) acc[m][j] = (f32x4){0.f, 0.f, 0.f, 0.f};
#pragma unroll
            for (int kb = 0; kb < 4; ++kb)
#pragma unroll
                for (int m = 0; m < 2; ++m) { float v[8], lo[8];
#pragma unroll
                    for (int e = 0; e < 8; ++e) { v[e] = wt[(16 * m + fr) * 129 + 32 * kb + 8 * fq + e]; lo[e] = v[e] - bf2f(f2bf(v[e])); }
                    const u32x4 ph8 = pk8_sw(v), pl8 = pk8_sw(lo); const bf16x8 ah = *reinterpret_cast<const bf16x8*>(&ph8), al = *reinterpret_cast<const bf16x8*>(&pl8);
#pragma unroll
                    for (int j = 0; j < 2; ++j) { acc[m][j] = __builtin_amdgcn_mfma_f32_16x16x32_bf16(ah, bh[j][kb], acc[m][j], 0, 0, 0);
                        acc[m][j] = __builtin_amdgcn_mfma_f32_16x16x32_bf16(ah, bl[j][kb], acc[m][j], 0, 0, 0); acc[m][j] = __builtin_amdgcn_mfma_f32_16x16x32_bf16(al, bh[j][kb], acc[m][j], 0, 0, 0); } }
#pragma unroll
            for (int m = 0; m < 2; ++m)
#pragma unroll
                for (int j = 0; j < 2; ++j) { const int n = 32 * wid + 16 * j + fr, part = n >> 7, cp = n & 127; float q[4];
#pragma unroll
                    for (int r = 0; r < 4; ++r) q[r] = __builtin_amdgcn_fmed3f(acc[m][j][r] * W8SC, -448.f, 448.f);
                    int w8 = __builtin_amdgcn_cvt_pk_fp8_f32(q[0], q[1], 0, false); w8 = __builtin_amdgcn_cvt_pk_fp8_f32(q[2], q[3], w8, true);
                    *(unsigned*)(WZ + (size_t)(part * 512 + g * 128 + cp) * DM + k0 + 16 * m + 4 * fq) = (unsigned)w8; }
            __syncthreads(); } }
    tbase += ntile;
}
__device__ __forceinline__ void prep_dft(const Ptrs& P, int wid) {
    bf16_t* TC = WSP(bf16_t, OFF_TC);
    const size_t nthr = (size_t)gridDim.x * 512, gid = (size_t)bid_() * 512 + hidden_tid(wid);
    for (size_t e = gid; e < (size_t)RT; e += nthr) WSP(int, OFF_IDL)[e] = (int)e;
    for (size_t e = gid; e < (size_t)256 * 128; e += nthr) { const int kk = e & 127, rho = e >> 7; float v = 0.f;
        if ((rho & 127) < 64) { const int k2 = rho & 63, po = rho >> 7, part = kk >> 6, n2 = kk & 63; const float ph = 2.f * (float)((n2 * k2) & 63) / 64.f;
            const float c = cospif(ph), sn = sinpif(ph); v = po == 0 ? (part == 0 ? c : sn) : (part == 0 ? -sn : c); }
        WSP(bf16_t, OFF_MA)[e] = f2bf(v); }
    for (size_t e = gid; e < (size_t)256 * 128; e += nthr) { const int kk = e & 127, p = e >> 7; float v = 0.f;
        if (p < 64) { const int hfo = p >> 5, k1 = p & 31, hf = kk >> 6, part = (kk >> 5) & 1, n1 = kk & 31; const float ph = 2.f * (float)((n1 * k1) & 31) / 32.f;
            if (hf == hfo) v = (part == 0 ? cospif(ph) : sinpif(ph)) * 0.02209708691207961f; }
        WSP(bf16_t, OFF_MB)[e] = f2bf(v); }
    for (size_t e = gid; e < (size_t)64 * 32; e += nthr) { const int n1 = e & 31, k2 = e >> 5; const float ph = 2.f * (float)(n1 * k2) / 2048.f; WSP(float, OFF_TW)[2 * e] = cospif(ph); WSP(float, OFF_TW)[2 * e + 1] = sinpif(ph); }
    for (size_t e = gid; e < (size_t)256 * 256; e += nthr) { const int kp = e & 255, m = e >> 8; const int k = 2 * kp; const int kk = k & 255;
        const float p0 = 2.f * (float)((m * kk) & 255) / 256.f, p1 = 2.f * (float)((m * (kk + 1)) & 255) / 256.f; const float s = 0.0625f;
        const float v0 = (k < 256 ? cospif(p0) : sinpif(p0)) * s, v1 = (k < 256 ? cospif(p1) : sinpif(p1)) * s; *(unsigned*)(TC + (size_t)m * 512 + k) = cvt_pk_bf16(v0, v1); }
}

__device__ __forceinline__ float fast_sigmoid(float x) { return __builtin_amdgcn_rcpf(1.f + __builtin_amdgcn_exp2f(-1.4426950408889634f * x)); }
__device__ __forceinline__ u32x4 pack8(const f32x4& v0, const f32x4& v1) { u32x4 w; w[0] = cvt_pk_bf16(v0[0], v0[1]); w[1] = cvt_pk_bf16(v0[2], v0[3]); w[2] = cvt_pk_bf16(v1[0], v1[1]); w[3] = cvt_pk_bf16(v1[2], v1[3]); return w; }
__device__ __forceinline__ float sumsq8(const f32x4& v0, const f32x4& v1) { return v0[0] * v0[0] + v0[1] * v0[1] + v0[2] * v0[2] + v0[3] * v0[3] + v1[0] * v1[0] + v1[1] * v1[1] + v1[2] * v1[2] + v1[3] * v1[3]; }

struct EpiProj { static constexpr int NST = 8; const Ptrs P; int l;
    __device__ __forceinline__ void operator()(const f32x4 (&acc)[2][2][4][2], const fg::GU& u, int wr, int wc, int fr, int fq) const {
        const int kind = u.kind;
        if (kind <= 2) {
            bf16_t* dst = kind == 0 ? WSP(bf16_t, OFF_CKV) : WSP(bf16_t, OFF_CQ); const int ld = kind == 0 ? KV_RANK : Q_RANK; const int cb = kind == 2 ? 256 : 0;
            float* ssp = kind == 0 ? WSP(float, OFF_SSP) : WSP(float, OFF_SSPQ); const int sstride = kind == 0 ? 4 : 8; const int sslot = (kind == 2 ? 4 : 0) + wc;
            const int nbj = kind == 2 ? 1 : 2;
#pragma unroll
            for (int ai = 0; ai < 2; ++ai)
#pragma unroll
                for (int m = 0; m < 4; ++m) { const int row = u.r0 + ai * 128 + wr * 64 + m * 16 + fr; float ss = 0.f;
#pragma unroll
                    for (int bj = 0; bj < 2; ++bj) if (bj < nbj) { ss += sumsq8(acc[ai][bj][m][0], acc[ai][bj][m][1]);
                        *(u32x4*)(dst + (size_t)row * ld + cb + bj * 128 + wc * 32 + 8 * fq) = pack8(acc[ai][bj][m][0], acc[ai][bj][m][1]); }
                    ss += lane_xor<16>(ss); ss = lane_xor32_sum(ss);
                    if (fq == 0) ssp[(size_t)row * sstride + sslot] = ss;
                    if (kind == 2 && wc == 0) {
                        const f32x4 x1 = acc[ai][1][m][0], x2 = acc[ai][1][m][1]; f32x4 o1 = x1, o2 = x2;
                        if (row < RX) { const float* cs = WSP(float, OFF_ROPE) + ((size_t)(row & (SEQ - 1)) * 16 + 4 * fq) * 2; const f32x4 t0 = *(const f32x4*)cs, t1 = *(const f32x4*)(cs + 4);
                            const float c[4] = {t0[0], t0[2], t1[0], t1[2]}, s[4] = {t0[1], t0[3], t1[1], t1[3]};
#pragma unroll
                            for (int j = 0; j < 4; ++j) { o1[j] = x1[j] * c[j] - x2[j] * s[j]; o2[j] = x2[j] * c[j] + x1[j] * s[j]; } }
                        const u32x4 w = pack8(o1, o2); bf16_t* kp = WSP(bf16_t, OFF_K) + (size_t)row * 768 + 64 + 8 * fq;
#pragma unroll
                        for (int h = 0; h < NH; ++h) *(u32x4*)(kp + h * 96) = w; }
                }
        } else if (kind == 3) {
            bf16_t* dst = WSP(bf16_t, OFF_CB);
#pragma unroll
            for (int ai = 0; ai < 2; ++ai)
#pragma unroll
                for (int m = 0; m < 4; ++m) { const int row = u.r0 + ai * 128 + wr * 64 + m * 16 + fr;
#pragma unroll
                    for (int bj = 0; bj < 2; ++bj) *(u32x4*)(dst + (size_t)row * CONVW + u.aux + bj * 128 + wc * 32 + 8 * fq) = pack8(acc[ai][bj][m][0], acc[ai][bj][m][1]); }
        } else if (kind == 4) {
            bf16_t* dst = WSP(bf16_t, OFF_INNER);
#pragma unroll
            for (int ai = 0; ai < 2; ++ai)
#pragma unroll
                for (int m = 0; m < 4; ++m) { const int row = u.r0 + ai * 128 + wr * 64 + m * 16 + fr;
                    const f32x4 p0 = acc[ai][0][m][0] * acc[ai][1][m][0], p1 = acc[ai][0][m][1] * acc[ai][1][m][1];
                    *(u32x4*)(dst + (size_t)row * CONVW + u.aux * 128 + wc * 32 + 8 * fq) = pack8(p0, p1); }
        } else if (kind == 7) {
            const int b = u.c0 >> 3, tq = u.c0 & 7; bf16_t* za = WSP(bf16_t, OFF_ZA);
#pragma unroll
            for (int ai = 0; ai < 2; ++ai)
#pragma unroll
                for (int m = 0; m < 4; ++m) { const int zrow = u.r0 + ai * 128 + wr * 64 + m * 16 + fr; const int part = zrow >> 9, gc = zrow & 511;
#pragma unroll
                    for (int bj = 0; bj < 2; ++bj) { const int j0 = bj * 128 + wc * 32 + 8 * fq; const int n1 = 4 * tq + (j0 >> 6), n2 = j0 & 63;
                        *(u32x4*)(za + ((size_t)((b * 32 + n1) * 512 + gc)) * 128 + part * 64 + n2) = pack8(acc[ai][bj][m][0], acc[ai][bj][m][1]); } }
        } else {
            const int tok0 = u.c0; const bool isx = tok0 < RX;
            const int b = isx ? tok0 / SEQ : (tok0 - RX) / CTX, nb = isx ? tok0 % SEQ : 0, Nb = isx ? SEQ : CTX;
            bf16_t* base = isx ? WSP(bf16_t, OFF_ZT) + (size_t)b * 512 * 4096 : WSP(bf16_t, OFF_ZTC) + (size_t)b * 512 * 512;
#pragma unroll
            for (int ai = 0; ai < 2; ++ai)
#pragma unroll
                for (int m = 0; m < 4; ++m) { const int zrow = u.r0 + ai * 128 + wr * 64 + m * 16 + fr; const int part = zrow >> 9, gc = zrow & 511;
#pragma unroll
                    for (int bj = 0; bj < 2; ++bj) *(u32x4*)(base + (size_t)gc * (2 * Nb) + part * Nb + nb + bj * 128 + wc * 32 + 8 * fq) = pack8(acc[ai][bj][m][0], acc[ai][bj][m][1]); }
        }
    }
};
struct EpiZ { static constexpr int NST = 16; const Ptrs P;
    __device__ __forceinline__ void operator()(const f32x4 (&acc)[2][2][4][2], const fg::GU& u, int wr, int wc, int fr, int fq) const {
        constexpr float sc = 1.f / W8SC;
        if (u.kind == 7) {
            const int b = u.c0 >> 3, tq = u.c0 & 7; bf16_t* za = WSP(bf16_t, OFF_ZA);
#pragma unroll
            for (int ai = 0; ai < 2; ++ai)
#pragma unroll
                for (int m = 0; m < 4; ++m) { const int zrow = u.r0 + ai * 128 + wr * 64 + m * 16 + fr; const int part = zrow >> 9, gc = zrow & 511;
#pragma unroll
                    for (int bj = 0; bj < 2; ++bj) { const int j0 = bj * 128 + wc * 32 + 8 * fq; const int n1 = 4 * tq + (j0 >> 6), n2 = j0 & 63;
                        *(u32x4*)(za + ((size_t)((b * 32 + n1) * 512 + gc)) * 128 + part * 64 + n2) = pack8(acc[ai][bj][m][0] * sc, acc[ai][bj][m][1] * sc); } }
        } else {
            const int tok0 = u.c0; const bool isx = tok0 < RX;
            const int b = isx ? tok0 / SEQ : (tok0 - RX) / CTX, nb = isx ? tok0 % SEQ : 0, Nb = isx ? SEQ : CTX;
            bf16_t* base = isx ? WSP(bf16_t, OFF_ZT) + (size_t)b * 512 * 4096 : WSP(bf16_t, OFF_ZTC) + (size_t)b * 512 * 512;
#pragma unroll
            for (int ai = 0; ai < 2; ++ai)
#pragma unroll
                for (int m = 0; m < 4; ++m) { const int zrow = u.r0 + ai * 128 + wr * 64 + m * 16 + fr; const int part = zrow >> 9, gc = zrow & 511;
#pragma unroll
                    for (int bj = 0; bj < 2; ++bj) *(u32x4*)(base + (size_t)gc * (2 * Nb) + part * Nb + nb + bj * 128 + wc * 32 + 8 * fq) = pack8(acc[ai][bj][m][0] * sc, acc[ai][bj][m][1] * sc); }
        }
    }
};
struct EpiGate { static constexpr int NST = 16; const Ptrs P; int l;
    __device__ __forceinline__ void operator()(const f32x4 (&acc)[2][2][4][2], const fg::GU& u, int wr, int wc, int fr, int fq) const {
        {
            u8* dst = WSP(u8, OFF_GATES); const float* bias = P.b_gate + (size_t)l * 3 * DM + u.aux + wc * 32 + 8 * fq;
            f32x4 bv[2][2];
#pragma unroll
            for (int bj = 0; bj < 2; ++bj) { bv[bj][0] = *(const f32x4*)(bias + bj * 128); bv[bj][1] = *(const f32x4*)(bias + bj * 128 + 4); }
#pragma unroll
            for (int ai = 0; ai < 2; ++ai)
#pragma unroll
                for (int m = 0; m < 4; ++m) { const int row = u.r0 + ai * 128 + wr * 64 + m * 16 + fr;
#pragma unroll
                    for (int bj = 0; bj < 2; ++bj) { u32x2 w;
#pragma unroll
                        for (int n = 0; n < 2; ++n) { unsigned pk = 0;
#pragma unroll
                            for (int j = 0; j < 4; ++j) { const float g = fmaxf(255.f * fast_sigmoid(acc[ai][bj][m][n][j] * (1.f / W8SC) + bv[bj][n][j]), 1.f); pk |= ((unsigned)__float2int_rn(g) & 0xffu) << (8 * j); }
                            w[n] = pk; }
                        *(u32x2*)(dst + (size_t)row * 3072 + u.aux + bj * 128 + wc * 32 + 8 * fq) = w; } }
        }
    }
};
struct SchedW1 { const char* H; const char* W1; int l;
    __device__ __forceinline__ bool next(int i, fg::GU& u) const {
        const int c = bid_(); const int nMx = l == 0 ? RT / 256 : RX / 256; const int n1 = nMx * 9, n2 = l == 0 ? 0 : 16;
        const int a0 = l == 0 ? 144 : 160, a1 = l == 0 ? 152 : 176, k0 = 3, k1 = l == 0 ? 1 : 2, k2 = l == 0 ? 2 : 1;
        const int cnt = c < a0 ? k0 : (c < a1 ? k1 : k2); const int base = c < a0 ? k0 * c : (c < a1 ? k0 * a0 + k1 * (c - a0) : k0 * a0 + k1 * (a1 - a0) + k2 * (c - a1));
        const int L = base + i; if (i >= cnt || L >= n1 + n2) return false; u.gl = nullptr; u.gn = 256; u.aux = 0; int pm, ct;
        if (L < n1) fg::tile_order(L, nMx, 9, pm, ct); else { const int j = L - n1; pm = RX / 256 + (j >> 1); ct = (j & 1) ? 2 : 0; }
        u.a = H + (size_t)pm * 256 * DM * 2; u.b = W1 + (size_t)ct * 256 * DM * 2; u.r0 = pm * 256; u.c0 = ct * 256;
        if (ct <= 2) u.kind = ct; else if (ct <= 4) { u.kind = 3; u.aux = (ct - 3) * 256; } else { u.kind = 4; u.aux = ct - 5; }
        return true; } };
struct SchedGate { const char* H8; const char* W8; int l;
    __device__ __forceinline__ bool next(int i, fg::GU& u) const { const int c = bid_(); const int nMx = l == 0 ? RT / 256 : RX / 256;
        const int b0 = l == 0 ? 144 : 160, b1 = l == 0 ? 152 : 176, b2 = l == 0 ? 224 : 256, n0 = l == 0 ? 3 : 2, n1 = l == 0 ? 6 : 3, n2 = l == 0 ? 4 : 5, n3 = 3;
        const int cnt = c < b0 ? n0 : (c < b1 ? n1 : (c < b2 ? n2 : n3));
        const int base = c < b0 ? n0 * c : (c < b1 ? n0 * b0 + n1 * (c - b0) : (c < b2 ? n0 * b0 + n1 * (b1 - b0) + n2 * (c - b1) : n0 * b0 + n1 * (b1 - b0) + n2 * (b2 - b1) + n3 * (c - b2)));
        const int L = base + i; if (i >= cnt || L >= nMx * 12) return false; int pm, ct; fg::tile_order(L, nMx, 12, pm, ct); u.gl = nullptr; u.gn = 256;
        u.a = H8 + (size_t)pm * 256 * DM; u.b = W8 + (size_t)ct * 256 * DM; u.r0 = pm * 256; u.c0 = 0; u.kind = 5; u.aux = ct * 256; return true; } };
struct SchedZx { const char* H; const char* WZ;
    __device__ __forceinline__ bool next(int i, fg::GU& u) const { const int L = i * (int)gridDim.x + bid_(); if (L >= 256) return false; const int zt = L & 3, bt = L >> 2, b = bt >> 3, tq = bt & 7;
        u.gl = nullptr; u.gn = 256; u.aux = 0; u.a = WZ + (size_t)zt * 256 * DM; u.b = H + ((size_t)b * SEQ + 4 * tq) * DM; u.r0 = zt * 256; u.c0 = bt; u.kind = 7; return true; } };
struct SchedZc { const char* H; const char* WZ;
    __device__ __forceinline__ bool next(int i, fg::GU& u) const { const int L = bid_() - 224; if (i > 0 || L < 0 || L >= 32) return false; const int zt = L & 3, tt = RX / 256 + (L >> 2);
        u.gl = nullptr; u.gn = 256; u.aux = 0; u.a = WZ + (size_t)zt * 256 * DM; u.b = H + (size_t)tt * 256 * DM; u.r0 = zt * 256; u.c0 = tt * 256; u.kind = 6; return true; } };
struct SchedFftA { const char* ZA; const char* MA;
    __device__ __forceinline__ bool next(int i, fg::GU& u) const { const int L = i * (int)gridDim.x + bid_(); if (L >= 512) return false; const int b = L >> 6, gcb = L & 63;
        u.gl = nullptr; u.gn = 256; u.aux = 0; u.kind = 0; u.a = MA; u.b = ZA + ((size_t)b * 32 * 512 + gcb * 8) * 256; u.r0 = b; u.c0 = gcb; return true; } };
struct EpiFftA { const Ptrs P;
    __device__ __forceinline__ void operator()(const f32x4 (&acc)[2][2][4][2], const fg::GU& u, int wr, int wc, int fr, int fq) const {
        if (wr != 0) return;
        const int b = u.r0, gcb = u.c0; bf16_t* zb = WSP(bf16_t, OFF_ZB); const float* tw = WSP(float, OFF_TW);
#pragma unroll
        for (int m = 0; m < 4; ++m) { const int k2 = 16 * m + fr; const float* t = tw + ((size_t)k2 * 32 + 8 * fq) * 2;
            const f32x4 t0 = *(const f32x4*)t, t1 = *(const f32x4*)(t + 4), t2 = *(const f32x4*)(t + 8), t3 = *(const f32x4*)(t + 12);
            const float c[8] = {t0[0], t0[2], t1[0], t1[2], t2[0], t2[2], t3[0], t3[2]}, sn[8] = {t0[1], t0[3], t1[1], t1[3], t2[1], t2[3], t3[1], t3[3]};
#pragma unroll
            for (int bj = 0; bj < 2; ++bj) { const int gc = gcb * 8 + 4 * bj + wc; float vr[8], vi[8];
#pragma unroll
                for (int j = 0; j < 8; ++j) { const float re = acc[0][bj][m][j >> 2][j & 3], im = acc[1][bj][m][j >> 2][j & 3]; vr[j] = re * c[j] + im * sn[j]; vi[j] = im * c[j] - re * sn[j]; }
                bf16_t* o = zb + ((((size_t)(b * 64 + k2) * 256 + (gc & 255)) * 2 + (gc >> 8)) * 64) + 8 * fq;
                *(u32x4*)o = pk8(vr); *(u32x4*)(o + 32) = pk8(vi); } }
    }
};
struct SchedFftB { const char* ZB; const char* MB;
    __device__ __forceinline__ bool next(int i, fg::GU& u) const { const int L = i * (int)gridDim.x + bid_(); if (L >= 512) return false;
        u.gl = nullptr; u.gn = 256; u.aux = 0; u.kind = 0; u.a = MB; u.b = ZB + (size_t)L * 256 * 256; u.r0 = L >> 6; u.c0 = L & 63; return true; } };
struct EpiFftB { bf16_t* four;
    __device__ __forceinline__ void operator()(const f32x4 (&acc)[2][2][4][2], const fg::GU& u, int wr, int wc, int fr, int fq) const {
        if (wr != 0) return;
        const int b = u.r0, k2 = u.c0;
#pragma unroll
        for (int m = 0; m < 4; ++m) { const int hf = m >> 1, k1 = 16 * (m & 1) + fr;
#pragma unroll
            for (int bj = 0; bj < 2; ++bj) *(u32x4*)(four + ((size_t)b * SEQ + 64 * k1 + k2) * FW + 256 * hf + bj * 128 + wc * 32 + 8 * fq) = pack8(acc[0][bj][m][0], acc[0][bj][m][1]); }
    }
};

struct EpiUKV { const Ptrs P;
    __device__ __forceinline__ void operator()(const f32x4 (&acc)[2][2][4][2], const fg::GU& u, int wr, int wc, int fr, int fq) const {
#pragma unroll
        for (int ai = 0; ai < 2; ++ai)
#pragma unroll
            for (int m = 0; m < 4; ++m) { const int row = u.r0 + ai * 128 + wr * 64 + m * 16 + fr;
                const f32x4 sp = *(const f32x4*)(WSP(float, OFF_SSP) + (size_t)row * 4); const float r = rsqrtf((sp[0] + sp[1] + sp[2] + sp[3]) * (1.f / KV_RANK) + EPS);
#pragma unroll
                for (int bj = 0; bj < 2; ++bj) { const int h = (u.c0 >> 7) + bj; const f32x4 v0 = acc[ai][bj][m][0] * r, v1 = acc[ai][bj][m][1] * r;
                    bf16_t* dst = wc < 2 ? WSP(bf16_t, OFF_K) + (size_t)row * 768 + h * 96 + wc * 32 + 8 * fq : WSP(bf16_t, OFF_V) + (size_t)row * 512 + h * 64 + (wc - 2) * 32 + 8 * fq;
                    *(u32x4*)dst = pack8(v0, v1); } }
    }
};
struct EpiUQ { const Ptrs P;
    __device__ __forceinline__ void operator()(const f32x4 (&acc)[2][2][4][2], const fg::GU& u, int wr, int wc, int fr, int fq) const {
#pragma unroll
        for (int ai = 0; ai < 2; ++ai)
#pragma unroll
            for (int m = 0; m < 4; ++m) { const int row = u.r0 + ai * 128 + wr * 64 + m * 16 + fr;
                const float* spp = WSP(float, OFF_SSPQ) + (size_t)row * 8; const f32x4 s0 = *(const f32x4*)spp, s1 = *(const f32x4*)(spp + 4);
                const float r = rsqrtf((((s0[0] + s0[1]) + (s0[2] + s0[3])) + ((s1[0] + s1[1]) + (s1[2] + s1[3]))) * (1.f / Q_RANK) + EPS) * QSCALE;
#pragma unroll
                for (int bj = 0; bj < 2; ++bj) { const int col = u.c0 + bj * 128 + wc * 32; const int part = (col >> 5) % 3;
                    f32x4 v0 = acc[ai][bj][m][0] * r, v1 = acc[ai][bj][m][1] * r;
                    if (part == 2 && row < RX) { const float* cs = WSP(float, OFF_ROPE) + ((size_t)(row & (SEQ - 1)) * 16 + 4 * fq) * 2; const f32x4 t0 = *(const f32x4*)cs, t1 = *(const f32x4*)(cs + 4);
                        const float c[4] = {t0[0], t0[2], t1[0], t1[2]}, s[4] = {t0[1], t0[3], t1[1], t1[3]}; const f32x4 x1 = v0, x2 = v1;
#pragma unroll
                        for (int j = 0; j < 4; ++j) { v0[j] = x1[j] * c[j] - x2[j] * s[j]; v1[j] = x2[j] * c[j] + x1[j] * s[j]; } }
                    *(u32x4*)(WSP(bf16_t, OFF_Q) + (size_t)row * 768 + col + 8 * fq) = pack8(v0, v1); } }
    }
};
struct SchedPlainShift { const char* A; const char* Bt; int nM, nN, K, shift;
    __device__ __forceinline__ bool next(int i, fg::GU& u) const { const int G = gridDim.x; const int L = i * G + (bid_() + G - shift) % G; if (L >= nM * nN) return false; int pm, pn; fg::tile_order(L, nM, nN, pm, pn);
        u.a = A + (size_t)pm * 256 * K * 2; u.b = Bt + (size_t)pn * 256 * K * 2; u.r0 = pm * 256; u.c0 = pn * 256; u.kind = 0; u.aux = 0; u.gl = nullptr; u.gn = 256; return true; } };

namespace at {
constexpr int NW = 8, QBLK = 32, KVBLK = 64, DQK = 96, DV = 64;
constexpr int SHM_V = KVBLK * DV * 2, SHM_K = KVBLK * 256, NSLOT = 4, SLOT_B = SHM_K + SHM_V, SHM_ATTN = NSLOT * SLOT_B + NW * 64 * 4;
constexpr float THR2 = 2896.309375740099f;
typedef short s16x4 __attribute__((ext_vector_type(4)));
typedef float f32x16 __attribute__((ext_vector_type(16)));
#define AT_KSWZ(row, colB) ((row) * 256 + ((colB) ^ (((row) & 15) << 4)))
#define AT_SBAR() __builtin_amdgcn_sched_barrier(0)
__device__ __forceinline__ int crow(int r, int hi) { return (r & 3) + 8 * (r >> 2) + 4 * hi; }
__device__ __forceinline__ float rowmaxSM(const f32x16& p0, const f32x16& p1) {
  float pmax = p0[0];
#pragma unroll
  for (int r = 1; r < 16; ++r) pmax = fmaxf(pmax, p0[r]);
#pragma unroll
  for (int r = 0; r < 16; ++r) pmax = fmaxf(pmax, p1[r]);
  { auto rr = __builtin_amdgcn_permlane32_swap(__float_as_uint(pmax), __float_as_uint(pmax), false, false);
    pmax = fmaxf(__uint_as_float(rr[0]), __uint_as_float(rr[1])); }
  return pmax;
}
__device__ __forceinline__ void headSM(f32x16& p0, f32x16& p1, float& m_reg, float& mn, float& alpha) {
  const float pmax = rowmaxSM(p0, p1); mn = fmaxf(m_reg, pmax); alpha = __builtin_amdgcn_exp2f(m_reg - mn); m_reg = mn;
#pragma unroll
  for (int r = 0; r < 16; ++r) p0[r] = p0[r] - mn;
#pragma unroll
  for (int r = 0; r < 16; ++r) p1[r] = p1[r] - mn;
#pragma unroll
  for (int r = 0; r < 16; ++r) p0[r] = __builtin_amdgcn_exp2f(p0[r]);
}
struct KFrag { bf16x8 f[12]; };
template <int OFF> __device__ __forceinline__ bf16x8 k_read(int a) { bf16x8 r; asm volatile("ds_read_b128 %0, %1 offset:%2" : "=v"(r) : "v"(a), "i"(OFF) : "memory"); return r; }
__device__ __forceinline__ void k_issue(KFrag& k, const int (&ka)[DQK / 16], int so) {
#pragma unroll
  for (int d0 = 0; d0 < DQK / 16; ++d0) { const int a = ka[d0] + so; k.f[2 * d0] = k_read<0>(a); k.f[2 * d0 + 1] = k_read<32 * 256>(a); }
}
__device__ __forceinline__ void dma16(const void* g, unsigned ldsaddr) { unsigned keep;
  asm volatile("s_mov_b32 %0, m0\n\ts_mov_b32 m0, %2\n\ts_nop 0\n\tglobal_load_lds_dwordx4 %1, off\n\ts_mov_b32 m0, %0" : "=&s"(keep) : "v"(g), "s"(ldsaddr) : "memory"); }
#define AT_KW(N, A, B) asm volatile("s_waitcnt lgkmcnt(" #N ")" : "+v"(A), "+v"(B))
#define AT_MM(A, B, C) __builtin_amdgcn_mfma_f32_32x32x16_bf16(A, B, C, 0, 0, 0)
#define AT_PK4(P, BASE, OUT) do { unsigned a0 = cvt_pk_bf16(P[BASE + 0], P[BASE + 1]), a1 = cvt_pk_bf16(P[BASE + 2], P[BASE + 3]);   \
    unsigned b0 = cvt_pk_bf16(P[BASE + 4], P[BASE + 5]), b1 = cvt_pk_bf16(P[BASE + 6], P[BASE + 7]);                              \
    auto r0 = __builtin_amdgcn_permlane32_swap(a0, b0, false, false); auto r1 = __builtin_amdgcn_permlane32_swap(a1, b1, false, false); \
    u32x4 w = {r0[0], r1[0], r0[1], r1[1]}; OUT = *reinterpret_cast<bf16x8*>(&w); } while (0)
template <bool PREV> __device__ __forceinline__ void qk_block(f32x16& n0, f32x16& n1, KFrag& k, const bf16x8* qr, const float zf, f32x16& P0, f32x16& P1, float& psum, float& l_reg, bf16x8& pa0, bf16x8& pa1, bf16x8& pa2, bf16x8& pa3) {
  f32x16 z; _Pragma("unroll") for (int r = 0; r < 16; ++r) z[r] = zf;
  float ps = 0.f;
  if (PREV) {
#pragma unroll
    for (int r = 0; r < 16; ++r) P1[r] = __builtin_amdgcn_exp2f(P1[r]);
    asm volatile("s_waitcnt lgkmcnt(10)" : "+v"(k.f[0]), "+v"(k.f[1]), "+v"(P1)); }
  else AT_KW(10, k.f[0], k.f[1]);
  n0 = AT_MM(k.f[0], qr[0], z); n1 = AT_MM(k.f[1], qr[0], z);
  if (PREV) {
#pragma unroll
    for (int r = 0; r < 16; ++r) ps += P0[r]; }
  AT_SBAR();
  AT_KW(8, k.f[2], k.f[3]); n0 = AT_MM(k.f[2], qr[1], n0); n1 = AT_MM(k.f[3], qr[1], n1);
  if (PREV) {
#pragma unroll
    for (int r = 0; r < 16; ++r) ps += P1[r]; }
  AT_SBAR();
  AT_KW(6, k.f[4], k.f[5]); n0 = AT_MM(k.f[4], qr[2], n0); n1 = AT_MM(k.f[5], qr[2], n1);
  if (PREV) { AT_PK4(P0, 0, pa0); AT_PK4(P0, 8, pa1); }
  AT_SBAR();
  AT_KW(4, k.f[6], k.f[7]); n0 = AT_MM(k.f[6], qr[3], n0); n1 = AT_MM(k.f[7], qr[3], n1);
  if (PREV) { AT_PK4(P1, 0, pa2); AT_PK4(P1, 8, pa3); }
  AT_SBAR();
  AT_KW(2, k.f[8], k.f[9]); n0 = AT_MM(k.f[8], qr[4], n0); n1 = AT_MM(k.f[9], qr[4], n1);
  if (PREV) { auto rr = __builtin_amdgcn_permlane32_swap(__float_as_uint(ps), __float_as_uint(ps), false, false);
    ps = __uint_as_float(rr[0]) + __uint_as_float(rr[1]); l_reg += ps; psum = ps; }
  AT_SBAR();
  AT_KW(0, k.f[10], k.f[11]); n0 = AT_MM(k.f[10], qr[5], n0); n1 = AT_MM(k.f[11], qr[5], n1);
  AT_SBAR();
}
__device__ __forceinline__ int v_st(int k, int c) { const int kk = (k & ~0xC) | ((k & 4) << 1) | ((k & 8) >> 1); return ((kk >> 3) * 2 + (c >> 5)) * 512 + ((kk & 7) * 32 + (c & 31)) * 2; }
__device__ __forceinline__ int v_rd_base(int lane) { return ((lane & 3) << 3) | (((lane >> 2) & 3) << 6) | (((lane >> 4) & 1) << 5) | (((lane >> 5) & 1) << 8); }
constexpr int v_rd_off(int d0, int ks, int half) { return d0 * 512 + ks * 2048 + half * 1024; }
template <int OFF> __device__ __forceinline__ s16x4 tr_read(int vb) {
  s16x4 r; asm volatile("ds_read_b64_tr_b16 %0, %1 offset:%2" : "=&v"(r) : "v"(vb), "i"(OFF) : "memory"); return r;
}
struct VFrag { s16x4 f[16]; };
__device__ __forceinline__ void pv_issue(VFrag& v, int vb) {
  v.f[0] = tr_read<v_rd_off(0, 0, 0)>(vb);  v.f[1] = tr_read<v_rd_off(0, 0, 1)>(vb);  v.f[2] = tr_read<v_rd_off(1, 0, 0)>(vb);  v.f[3] = tr_read<v_rd_off(1, 0, 1)>(vb);
  v.f[4] = tr_read<v_rd_off(0, 1, 0)>(vb);  v.f[5] = tr_read<v_rd_off(0, 1, 1)>(vb);  v.f[6] = tr_read<v_rd_off(1, 1, 0)>(vb);  v.f[7] = tr_read<v_rd_off(1, 1, 1)>(vb);
  v.f[8] = tr_read<v_rd_off(0, 2, 0)>(vb);  v.f[9] = tr_read<v_rd_off(0, 2, 1)>(vb);  v.f[10] = tr_read<v_rd_off(1, 2, 0)>(vb); v.f[11] = tr_read<v_rd_off(1, 2, 1)>(vb);
  v.f[12] = tr_read<v_rd_off(0, 3, 0)>(vb); v.f[13] = tr_read<v_rd_off(0, 3, 1)>(vb); v.f[14] = tr_read<v_rd_off(1, 3, 0)>(vb); v.f[15] = tr_read<v_rd_off(1, 3, 1)>(vb);
}
#define AT_VW(N, V, I) asm volatile("s_waitcnt lgkmcnt(" #N ")" : "+v"(V.f[I]), "+v"(V.f[I + 1]), "+v"(V.f[I + 2]), "+v"(V.f[I + 3]))
#define AT_PK(L, H) (bf16x8){L[0], L[1], L[2], L[3], H[0], H[1], H[2], H[3]}
template <bool NEXT> __device__ __forceinline__ void pv_block(f32x16* o, VFrag& v, bf16x8 pa0, bf16x8 pa1, bf16x8 pa2, bf16x8 pa3, f32x16& n0, f32x16& n1, float& m_reg, float& l_reg, float psum, float& alpha) {
  if (NEXT) {
#pragma unroll
    for (int r = 0; r < 4; ++r) n0[r] = __builtin_amdgcn_exp2f(n0[r]);
    asm volatile("s_waitcnt lgkmcnt(12)" : "+v"(v.f[0]), "+v"(v.f[1]), "+v"(v.f[2]), "+v"(v.f[3]), "+v"(n0)); }
  else AT_VW(12, v, 0);
  o[0] = AT_MM(pa0, AT_PK(v.f[0], v.f[1]), o[0]); o[1] = AT_MM(pa0, AT_PK(v.f[2], v.f[3]), o[1]);
  if (NEXT) {
#pragma unroll
    for (int r = 4; r < 8; ++r) n0[r] = __builtin_amdgcn_exp2f(n0[r]);
    asm volatile("s_waitcnt lgkmcnt(8)" : "+v"(v.f[4]), "+v"(v.f[5]), "+v"(v.f[6]), "+v"(v.f[7]), "+v"(n0)); }
  else AT_VW(8, v, 4);
  o[0] = AT_MM(pa1, AT_PK(v.f[4], v.f[5]), o[0]); o[1] = AT_MM(pa1, AT_PK(v.f[6], v.f[7]), o[1]);
  if (NEXT) {
#pragma unroll
    for (int r = 8; r < 12; ++r) n0[r] = __builtin_amdgcn_exp2f(n0[r]);
    asm volatile("s_waitcnt lgkmcnt(4)" : "+v"(v.f[8]), "+v"(v.f[9]), "+v"(v.f[10]), "+v"(v.f[11]), "+v"(n0)); }
  else AT_VW(4, v, 8);
  o[0] = AT_MM(pa2, AT_PK(v.f[8], v.f[9]), o[0]); o[1] = AT_MM(pa2, AT_PK(v.f[10], v.f[11]), o[1]);
  if (NEXT) {
#pragma unroll
    for (int r = 12; r < 16; ++r) n0[r] = __builtin_amdgcn_exp2f(n0[r]);
    asm volatile("s_waitcnt lgkmcnt(0)" : "+v"(v.f[12]), "+v"(v.f[13]), "+v"(v.f[14]), "+v"(v.f[15]), "+v"(n0)); }
  else AT_VW(0, v, 12);
  o[0] = AT_MM(pa3, AT_PK(v.f[12], v.f[13]), o[0]); o[1] = AT_MM(pa3, AT_PK(v.f[14], v.f[15]), o[1]);
  AT_SBAR();
  if (NEXT) {
    alpha = 1.f;
    if (!__all(psum <= THR2)) { const float ex = fmaxf(__builtin_amdgcn_logf(psum), 0.f); alpha = __builtin_amdgcn_exp2f(-ex); m_reg += ex; l_reg *= alpha;
#pragma unroll
      for (int r = 0; r < 16; ++r) { n0[r] *= alpha; n1[r] -= ex; } } }
}
#undef AT_PK
__device__ __forceinline__ void attn_unit(const bf16_t* __restrict__ Qg, const bf16_t* __restrict__ Kg, const bf16_t* __restrict__ Vg, bf16_t* __restrict__ Og,
                                          int qrow0, int h, int ctxrow0, int xrow0, int nctx_t, int NT, char* lds, int wid) {
  const int tid = hidden_tid(wid), lane = tid & 63, r32 = lane & 31, hi = lane >> 5;
  const unsigned lds0 = (unsigned)(uintptr_t)lds;
  float* ws = (float*)(lds + NSLOT * SLOT_B) + wid * 64; float* li_l = ws; float* al_l = ws + 32;
  float m_reg = -1e30f, l_reg = 0; f32x16 o[2] = {}; bf16x8 qr[DQK / 16];
  const bf16_t* Kh = Kg + h * 96; const bf16_t* Vh = Vg + h * 64;
  const int kra = 8 * wid + (lane >> 4), krb = kra + 4, cpos = lane & 15, ca = cpos ^ (kra & 15), cb = cpos ^ (krb & 15);
  const bool va = ca < 12, vb_ = cb < 12; const int koffa = kra * 768 + ca * 8, koffb = krb * 768 + cb * 8;
  const int vu = wid * 64 + lane, vsub = vu >> 5, vkk = (vsub >> 1) * 8 + ((vu >> 2) & 7), vk = (vkk & ~0xC) | ((vkk & 4) << 1) | ((vkk & 8) >> 1), voff = vk * 512 + (vsub & 1) * 32 + (vu & 3) * 8;
#define AT_KROW(j) ((j) < nctx_t ? ctxrow0 + (j) * KVBLK : xrow0 + ((j) - nctx_t) * KVBLK)
#define AT_SLOT(t) (((t) & (NSLOT - 1)) * SLOT_B)
#define AT_DMA(t) do { const int _kr = AT_KROW(t); const unsigned _sb = lds0 + AT_SLOT(t); const bf16_t* _kp = Kh + (size_t)_kr * 768;                 \
    if (va) dma16(_kp + koffa, _sb + wid * 2048); if (vb_) dma16(_kp + koffb, _sb + wid * 2048 + 1024); dma16(Vh + (size_t)_kr * 512 + voff, _sb + SHM_K + wid * 1024); } while (0)
#define AT_TOP(t) do { if ((t) + 1 < NT) asm volatile("s_waitcnt vmcnt(3)" ::: "memory"); else asm volatile("s_waitcnt vmcnt(0)" ::: "memory"); __syncthreads(); if ((t) + 2 < NT) AT_DMA((t) + 2); } while (0)
#define AT_RESC(a) do { if (__any((a) < 1.f)) { if (hi == 0) al_l[r32] = (a); asm volatile("s_waitcnt lgkmcnt(0)" ::: "memory"); \
    _Pragma("unroll") for (int d = 0; d < 2; ++d) _Pragma("unroll") for (int r = 0; r < 16; ++r) o[d][r] *= al_l[crow(r, hi)]; } } while (0)
  AT_DMA(0); AT_DMA(1);
  const bf16_t* Qw = Qg + (size_t)(qrow0 + wid * QBLK + r32) * 768 + h * 96 + hi * 8;
#pragma unroll
  for (int d0 = 0; d0 < DQK / 16; ++d0) qr[d0] = *reinterpret_cast<const bf16x8*>(Qw + d0 * 16);
  const int vb0 = (int)lds0 + SHM_K + v_rd_base(lane);
  f32x16 pA0, pA1, pB0, pB1; float mnA, alA, alB, psum = 0.f; bf16x8 pa0, pa1, pa2, pa3; KFrag kf; VFrag vf;
  int ka[DQK / 16];
#pragma unroll
  for (int d0 = 0; d0 < DQK / 16; ++d0) ka[d0] = (int)lds0 + AT_KSWZ(r32, (d0 * 16 + hi * 8) * 2);
  asm volatile("s_waitcnt vmcnt(0)" ::: "memory"); __syncthreads(); AT_DMA(2);
  k_issue(kf, ka, 0); AT_SBAR(); qk_block<false>(pA0, pA1, kf, qr, 0.f, pA0, pA1, psum, l_reg, pa0, pa1, pa2, pa3); headSM(pA0, pA1, m_reg, mnA, alA);

  for (int t = 1; t + 1 < NT; t += 2) {
    AT_TOP(t);
    AT_SBAR(); k_issue(kf, ka, AT_SLOT(t)); AT_SBAR(); qk_block<true>(pB0, pB1, kf, qr, -m_reg, pA0, pA1, psum, l_reg, pa0, pa1, pa2, pa3);
    pv_issue(vf, vb0 + AT_SLOT(t - 1)); AT_SBAR(); pv_block<true>(o, vf, pa0, pa1, pa2, pa3, pB0, pB1, m_reg, l_reg, psum, alB);
    AT_RESC(alB);
    AT_TOP(t + 1);
    AT_SBAR(); k_issue(kf, ka, AT_SLOT(t + 1)); AT_SBAR(); qk_block<true>(pA0, pA1, kf, qr, -m_reg, pB0, pB1, psum, l_reg, pa0, pa1, pa2, pa3);
    pv_issue(vf, vb0 + AT_SLOT(t)); AT_SBAR(); pv_block<true>(o, vf, pa0, pa1, pa2, pa3, pA0, pA1, m_reg, l_reg, psum, alA);
    AT_RESC(alA);
  }
  AT_TOP(NT - 1);
  AT_SBAR(); k_issue(kf, ka, AT_SLOT(NT - 1)); AT_SBAR(); qk_block<true>(pB0, pB1, kf, qr, -m_reg, pA0, pA1, psum, l_reg, pa0, pa1, pa2, pa3);
  pv_issue(vf, vb0 + AT_SLOT(NT - 2)); AT_SBAR(); pv_block<true>(o, vf, pa0, pa1, pa2, pa3, pB0, pB1, m_reg, l_reg, psum, alB);
  AT_RESC(alB);
  { float ps = 0.f;
#pragma unroll
    for (int r = 0; r < 16; ++r) pB1[r] = __builtin_amdgcn_exp2f(pB1[r]);
#pragma unroll
    for (int r = 0; r < 16; ++r) ps += pB0[r];
#pragma unroll
    for (int r = 0; r < 16; ++r) ps += pB1[r];
    { auto rr = __builtin_amdgcn_permlane32_swap(__float_as_uint(ps), __float_as_uint(ps), false, false); ps = __uint_as_float(rr[0]) + __uint_as_float(rr[1]); }
    l_reg += ps; AT_PK4(pB0, 0, pa0); AT_PK4(pB0, 8, pa1); AT_PK4(pB1, 0, pa2); AT_PK4(pB1, 8, pa3); }
  AT_SBAR();
  pv_issue(vf, vb0 + AT_SLOT(NT - 1)); pv_block<false>(o, vf, pa0, pa1, pa2, pa3, pB0, pB1, m_reg, l_reg, psum, alB);
  if (hi == 0) li_l[r32] = l_reg; asm volatile("s_waitcnt lgkmcnt(0)" ::: "memory");
  float rli[16];
#pragma unroll
  for (int r = 0; r < 16; ++r) rli[r] = __builtin_amdgcn_rcpf(li_l[crow(r, hi)]);
  bf16_t* Ow = Og + (size_t)(qrow0 + wid * QBLK) * 512 + h * 64;
#pragma unroll
  for (int r = 0; r < 16; ++r) { const int orow = crow(r, hi);
#pragma unroll
    for (int d0 = 0; d0 < 2; ++d0) Ow[(size_t)orow * 512 + d0 * 32 + r32] = f2bf(o[d0][r] * rli[r]); }
  __syncthreads();
#undef AT_KROW
#undef AT_SLOT
#undef AT_DMA
#undef AT_TOP
#undef AT_RESC
}
}

struct EpiBf16 { static constexpr int NST = 16; bf16_t* o; int ld;
    __device__ __forceinline__ void operator()(const f32x4 (&acc)[2][2][4][2], const fg::GU& u, int wr, int wc, int fr, int fq) const {
#pragma unroll
        for (int ai = 0; ai < 2; ++ai)
#pragma unroll
            for (int m = 0; m < 4; ++m) { const int row = u.r0 + ai * 128 + wr * 64 + m * 16 + fr;
#pragma unroll
                for (int bj = 0; bj < 2; ++bj) *(u32x4*)(o + (size_t)row * ld + u.c0 + bj * 128 + wc * 32 + 8 * fq) = pack8(acc[ai][bj][m][0], acc[ai][bj][m][1]); }
    }
};
struct SchedF2c { const char* T; const char* ZT;
    __device__ __forceinline__ bool next(int i, fg::GU& u) const { const int c = bid_() - 192; if (i > 0 || c < 0 || c >= 16) return false; const int b = c >> 1, pn = c & 1;
        u.a = T; u.b = ZT + ((size_t)b * 512 + pn * 256) * 512 * 2; u.r0 = RX + b * CTX; u.c0 = pn * 256; u.kind = 0; u.aux = 0; u.gl = nullptr; u.gn = 256; return true; } };
__device__ __forceinline__ void attn_phase(const Ptrs& P, int l, char* lds, int wid) {
    const int c = bid_(); const bf16_t* Q = WSP(bf16_t, OFF_Q); const bf16_t* K = WSP(bf16_t, OFF_K); const bf16_t* V = WSP(bf16_t, OFF_V); bf16_t* O = WSP(bf16_t, OFF_ATT);
    { const int x = c & 7, sidx = c >> 3;
#pragma unroll
      for (int k = 0; k < 2; ++k) { const int loc = sidx + 32 * k; const int bh = x * 8 + (loc >> 3), qb = loc & 7; const int b = bh >> 3, h = bh & 7;
          at::attn_unit(Q, K, V, O, b * SEQ + qb * 256, h, RX + b * CTX, b * SEQ, CTX / 64, (CTX + SEQ) / 64, lds, wid); } }
    if (l == 0 && c >= 128 && c < 192) { const int j = c - 128, b = j >> 3, h = j & 7;
        at::attn_unit(Q, K, V, O, RX + b * CTX, h, RX + b * CTX, 0, CTX / 64, CTX / 64, lds, wid); }
}

__device__ __forceinline__ void moe_tr_tile(const Ptrs& P, int l, int t, const float*& src, int& ld, char*& dst, int& K, bool& o8) {
    const int e = t / 96, r = t % 96;
    if (r < 64) { const int nb = r >> 3, kb = r & 7, pn = nb >> 2, half = (nb >> 1) & 1, sub = nb & 1;
        const float* base = half ? (e < NE ? P.w_up_e + ((size_t)l * NE + e) * DM * FE : P.w_up_s + (size_t)l * DM * FE) : (e < NE ? P.w_gate_e + ((size_t)l * NE + e) * DM * FE : P.w_gate_s + (size_t)l * DM * FE);
        ld = FE; K = DM; o8 = true; src = base + (size_t)(128 * kb) * FE + 128 * pn + 64 * sub; dst = P.ws + OFF_WGU + ((size_t)e * 512 + 64 * nb) * DM + 128 * kb; }
    else { const int q = r - 64, nb = q >> 1, kb = q & 1;
        const float* base = e < NE ? P.w_down_e + ((size_t)l * NE + e) * FE * DM : P.w_down_s + (size_t)l * FE * DM;
        ld = DM; K = FE; o8 = false; src = base + (size_t)(128 * kb) * DM + 64 * nb; dst = P.ws + OFF_WD + (((size_t)e * DM + 64 * nb) * FE + 128 * kb) * 2; }
}
__device__ __forceinline__ void moe_tr_dma(const float* src, int ld, LAS unsigned char* buf, int tid, int wid) {
#pragma unroll
    for (int i = 0; i < 4; ++i) { const int e = tid + 512 * i, kk = e >> 4, n4 = (e & 15) * 4; const float* g = src + (size_t)kk * ld + n4; unsigned keep;
        asm volatile("s_mov_b32 %0, m0\n\ts_mov_b32 m0, %2\n\ts_nop 0\n\tglobal_load_lds_dwordx4 %1, off\n\ts_mov_b32 m0, %0" : "=&s"(keep) : "v"(g), "s"((unsigned)(size_t)(buf + (wid * 64 + 512 * i) * 16)) : "memory"); }
}
__device__ __forceinline__ void prep_moe(const Ptrs& P, int l, LAS unsigned char* lds, int wid, int wg0) {
    const int G = (int)gridDim.x - wg0, me = bid_() - wg0; if (me < 0) return;
    const int tid = hidden_tid(wid); constexpr int NT = 33 * 96;
    const float* src = nullptr; int ld = 0; char* dst = nullptr; int K = 0; bool o8 = false; int cur = 0;
    int t = me; if (t >= NT) return;
    moe_tr_tile(P, l, t, src, ld, dst, K, o8); moe_tr_dma(src, ld, lds, tid, wid);
    for (; t < NT; t += G) {
        asm volatile("s_waitcnt vmcnt(0)" ::: "memory"); __syncthreads();
        char* cdst = dst; const int cK = K; const bool co8 = o8; const LAS float* tile = (const LAS float*)(lds + cur * 32768);
        if (t + G < NT) { moe_tr_tile(P, l, t + G, src, ld, dst, K, o8); moe_tr_dma(src, ld, lds + (cur ^ 1) * 32768, tid, wid); }
#pragma unroll
        for (int i = 0; i < 2; ++i) { const int e = tid + 512 * i, nn = e & 63, kc = (e >> 6) * 8; float v[8];
#pragma unroll
            for (int j = 0; j < 8; ++j) v[j] = tile[(kc + j) * 64 + nn];
            if (co8) *(u32x2*)((u8*)cdst + (size_t)nn * cK + kc) = pk8_fp8(v, W8SC); else *(u32x4*)((bf16_t*)cdst + (size_t)nn * cK + kc) = pk8(v); }
        __syncthreads(); cur ^= 1; }
    asm volatile("s_waitcnt vmcnt(0)" ::: "memory");
}
struct MoeTile { int e, i, gn, r0; };
__device__ __forceinline__ bool moe_tile(const LAS int* base, const LAS int* cnt, int rt, int nMl, MoeTile& t) {
    const int T = base[NE] >> 8;
    if (rt < T) { int e = 0;
        for (int k = 1; k < NE; ++k) e = (base[k] <= rt * 256) ? k : e;
        t.e = e; t.i = rt - (base[e] >> 8); const int rem = cnt[e] - t.i * 256; t.gn = rem < 256 ? rem : 256; t.r0 = rt * 256; return true; }
    const int ts = rt - T; if (ts >= nMl) return false;
    t.e = NE; t.i = ts; t.gn = 256; t.r0 = SLOTS + ts * 256; return true;
}
struct SchedMoe1 { const char* H2; const char* WGU; const LAS int* base; const LAS int* cnt; const int* toklist; const int* idl; int nMl;
    __device__ __forceinline__ bool next(int i, fg::GU& u) const { const int L = i * (int)gridDim.x + bid_(); const int nrt = (base[NE] >> 8) + nMl; if (L >= nrt * 2) return false;
        int rt, pn; fg::tile_order(L, nrt, 2, rt, pn); MoeTile t; moe_tile(base, cnt, rt, nMl, t);
        u.a = H2; u.b = WGU + ((size_t)t.e * 512 + pn * 256) * DM; u.gl = t.e < NE ? toklist + (size_t)t.e * RT + t.i * 256 : idl + t.i * 256; u.gn = t.gn;
        u.kind = t.e; u.r0 = t.r0; u.c0 = pn * 128; u.aux = t.i * 256; return true; } };
struct EpiAct { static constexpr int NST = 8; bf16_t* act; const float* wlist;
    __device__ __forceinline__ void operator()(const f32x4 (&acc)[2][2][4][2], const fg::GU& u, int wr, int wc, int fr, int fq) const {
#pragma unroll
        for (int ai = 0; ai < 2; ++ai)
#pragma unroll
            for (int m = 0; m < 4; ++m) { const int lr = ai * 128 + wr * 64 + m * 16 + fr; const int lc = lr < u.gn ? lr : u.gn - 1;
                const float w = u.kind < NE ? wlist[(size_t)u.kind * RT + u.aux + lc] : 1.f; f32x4 o[2];
#pragma unroll
                for (int n = 0; n < 2; ++n)
#pragma unroll
                    for (int j = 0; j < 4; ++j) { const float g = acc[ai][0][m][n][j] * (1.f / W8SC); o[n][j] = g * fast_sigmoid(g) * (acc[ai][1][m][n][j] * (1.f / W8SC)) * w; }
                *(u32x4*)(act + (size_t)(u.r0 + lr) * FE + u.c0 + wc * 32 + 8 * fq) = pack8(o[0], o[1]); }
    }
};
struct SchedMoe2 { const char* ACT; const char* WD; const LAS int* base; const LAS int* cnt; int nMl;
    __device__ __forceinline__ bool next(int i, fg::GU& u) const { const int L = i * (int)gridDim.x + bid_(); const int nrt = (base[NE] >> 8) + nMl; if (L >= nrt * 4) return false;
        int rt, pn; fg::tile_order(L, nrt, 4, rt, pn); MoeTile t; moe_tile(base, cnt, rt, nMl, t);
        u.a = ACT + (size_t)t.r0 * FE * 2; u.b = WD + ((size_t)t.e * DM + pn * 256) * FE * 2; u.gl = nullptr; u.gn = 256;
        u.kind = t.e; u.r0 = t.e < NE ? t.r0 : t.i * 256; u.c0 = pn * 256; u.aux = 0; return true; } };
constexpr float YSC = 8.f;
__device__ __forceinline__ float y8(float v) { return __builtin_amdgcn_fmed3f(v * YSC, -448.f, 448.f); }
__device__ __forceinline__ u32x2 pack8_fp8(const f32x4& v0, const f32x4& v1) { int a = __builtin_amdgcn_cvt_pk_fp8_f32(y8(v0[0]), y8(v0[1]), 0, false); a = __builtin_amdgcn_cvt_pk_fp8_f32(y8(v0[2]), y8(v0[3]), a, true);
    int b = __builtin_amdgcn_cvt_pk_fp8_f32(y8(v1[0]), y8(v1[1]), 0, false); b = __builtin_amdgcn_cvt_pk_fp8_f32(y8(v1[2]), y8(v1[3]), b, true); return (u32x2){(unsigned)a, (unsigned)b}; }
struct EpiY { static constexpr int NST = 16; u8* y; u8* ys;
    __device__ __forceinline__ void operator()(const f32x4 (&acc)[2][2][4][2], const fg::GU& u, int wr, int wc, int fr, int fq) const {
        u8* o = u.kind < NE ? y : ys;
#pragma unroll
        for (int ai = 0; ai < 2; ++ai)
#pragma unroll
            for (int m = 0; m < 4; ++m) { const int row = u.r0 + ai * 128 + wr * 64 + m * 16 + fr;
#pragma unroll
                for (int bj = 0; bj < 2; ++bj) *(u32x2*)(o + (size_t)row * DM + u.c0 + bj * 128 + wc * 32 + 8 * fq) = pack8_fp8(acc[ai][bj][m][0], acc[ai][bj][m][1]); }
    }
};

__device__ __forceinline__ void ada_phase(const Ptrs& P, float* ldsf, int wid) {
    const int tid = hidden_tid(wid); float* sl = ldsf; float* red = ldsf + 9 * DM;
    for (int e = tid; e < 9 * DM; e += 512) { const int ar = e >> 10, k = e & 1023; const float v = ar < NB ? P.c[ar * DM + k] : P.c_ctx[k]; sl[e] = v * sigmoidf_(v); }
    __syncthreads();
    constexpr int CW = 48, NCH = 6144 / CW;
    for (int ch = bid_(); ch < 2 * NCH; ch += gridDim.x) { const int l = ch / NCH, c0 = (ch % NCH) * CW, cc = tid & 63, kg = tid >> 6; const bool act = cc < CW;
        const float* w = P.w_ada + (size_t)l * DM * 6144 + (size_t)(kg * 128) * 6144 + c0 + (act ? cc : 0); float acc[9];
#pragma unroll
        for (int r = 0; r < 9; ++r) acc[r] = 0.f;
#pragma unroll 1
        for (int k0 = 0; k0 < 128; k0 += 32) { float wv[32];
#pragma unroll
            for (int j = 0; j < 32; ++j) wv[j] = w[(size_t)(k0 + j) * 6144];
#pragma unroll
            for (int j4 = 0; j4 < 8; ++j4)
#pragma unroll
                for (int r = 0; r < 9; ++r) { const f32x4 s4 = *(const f32x4*)(sl + r * DM + kg * 128 + k0 + 4 * j4);
#pragma unroll
                    for (int q = 0; q < 4; ++q) acc[r] += s4[q] * wv[4 * j4 + q]; } }
        if (act) {
#pragma unroll
            for (int r = 0; r < 9; ++r) red[(kg * 9 + r) * 64 + cc] = acc[r]; }
        __syncthreads();
        for (int e = tid; e < 9 * CW; e += 512) { const int r = e / CW, c = e % CW; float s = 0.f;
#pragma unroll
            for (int g = 0; g < 8; ++g) s += red[(g * 9 + r) * 64 + c];
            WSP(float, OFF_ADA)[((size_t)l * 9 + r) * 6144 + c0 + c] = s + P.b_ada[l * 6144 + c0 + c]; }
        __syncthreads(); }
}
__device__ __forceinline__ void misc_prep(const Ptrs& P, int wid) {
    const size_t nthr = (size_t)gridDim.x * 512, gid = (size_t)bid_() * 512 + hidden_tid(wid);
    for (size_t idx = gid; idx < (size_t)SEQ * 16; idx += nthr) { const int n = idx / 16, i = idx % 16; const int r = n / 64, col = n % 64;
        const float inv = powf(10000.f, -(float)(i & 7) / 8.f); const float ang = (float)(i < 8 ? r : col) * inv;
        float* t = WSP(float, OFF_ROPE) + idx * 2; t[0] = (float)cos((double)ang); t[1] = (float)sin((double)ang); }
    for (size_t idx = gid; idx < (size_t)2 * NE * DM; idx += nthr) { const int k = idx & 1023, e = (idx >> 10) & 31, l = idx >> 15; const float w = P.w_router[(size_t)l * DM * NE + (size_t)k * NE + e];
        const bf16_t hi = f2bf(w); const bf16_t lo = f2bf(w - bf2f(hi)); bf16_t* wr = WSP(bf16_t, OFF_WR) + (size_t)l * 2 * NE * DM; wr[e * DM + k] = hi; wr[NE * DM + e * DM + k] = lo; }
}
__device__ __forceinline__ void ld16_f32(const float* p, int lane, float (&v)[16]) {
#pragma unroll
    for (int c = 0; c < 2; ++c) { const f32x4 a = *(const f32x4*)(p + c * 512 + lane * 8), b = *(const f32x4*)(p + c * 512 + lane * 8 + 4);
#pragma unroll
        for (int j = 0; j < 4; ++j) { v[c * 8 + j] = a[j]; v[c * 8 + 4 + j] = b[j]; } } }
__device__ __forceinline__ void ld16_bf16(const bf16_t* p, int lane, float (&v)[16]) {
#pragma unroll
    for (int c = 0; c < 2; ++c) { const u32x4 w = *(const u32x4*)(p + c * 512 + lane * 8);
#pragma unroll
        for (int t = 0; t < 4; ++t) { v[c * 8 + 2 * t] = bflo(w[t]); v[c * 8 + 2 * t + 1] = bfhi(w[t]); } } }
__device__ __forceinline__ void ld16_fp8(const u8* p, int lane, float (&v)[16]) {
#pragma unroll
    for (int c = 0; c < 2; ++c) { const u32x2 w = *(const u32x2*)(p + c * 512 + lane * 8);
#pragma unroll
        for (int t = 0; t < 2; ++t) { const auto lo = __builtin_amdgcn_cvt_pk_f32_fp8((int)w[t], false), hi = __builtin_amdgcn_cvt_pk_f32_fp8((int)w[t], true);
            v[c * 8 + 4 * t] = lo[0]; v[c * 8 + 4 * t + 1] = lo[1]; v[c * 8 + 4 * t + 2] = hi[0]; v[c * 8 + 4 * t + 3] = hi[1]; } } }
__device__ __forceinline__ void st16_f32(float* p, int lane, const float (&v)[16]) {
#pragma unroll
    for (int c = 0; c < 2; ++c) { *(f32x4*)(p + c * 512 + lane * 8) = (f32x4){v[c * 8], v[c * 8 + 1], v[c * 8 + 2], v[c * 8 + 3]}; *(f32x4*)(p + c * 512 + lane * 8 + 4) = (f32x4){v[c * 8 + 4], v[c * 8 + 5], v[c * 8 + 6], v[c * 8 + 7]}; } }
__device__ __forceinline__ void st16_fp8(u8* p, int lane, const float (&v)[16]) {
#pragma unroll
    for (int c = 0; c < 2; ++c) *(u32x2*)(p + c * 512 + lane * 8) = pk8_fp8(v + c * 8, 1.f); }
__device__ __forceinline__ void st16_bf16(bf16_t* p, int lane, const float (&v)[16]) {
#pragma unroll
    for (int c = 0; c < 2; ++c) *(u32x4*)(p + c * 512 + lane * 8) = pk8(v + c * 8); }
__device__ __forceinline__ void normmod0_phase(const Ptrs& P, int wid) {
    const int lane = hidden_tid(wid) & 63; const int stride = (int)gridDim.x * 8;
    float g[16]; ld16_f32(P.g_pre_mix, lane, g);
    for (int rowA = bid_() * 8 + wid; rowA < RT; rowA += 2 * stride) {
        const bool hasB = rowA + stride < RT; const int rows[2] = {rowA, hasB ? rowA + stride : rowA};
        float v[2][16], sh[2][16], sc[2][16];
#pragma unroll
        for (int q = 0; q < 2; ++q) { const int row = rows[q]; const float* src = row < RX ? P.x + (size_t)row * DM : P.ctx + (size_t)(row - RX) * DM;
            const float* ada = WSP(float, OFF_ADA) + (size_t)row_arow(row) * 6144; ld16_f32(src, lane, v[q]); ld16_f32(ada, lane, sh[q]); ld16_f32(ada + 1024, lane, sc[q]); }
#pragma unroll
        for (int q = 0; q < 2; ++q) { float ss = 0.f;
#pragma unroll
            for (int i = 0; i < 16; ++i) ss += v[q][i] * v[q][i];
            ss = wave_sum(ss); const float r = rsqrtf(ss / DM + EPS);
#pragma unroll
            for (int i = 0; i < 16; ++i) v[q][i] = v[q][i] * r * g[i] * (1.f + sc[q][i]) + sh[q][i]; }
#pragma unroll
        for (int q = 0; q < 2; ++q) if (q == 0 || hasB) { st16_bf16(WSP(bf16_t, OFF_H) + (size_t)rows[q] * DM, lane, v[q]); st16_fp8(WSP(u8, OFF_H8) + (size_t)rows[q] * DM, lane, v[q]); } }
}
__device__ __forceinline__ void conv_phase(const Ptrs& P, int l, int nrows, int wid) {
    const size_t nthr = (size_t)gridDim.x * 512, gid = (size_t)bid_() * 512 + hidden_tid(wid);
    const bf16_t* in = WSP(bf16_t, OFF_INNER); const bf16_t* cb = WSP(bf16_t, OFF_CB); bf16_t* out = WSP(bf16_t, OFF_CONV); const float* w = P.conv_w + (size_t)l * 3 * 512;
    for (size_t e = gid; e < (size_t)nrows * 64; e += nthr) { const int row = e >> 6, j = (e & 63) * 8; const bool isx = row < RX; const int len = isx ? SEQ : CTX; const int n = isx ? (row & (SEQ - 1)) : ((row - RX) & (CTX - 1));
        float y[8];
#pragma unroll
        for (int t = 0; t < 8; ++t) y[t] = 0.f;
#pragma unroll
        for (int d = 0; d < 3; ++d) { const int nn = n + d - 1; if (nn >= 0 && nn < len) { const u32x4 iv = *(const u32x4*)(in + (size_t)(row + d - 1) * 512 + j);
                const f32x4 w0 = *(const f32x4*)(w + d * 512 + j), w1 = *(const f32x4*)(w + d * 512 + j + 4);
#pragma unroll
                for (int t = 0; t < 4; ++t) { y[2 * t] += (t < 2 ? w0[2 * t] : w1[2 * t - 4]) * bflo(iv[t]); y[2 * t + 1] += (t < 2 ? w0[2 * t + 1] : w1[2 * t - 3]) * bfhi(iv[t]); } } }
        const u32x4 cv = *(const u32x4*)(cb + (size_t)row * 512 + j); u32x4 o;
#pragma unroll
        for (int t = 0; t < 4; ++t) o[t] = cvt_pk_bf16(bflo(cv[t]) * y[2 * t], bfhi(cv[t]) * y[2 * t + 1]);
        *(u32x4*)(out + (size_t)row * 512 + j) = o; }
}
template <int K> __device__ __forceinline__ int lane_xor_i(int v) { return __builtin_amdgcn_ds_swizzle(v, (K << 10) | 0x1f); }
__device__ __forceinline__ void post_mix_phase(const Ptrs& P, int l, int nrows, LAS unsigned char* lds, int wid) {
    constexpr int TS = 2064;
    const int tid = hidden_tid(wid), lane = tid & 63;
    LAS unsigned char* tHi = lds; LAS unsigned char* tLo = lds + 16 * TS; LAS float* red = (LAS float*)(lds + 32 * TS);
    LAS int* lcount = (LAS int*)(lds + 32 * TS + 16384); LAS int* gbase = lcount + 32; LAS int* pend = lcount + 64;
    if (tid < 64) lcount[tid] = 0;
    __syncthreads();
    int gi = 0;
    const bf16_t* wr = WSP(bf16_t, OFF_WR) + (size_t)l * 2 * NE * DM;
    bf16x8 bh[4][2], bl[4][2];
#pragma unroll
    for (int ks = 0; ks < 4; ++ks)
#pragma unroll
        for (int nt = 0; nt < 2; ++nt) { const size_t off = (size_t)(nt * 16 + (lane & 15)) * DM + wid * 128 + ks * 32 + 8 * (lane >> 4);
            bh[ks][nt] = *(const bf16x8*)(wr + off); bl[ks][nt] = *(const bf16x8*)(wr + (size_t)NE * DM + off); }
    const float* gpm = P.g_post_mix + l * DM; const float* gpf = P.g_pre_ffn + l * DM;
    const float brt = P.b_router[l * NE + (lane & 31)];
    int* cnt = WSP(int, OFF_CNT2) + l * 64; int* tl = WSP(int, OFF_TOKLIST); float* wl = WSP(float, OFF_WLIST);
    float gpmv[16], gpfv[16]; ld16_f32(gpm, lane, gpmv); ld16_f32(gpf, lane, gpfv);
    for (int g = bid_(); g < nrows / 16; g += gridDim.x, ++gi) {
        const int row0 = g * 16 + 2 * wid; const bool isx = row0 < RX;
        const float* ada = WSP(float, OFF_ADA) + ((size_t)l * 9 + row_arow(row0)) * 6144;
        float xv[2][16], yv[2][16], g1[16], sc2[16], sh2[16], ry[2];
        ld16_f32(ada + 2048, lane, g1); ld16_f32(ada + 4096, lane, sc2); ld16_f32(ada + 3072, lane, sh2);
#pragma unroll
        for (int rr = 0; rr < 2; ++rr) { const int row = row0 + rr;
            if (l == 0) ld16_f32(isx ? P.x + (size_t)row * DM : P.ctx + (size_t)(row - RX) * DM, lane, xv[rr]);
            else ld16_bf16(isx ? (const bf16_t*)P.out + (size_t)row * DM : WSP(bf16_t, OFF_CTXRES) + (size_t)(row - RX) * DM, lane, xv[rr]);
            ld16_bf16(WSP(bf16_t, OFF_YX) + (size_t)row * DM, lane, yv[rr]);
            const float* sp = WSP(float, OFF_SSPY) + (size_t)row * 16; const f32x4 s0 = *(const f32x4*)sp, s1 = *(const f32x4*)(sp + 4), s2 = *(const f32x4*)(sp + 8), s3 = *(const f32x4*)(sp + 12); float ssy = 0.f;
#pragma unroll
            for (int i = 0; i < 4; ++i) ssy += s0[i];
#pragma unroll
            for (int i = 0; i < 4; ++i) ssy += s1[i];
#pragma unroll
            for (int i = 0; i < 4; ++i) ssy += s2[i];
#pragma unroll
            for (int i = 0; i < 4; ++i) ssy += s3[i];
            ry[rr] = rsqrtf(ssy / DM + EPS); }
#pragma unroll
        for (int rr = 0; rr < 2; ++rr) { const int rl = 2 * wid + rr, row = row0 + rr; float ss = 0.f;
            bf16_t* dst = l == 1 ? WSP(bf16_t, OFF_X1B) + (size_t)row * DM : isx ? (bf16_t*)P.out + (size_t)row * DM : WSP(bf16_t, OFF_CTXRES) + (size_t)(row - RX) * DM;
#pragma unroll
            for (int i = 0; i < 16; ++i) { xv[rr][i] = xv[rr][i] + g1[i] * (yv[rr][i] * ry[rr] * gpmv[i]); ss += xv[rr][i] * xv[rr][i]; }
            st16_bf16(dst, lane, xv[rr]);
            ss = wave_sum(ss); const float r = rsqrtf(ss / DM + EPS);
            float hl[16];
#pragma unroll
            for (int i = 0; i < 16; ++i) { const float hv = xv[rr][i] * r * gpfv[i] * (1.f + sc2[i]) + sh2[i]; const float hh = bf2f(f2bf(hv)); yv[rr][i] = hh; hl[i] = hv - hh; }
            st16_fp8(WSP(u8, OFF_H) + (size_t)row * DM, lane, yv[rr]);
#pragma unroll
            for (int c = 0; c < 2; ++c) { *(LAS u32x4*)(tHi + rl * TS + (c * 512 + lane * 8) * 2) = pk8(yv[rr] + c * 8); *(LAS u32x4*)(tLo + rl * TS + (c * 512 + lane * 8) * 2) = pk8(hl + c * 8); } }
        __syncthreads();
        f32x4 acc[2] = {(f32x4){0.f, 0.f, 0.f, 0.f}, (f32x4){0.f, 0.f, 0.f, 0.f}};
#pragma unroll
        for (int ks = 0; ks < 4; ++ks) { const int ao = (lane & 15) * TS + (wid * 128 + ks * 32 + 8 * (lane >> 4)) * 2;
            const bf16x8 ah = *(const LAS bf16x8*)(tHi + ao), al = *(const LAS bf16x8*)(tLo + ao);
#pragma unroll
            for (int nt = 0; nt < 2; ++nt) { acc[nt] = __builtin_amdgcn_mfma_f32_16x16x32_bf16(ah, bh[ks][nt], acc[nt], 0, 0, 0);
                acc[nt] = __builtin_amdgcn_mfma_f32_16x16x32_bf16(ah, bl[ks][nt], acc[nt], 0, 0, 0); acc[nt] = __builtin_amdgcn_mfma_f32_16x16x32_bf16(al, bh[ks][nt], acc[nt], 0, 0, 0); } }
#pragma unroll
        for (int nt = 0; nt < 2; ++nt)
#pragma unroll
            for (int j = 0; j < 4; ++j) red[(wid * 16 + 4 * (lane >> 4) + j) * 32 + nt * 16 + (lane & 15)] = acc[nt][j];
        __syncthreads();
        {
            const int e = lane & 31, rl = 2 * wid + (lane >> 5), row = g * 16 + rl; float lg = 0.f;
#pragma unroll
            for (int w = 0; w < 8; ++w) lg += red[(w * 16 + rl) * 32 + e];
            const float sc = sigmoidf_(lg); float key = sc + brt; int sel[TOPK]; float selw[TOPK]; float ssum = 0.f;
#pragma unroll
            for (int j = 0; j < TOPK; ++j) { float bk = key, bs = sc; int bi = e;
#define PM_STEP(KX) { const float ok = lane_xor<KX>(bk), os = lane_xor<KX>(bs); const int oi = lane_xor_i<KX>(bi); const bool take = (ok > bk) || (ok == bk && oi < bi); bk = take ? ok : bk; bs = take ? os : bs; bi = take ? oi : bi; }
                PM_STEP(1) PM_STEP(2) PM_STEP(4) PM_STEP(8) PM_STEP(16)
#undef PM_STEP
                sel[j] = bi; selw[j] = bs; ssum += bs; key = (e == bi) ? -1e30f : key; }
#pragma unroll
            for (int j = 0; j < TOPK; ++j) if (e == sel[j]) { const int lr = __hip_atomic_fetch_add(lcount + e, 1, __ATOMIC_RELAXED, __HIP_MEMORY_SCOPE_WORKGROUP); LAS int* pe = pend + ((gi * 16 + rl) * TOPK + j) * 4;
                pe[0] = e; pe[1] = lr; pe[2] = __float_as_int(selw[j] / ssum * 2.5f); pe[3] = row; } }
        __syncthreads(); }
    if (tid < NE) gbase[tid] = atomicAdd(cnt + tid, lcount[tid]);
    __syncthreads();
    { int* ti = WSP(int, OFF_TOKINFO);
      for (int p = tid; p < gi * 16 * TOPK; p += 512) { const LAS int* pe = pend + p * 4; const int e = pe[0], rank = gbase[e] + pe[1], row = pe[3]; const int j = p & (TOPK - 1);
          tl[(size_t)e * RT + rank] = row; wl[(size_t)e * RT + rank] = __int_as_float(pe[2]); ti[(size_t)row * 8 + 2 * j] = e; ti[(size_t)row * 8 + 2 * j + 1] = rank; } }
    __syncthreads();
}
__device__ __forceinline__ void moe_setup(const Ptrs& P, int l, LAS int* lbase, LAS int* lcnt, int wid) {
    __syncthreads();
    if (hidden_tid(wid) == 0) { const int* cnt = WSP(int, OFF_CNT2) + l * 64; int acc = 0; for (int e = 0; e < NE; ++e) { const int c = cnt[e]; lcnt[e] = c; lbase[e] = acc; acc += (c + 255) / 256 * 256; } lbase[NE] = acc; }
    __syncthreads();
}
__device__ __forceinline__ void acc8_fp8(u32x2 w, float* v) {
#pragma unroll
    for (int t = 0; t < 2; ++t) { const auto lo = __builtin_amdgcn_cvt_pk_f32_fp8((int)w[t], false), hi = __builtin_amdgcn_cvt_pk_f32_fp8((int)w[t], true);
        v[4 * t] += lo[0]; v[4 * t + 1] += lo[1]; v[4 * t + 2] += hi[0]; v[4 * t + 3] += hi[1]; } }
__device__ __forceinline__ void post_moe_phase(const Ptrs& P, int l, int nrows, const LAS int* lbase, int wid) {
    const int lane = hidden_tid(wid) & 63; const int stride = (int)gridDim.x * 8;
    float gp[16]; ld16_f32(P.g_post_ffn + l * DM, lane, gp);
    for (int rowA = bid_() * 8 + wid; rowA < nrows; rowA += 2 * stride) {
        const bool hasB = rowA + stride < nrows; int rows[2] = {rowA, hasB ? rowA + stride : rowA};
        u32x2 yr[2][5][2]; float xv[2][16], g2[2][16]; bf16_t* xr[2]; const float* ada[2];
#pragma unroll
        for (int q = 0; q < 2; ++q) { const int row = rows[q]; const bool isx = row < RX; xr[q] = l == 1 ? WSP(bf16_t, OFF_X1B) + (size_t)row * DM : isx ? (bf16_t*)P.out + (size_t)row * DM : WSP(bf16_t, OFF_CTXRES) + (size_t)(row - RX) * DM;
            ada[q] = WSP(float, OFF_ADA) + ((size_t)l * 9 + row_arow(row)) * 6144;
            const int* ti = WSP(int, OFF_TOKINFO) + (size_t)row * 8; const u8* Y = WSP(u8, OFF_Y);
            const u32x4 ta = *(const u32x4*)ti, tb = *(const u32x4*)(ti + 4);
            const int sl[4] = {lbase[ta[0]] + (int)ta[1], lbase[ta[2]] + (int)ta[3], lbase[tb[0]] + (int)tb[1], lbase[tb[2]] + (int)tb[3]};
            const u8* ys = WSP(u8, OFF_YS) + (size_t)row * DM;
#pragma unroll
            for (int c = 0; c < 2; ++c) { yr[q][0][c] = *(const u32x2*)(ys + c * 512 + lane * 8);
#pragma unroll
                for (int j = 0; j < 4; ++j) yr[q][1 + j][c] = *(const u32x2*)(Y + (size_t)sl[j] * DM + c * 512 + lane * 8); }
            ld16_bf16(xr[q], lane, xv[q]);
            ld16_f32(ada[q] + 5120, lane, g2[q]); }
        float v[2][16], r[2], ss2[2];
#pragma unroll
        for (int q = 0; q < 2; ++q) { float ss = 0.f;
#pragma unroll
            for (int i = 0; i < 16; ++i) v[q][i] = 0.f;
#pragma unroll
            for (int j = 0; j < 5; ++j)
#pragma unroll
                for (int c = 0; c < 2; ++c) acc8_fp8(yr[q][j][c], v[q] + c * 8);
#pragma unroll
            for (int i = 0; i < 16; ++i) { v[q][i] *= (1.f / YSC); ss += v[q][i] * v[q][i]; }
            ss = wave_sum(ss); r[q] = rsqrtf(ss / DM + EPS); ss2[q] = 0.f;
#pragma unroll
            for (int i = 0; i < 16; ++i) { v[q][i] = xv[q][i] + g2[q][i] * (v[q][i] * r[q] * gp[i]); ss2[q] += v[q][i] * v[q][i]; } }
#pragma unroll
        for (int q = 0; q < 2; ++q) if (q == 0 || hasB) { if (l == 1) st16_f32(P.out + (size_t)rows[q] * DM, lane, v[q]); else st16_bf16(xr[q], lane, v[q]);
            if (l == 0) { const float s2 = wave_sum(ss2[q]); const float r2 = rsqrtf(s2 / DM + EPS); const float* ada1 = ada[q] + 9 * 6144; float t0[16], t1[16], t2[16];
                ld16_f32(P.g_pre_mix + DM, lane, t0); ld16_f32(ada1 + 1024, lane, t1); ld16_f32(ada1, lane, t2);
#pragma unroll
                for (int i = 0; i < 16; ++i) v[q][i] = v[q][i] * r2 * t0[i] * (1.f + t1[i]) + t2[i];
                st16_bf16(WSP(bf16_t, OFF_H) + (size_t)rows[q] * DM, lane, v[q]); st16_fp8(WSP(u8, OFF_H8) + (size_t)rows[q] * DM, lane, v[q]); } }
    }
}

#define XB_TMO      128
#define XB_XCNT(j)  (256  + 64 * (j))
#define XB_XSUB(j)  (1280 + 64 * (j))
#define XB_XGEN(j)  (2304 + 64 * (j))
#define XB_TOP      3328
#define XB_TOPGEN   3392
#define XCD_BAR_WORDS 3456
#define XB_SPIN_CAP (1u << 18)
#define LAS __attribute__((address_space(3)))

__device__ __forceinline__ unsigned xb_ld(unsigned* p)              { return __hip_atomic_load(p, __ATOMIC_RELAXED, __HIP_MEMORY_SCOPE_AGENT); }
__device__ __forceinline__ unsigned xb_add(unsigned* p, unsigned v) { return __hip_atomic_fetch_add(p, v, __ATOMIC_RELAXED, __HIP_MEMORY_SCOPE_AGENT); }
__device__ __forceinline__ unsigned xb_xcc_id() { return (unsigned)__builtin_amdgcn_s_getreg((3 << 11) | 20) & 0xFu; }
#define XB_SPIN(cond, bar) do { unsigned _sp = 0; while (cond) { __builtin_amdgcn_s_sleep(1); \
    if ((++_sp & 255u) == 0u) { if (xb_ld(&(bar)[XB_TMO])) break; if (_sp > XB_SPIN_CAP) { atomicAdd(&(bar)[XB_TMO], 1u); break; } } } } while (0)

struct XcdBarrier {
    int wid;
    unsigned* bar; unsigned x;
    volatile LAS unsigned* st;
};

__device__ __forceinline__ XcdBarrier xcd_barrier_post(unsigned* bar, volatile LAS unsigned* st) {
    XcdBarrier b; b.wid = uni((int)threadIdx.x >> 6); b.bar = bar; b.x = xb_xcc_id(); b.st = st;
    if (b.wid == 0 && hidden_lane() == 0) (void)xb_add(&bar[XB_XCNT(b.x)], 1u);
    return b;
}
__device__ __forceinline__ void xcd_barrier_complete(unsigned* bar, unsigned x, unsigned& nloc, unsigned& nx) {
    const unsigned G = gridDim.x * gridDim.y * gridDim.z;
    unsigned sum, cnt, mine, sp = 0u;
    for (;;) {
        sum = 0u; cnt = 0u; mine = 0u;
#pragma unroll
        for (unsigned j = 0; j < 16; ++j) { const unsigned c = xb_ld(&bar[XB_XCNT(j)]); sum += c; cnt += (c > 0u) ? 1u : 0u; mine = (j == x) ? c : mine; }
        if (sum == G) break;
        __builtin_amdgcn_s_sleep(1);
        if ((++sp & 255u) == 0u) { if (xb_ld(&bar[XB_TMO])) break; if (sp > XB_SPIN_CAP) { atomicAdd(&bar[XB_TMO], 1u); break; } }
    }
    nloc = mine > 0u ? mine : 1u; nx = cnt > 0u ? cnt : 1u;
}

__device__ __forceinline__ void xcd_barrier(const XcdBarrier& b) {
    asm volatile("s_waitcnt vmcnt(0)" ::: "memory");
    __syncthreads();
    if (b.wid == 0 && hidden_lane() == 0) {
        unsigned* bar = b.bar;
        __builtin_amdgcn_s_waitcnt(0);
        unsigned nloc = b.st[0], nx = b.st[1];
        if (nloc == 0u) { xcd_barrier_complete(bar, b.x, nloc, nx); b.st[0] = nloc; b.st[1] = nx; }
        const unsigned old = xb_add(&bar[XB_XSUB(b.x)], 1u);
        const unsigned gen = old / nloc;
        if (old + 1u == (gen + 1u) * nloc) {
            __builtin_amdgcn_fence(__ATOMIC_RELEASE, "agent");
            asm volatile("s_waitcnt vmcnt(0)" ::: "memory");
            const unsigned og = xb_add(&bar[XB_TOP], 1u);
            const unsigned tg = og / nx;
            if (og + 1u == (tg + 1u) * nx) xb_add(&bar[XB_TOPGEN], 1u);
            else XB_SPIN(xb_ld(&bar[XB_TOPGEN]) == tg, bar);
            __builtin_amdgcn_fence(__ATOMIC_ACQUIRE, "agent");
            xb_add(&bar[XB_XGEN(b.x)], 1u);
            asm volatile("s_waitcnt vmcnt(0)" ::: "memory");
        } else {
            XB_SPIN(xb_ld(&bar[XB_XGEN(b.x)]) == gen, bar);
            __builtin_amdgcn_fence(__ATOMIC_ACQUIRE, "agent");
            asm volatile("s_waitcnt vmcnt(0)" ::: "memory");
        }
    }
    __syncthreads();
}

constexpr int N_PHASES = 20;
constexpr int MISC_OFF = fg::STAGE_BYTES;
constexpr int MK_LDS = fg::STAGE_BYTES + 1024 + 16384;
__global__ void __launch_bounds__(512, 2) mk_fwd(Args a) {
    extern __shared__ __attribute__((aligned(16))) unsigned char lds_raw[];
    LAS unsigned char* lds = (LAS unsigned char*)lds_raw;
    const Ptrs& P = a.P; const int lo = a.ph_lo, hi = a.ph_hi;
    const int wid_s = __builtin_amdgcn_readfirstlane((int)threadIdx.x >> 6);
    { const int t0 = hidden_tid(wid_s); if (t0 < 4) ((LAS unsigned*)(lds + MISC_OFF))[t0] = 0u; }
    __syncthreads();
    XcdBarrier bar; bar.wid = wid_s; bar.bar = WSP(unsigned, OFF_CTL); bar.x = 0; bar.st = nullptr;
    if (hi - lo > 1) bar = xcd_barrier_post(WSP(unsigned, OFF_CTL), (volatile LAS unsigned*)(lds + MISC_OFF));
#define IN(k) (lo <= (k) && (k) < hi)
#define SEAM(k) do { if (IN(k) && IN((k) + 1)) { XcdBarrier _b = bar; asm volatile("" : "+s"(_b.bar), "+s"(_b.x)); xcd_barrier(_b); } } while (0)
#define PHASE_P(Q) Ptrs Q = P; { char* _w = Q.ws; asm volatile("" : "+s"(_w)); Q.ws = _w; } LAS unsigned char* ldq = lds; asm volatile("" : "+s"(ldq)); int wq = wid_s; asm volatile("" : "+s"(wq)); \
    char* const ldg = (char*)ldq; LAS int* const lbase = (LAS int*)(ldq + MISC_OFF + 64); LAS int* const lcnt = (LAS int*)(ldq + MISC_OFF + 256); (void)ldg; (void)lbase; (void)lcnt
    if (IN(0)) { PHASE_P(Q); int tbase = 0; prep_mix(Q, 0, (float*)ldg, tbase, wq); prep_wz(Q, 0, (float*)ldg, tbase, wq); prep_dft(Q, wq);
        misc_prep(Q, wq); ada_phase(Q, (float*)ldg, wq); }
    SEAM(0);
    if (IN(1)) { PHASE_P(Q); normmod0_phase(Q, wq); }
    SEAM(1);
    for (int l = 0; l < 2; ++l) {
        const int pb = 2 + 9 * l; const int nMl = (l == 0 ? RT : RX) / 256, Rl = l == 0 ? RT : RX;
        if (IN(pb + 0)) { PHASE_P(Q); char* wm = Q.ws + OFF_WMIX + (size_t)l * WMIX_BYTES; EpiProj E{Q, l};
            { SchedW1 S{Q.ws + OFF_H, wm + WMIX_W1, l}; fg::gemm_phase<SchedW1, EpiProj, 0>(ldq, DM, S, E, wq); }
            { SchedGate S{Q.ws + OFF_H8, Q.ws + OFF_W1G8 + (size_t)l * 3072 * 1024, l}; EpiGate EG{Q, l}; fg::gemm_phase<SchedGate, EpiGate, 0, 0, true>(ldq, DM, S, EG, wq); }
            { SchedZx S{Q.ws + OFF_H8, wm + WMIX_WZ}; EpiZ EZ{Q}; fg::gemm_phase<SchedZx, EpiZ, 0, 1, true>(ldq, DM, S, EZ, wq); }
            if (l == 0) { SchedZc S{Q.ws + OFF_H8, wm + WMIX_WZ}; EpiZ EZ{Q}; fg::gemm_phase<SchedZc, EpiZ, 0, 0, true>(ldq, DM, S, EZ, wq); } }
        SEAM(pb + 0);
        if (IN(pb + 1)) { PHASE_P(Q); char* wm = Q.ws + OFF_WMIX + (size_t)l * WMIX_BYTES;
            { SchedPlainShift S{Q.ws + OFF_CKV, wm + WMIX_WUKV, RT / 256, 4, KV_RANK, 0}; EpiUKV E{Q}; fg::gemm_phase<SchedPlainShift, EpiUKV, 0>(ldq, KV_RANK, S, E, wq); }
            { SchedPlainShift S{Q.ws + OFF_CQ, wm + WMIX_WUQ, nMl, 3, Q_RANK, 32}; EpiUQ E{Q}; fg::gemm_phase<SchedPlainShift, EpiUQ, 0>(ldq, Q_RANK, S, E, wq); }
            { SchedFftA S{Q.ws + OFF_ZA, Q.ws + OFF_MA}; EpiFftA E{Q}; fg::gemm_phase<SchedFftA, EpiFftA, 0, 2>(ldq, 128, S, E, wq); }
            conv_phase(Q, l, Rl, wq); }
        SEAM(pb + 1);
        if (IN(pb + 2)) { PHASE_P(Q);
            { SchedFftB S{Q.ws + OFF_ZB, Q.ws + OFF_MB}; EpiFftB E{(bf16_t*)(Q.ws + OFF_FOUR)}; fg::gemm_phase<SchedFftB, EpiFftB, 0>(ldq, 128, S, E, wq); }
            if (l == 0) { SchedF2c S{Q.ws + OFF_TC, Q.ws + OFF_ZTC}; EpiBf16 E{(bf16_t*)(Q.ws + OFF_FOUR), FW}; fg::gemm_phase<SchedF2c, EpiBf16, 0>(ldq, 2 * CTX, S, E, wq); }
            attn_phase(Q, l, ldg, wq); }
        SEAM(pb + 2);
        if (IN(pb + 3)) { PHASE_P(Q); char* wm = Q.ws + OFF_WMIX + (size_t)l * WMIX_BYTES;
            SchedMerge S{Q.ws + OFF_ATT, Q.ws + OFF_CONV, Q.ws + OFF_FOUR, wm + WMIX_WA, nMl}; EpiMerge E{(bf16_t*)(Q.ws + OFF_MERGED), (const u8*)(Q.ws + OFF_GATES)};
            fg::gemm_phase<SchedMerge, EpiMerge, 0, 0, false, true>(ldq, 1536, S, E, wq);
            if (l == 0) { int tbase = 0; prep_mix(Q, 1, (float*)ldg, tbase, wq, 32); prep_wz(Q, 1, (float*)ldg, tbase, wq, 32); } }
        SEAM(pb + 3);
        if (IN(pb + 4)) { PHASE_P(Q); char* wm = Q.ws + OFF_WMIX + (size_t)l * WMIX_BYTES;
            SchedPlain S{Q.ws + OFF_MERGED, wm + WMIX_WO, nMl, 4, DM}; EpiYX E{(bf16_t*)(Q.ws + OFF_YX), (float*)(Q.ws + OFF_SSPY)}; fg::gemm_phase<SchedPlain, EpiYX, 0>(ldq, DM, S, E, wq);
            prep_moe(Q, l, ldq, wq, l == 0 ? 32 : 0); }
        SEAM(pb + 4);
        if (IN(pb + 5)) { PHASE_P(Q); post_mix_phase(Q, l, Rl, ldq, wq); }
        SEAM(pb + 5);
        if (IN(pb + 6)) { PHASE_P(Q); moe_setup(Q, l, lbase, lcnt, wq);
            SchedMoe1 S{Q.ws + OFF_H, Q.ws + OFF_WGU, lbase, lcnt, (const int*)(Q.ws + OFF_TOKLIST), (const int*)(Q.ws + OFF_IDL), nMl}; EpiAct E{(bf16_t*)(Q.ws + OFF_ACT), (const float*)(Q.ws + OFF_WLIST)};
            fg::gemm_phase<SchedMoe1, EpiAct, 1, 0, true>(ldq, DM, S, E, wq); }
        SEAM(pb + 6);
        if (IN(pb + 7)) { PHASE_P(Q); moe_setup(Q, l, lbase, lcnt, wq);
            SchedMoe2 S{Q.ws + OFF_ACT, Q.ws + OFF_WD, lbase, lcnt, nMl}; EpiY E{(u8*)(Q.ws + OFF_Y), (u8*)(Q.ws + OFF_YS)}; fg::gemm_phase<SchedMoe2, EpiY, 0>(ldq, FE, S, E, wq); }
        SEAM(pb + 7);
        if (IN(pb + 8)) { PHASE_P(Q); moe_setup(Q, l, lbase, lcnt, wq); post_moe_phase(Q, l, Rl, lbase, wq); }
        if (l == 0) SEAM(pb + 8);
    }
#undef PHASE_P
#undef IN
#undef SEAM
}

#ifndef MK_N_LAUNCHES
#define MK_N_LAUNCHES 1
#endif
extern "C" void kernel_launch(void* const* d_in, const int* in_sizes, int n_in, void* d_out, int out_size, void* d_ws, size_t ws_size, hipStream_t stream) {
    static int ready = 0;
    if (ready == 0) {
        if (n_in != 29 || out_size != RX * DM || ws_size < OFF_END_MIX) { fprintf(stderr, "kernel_launch: unexpected shapes (n_in %d out %d ws %zu need %zu)\n", n_in, out_size, ws_size, (size_t)OFF_END_MIX); ready = -1; return; }
        if (hipFuncSetAttribute((const void*)mk_fwd, hipFuncAttributeMaxDynamicSharedMemorySize, MK_LDS) != hipSuccess) { fprintf(stderr, "kernel_launch: hipFuncSetAttribute failed\n"); ready = -1; return; }
        int dev = 0, cus = 0, per_cu = 0;
        if (hipGetDevice(&dev) != hipSuccess || hipDeviceGetAttribute(&cus, hipDeviceAttributeMultiprocessorCount, dev) != hipSuccess) { ready = -1; return; }
        if (hipOccupancyMaxActiveBlocksPerMultiprocessor(&per_cu, (const void*)mk_fwd, 512, MK_LDS) != hipSuccess || per_cu < 1) { fprintf(stderr, "kernel_launch: occupancy query says %d blocks per CU\n", per_cu); }
        (void)hipGetLastError();
        if (cus != 256) fprintf(stderr, "kernel_launch: %d CUs (built for 256)\n", cus);
        ready = 1;
    }
    if (ready < 0) return;
    Ptrs P{};
    const float** pp = (const float**)&P; for (int i = 0; i < 29; ++i) pp[i] = (const float*)d_in[i];
    P.out = (float*)d_out; P.ws = (char*)d_ws;
    if (hipMemsetAsync((char*)d_ws + OFF_CTL, 0, CTL_BYTES, stream) != hipSuccess) { fprintf(stderr, "kernel_launch: memset failed\n"); return; }
    Args a{}; a.P = P;
    if (MK_N_LAUNCHES == 1) { a.ph_lo = 0; a.ph_hi = N_PHASES; hipLaunchKernelGGL(mk_fwd, dim3(256), dim3(512), MK_LDS, stream, a); }
    else for (int p = 0; p < N_PHASES; ++p) { a.ph_lo = p; a.ph_hi = p + 1; hipLaunchKernelGGL(mk_fwd, dim3(256), dim3(512), MK_LDS, stream, a); }
    const hipError_t le = hipPeekAtLastError(); if (le != hipSuccess) fprintf(stderr, "kernel_launch: launch failed: %s\n", hipGetErrorName(le));
}
```

```cpp
#include <hip/hip_runtime.h>
#include <stdint.h>
#include <stdio.h>

typedef unsigned short bf16_t;
typedef unsigned char u8;

constexpr int DM = 1024, NB = 8, SEQ = 2048, CTX = 256, NH = 8;
constexpr int RX = NB * SEQ, RC = NB * CTX, RT = RX + RC;
constexpr int QK_NOPE = 64, QK_ROPE = 32, V_DIM = 64, Q_RANK = 384, KV_RANK = 256, QK_DIM = 96;
constexpr int CONVW = 512, FW = 512, NE = 32, TOPK = 4, FE = 256;
constexpr int KV_END = 288, Q_END = 672, CB_END = 1184, CC_END = 1696, CX_END = 2208, FOUR_END = 2720, PROJ_W = 5792;
constexpr float EPS = 1e-6f;
constexpr float QSCALE = 0.10206207261596575f * 1.4426950408889634f;
constexpr int SLOTS = 73728 + 32 * 256;

__device__ __forceinline__ bf16_t f2bf(float f) { unsigned u = __float_as_uint(f); u += 0x7FFFu + ((u >> 16) & 1u); return (bf16_t)(u >> 16); }
__device__ __forceinline__ float bf2f(bf16_t b) { return __uint_as_float(((unsigned)b) << 16); }
__device__ __forceinline__ float sigmoidf_(float x) { return 1.f / (1.f + __expf(-x)); }
template <int K> __device__ __forceinline__ float lane_xor(float v) { return __int_as_float(__builtin_amdgcn_ds_swizzle(__float_as_int(v), (K << 10) | 0x1f)); }
__device__ __forceinline__ float lane_xor32_sum(float v) { auto rr = __builtin_amdgcn_permlane32_swap(__float_as_uint(v), __float_as_uint(v), false, false); return __uint_as_float(rr[0]) + __uint_as_float(rr[1]); }
__device__ __forceinline__ float lane_xor32_max(float v) { auto rr = __builtin_amdgcn_permlane32_swap(__float_as_uint(v), __float_as_uint(v), false, false); return fmaxf(__uint_as_float(rr[0]), __uint_as_float(rr[1])); }
__device__ __forceinline__ float wave_sum(float v) { v += lane_xor<1>(v); v += lane_xor<2>(v); v += lane_xor<4>(v); v += lane_xor<8>(v); v += lane_xor<16>(v); return lane_xor32_sum(v); }
__device__ __forceinline__ float wave_max(float v) { v = fmaxf(v, lane_xor<1>(v)); v = fmaxf(v, lane_xor<2>(v)); v = fmaxf(v, lane_xor<4>(v)); v = fmaxf(v, lane_xor<8>(v)); v = fmaxf(v, lane_xor<16>(v)); return lane_xor32_max(v); }
__device__ __forceinline__ int row_arow(int row) { return row < RX ? row / SEQ : NB; }
__device__ __forceinline__ int pe_pos(int half, int i) { return 8 * (i >> 2) + 4 * half + (i & 3); }

constexpr size_t al256(size_t x) { return (x + 255) / 256 * 256; }
constexpr size_t OFF_ADA = 0;
constexpr size_t OFF_ROPE = OFF_ADA + al256(2 * 9 * 6144 * 4);
constexpr size_t OFF_CTXRES = OFF_ROPE + al256(2048 * 16 * 2 * 4);
constexpr size_t OFF_SS = OFF_CTXRES + al256((size_t)RC * DM * 4);
constexpr size_t OFF_CNT = OFF_SS + al256((size_t)3 * RT * 4);
constexpr size_t OFF_BASE = OFF_CNT + 256;
constexpr size_t OFF_TOKLIST = OFF_BASE + 256;
constexpr size_t OFF_WLIST = OFF_TOKLIST + al256((size_t)NE * RT * 4);
constexpr size_t OFF_TOKINFO = OFF_WLIST + al256((size_t)NE * RT * 4);
constexpr size_t OFF_PERSIST_END = OFF_TOKINFO + al256((size_t)RT * 4 * 8);
constexpr size_t WMIX_W1 = 0;
constexpr size_t WMIX_WZ = WMIX_W1 + (size_t)2304 * 1024 * 2;
constexpr size_t WMIX_WUKV = WMIX_WZ + (size_t)1024 * 1024 * 2;
constexpr size_t WMIX_WUQ = WMIX_WUKV + (size_t)1024 * 256 * 2;
constexpr size_t WMIX_WA = WMIX_WUQ + (size_t)768 * 384 * 2;
constexpr size_t WMIX_WO = WMIX_WA + (size_t)3 * 1024 * 512 * 2;
constexpr size_t WMIX_BYTES = WMIX_WO + (size_t)1024 * 1024 * 2;
constexpr size_t OFF_WMIX = OFF_PERSIST_END;
constexpr size_t OFF_MA = OFF_WMIX + 2 * WMIX_BYTES;
constexpr size_t OFF_MB = OFF_MA + 256 * 128 * 2;
constexpr size_t OFF_TW = OFF_MB + 256 * 128 * 2;
constexpr size_t OFF_W1G8 = OFF_TW + 32 * 64 * 2 * 4;
constexpr size_t OFF_H8 = OFF_W1G8 + (size_t)2 * 3072 * 1024;
constexpr size_t OFF_TC = OFF_H8 + (size_t)RT * DM;
constexpr size_t OFF_SSP = OFF_TC + (size_t)256 * 512 * 2;
constexpr size_t OFF_SSPQ = OFF_SSP + (size_t)RT * 4 * 4;
constexpr size_t OFF_SSPY = OFF_SSPQ + (size_t)RT * 8 * 4;
constexpr size_t OFF_IDL = OFF_SSPY + (size_t)RT * 16 * 4;
constexpr size_t OFF_WR = OFF_IDL + (size_t)RT * 4;
constexpr size_t OFF_CTL = OFF_WR + (size_t)2 * 2 * NE * DM * 2;
constexpr size_t CTL_BYTES = 16384;
constexpr size_t OFF_CNT2 = OFF_CTL + 14336;
constexpr size_t OFF_FAST_END = OFF_CTL + CTL_BYTES;
constexpr size_t OFF_H = al256(OFF_FAST_END);
constexpr size_t OFF_CKV = OFF_H + al256((size_t)RT * DM * 2);
constexpr size_t OFF_CQ = OFF_CKV + al256((size_t)RT * 256 * 2);
constexpr size_t OFF_CB = OFF_CQ + al256((size_t)RT * 384 * 2);
constexpr size_t OFF_INNER = OFF_CB + al256((size_t)RT * 512 * 2);
constexpr size_t OFF_GATES = OFF_INNER + al256((size_t)RT * 512 * 2);
constexpr size_t OFF_ZT = OFF_GATES + al256((size_t)RT * 3072);
constexpr size_t OFF_ZTC = OFF_ZT + (size_t)NB * 512 * 4096 * 2;
constexpr size_t OFF_K = OFF_ZT + al256((size_t)RT * DM * 2);
constexpr size_t OFF_V = OFF_K + al256((size_t)RT * 768 * 2);
constexpr size_t OFF_Q = OFF_V + al256((size_t)RT * 512 * 2);
constexpr size_t OFF_ATT = OFF_Q + al256((size_t)RT * 768 * 2);
constexpr size_t OFF_CONV = OFF_ATT + al256((size_t)RT * 512 * 2);
constexpr size_t OFF_FOUR = OFF_CONV + al256((size_t)RT * 512 * 2);
constexpr size_t OFF_END_MIX = OFF_FOUR + al256((size_t)RT * 512 * 2);
constexpr size_t OFF_ZA = OFF_ZT;
constexpr size_t OFF_ZB = OFF_H;
constexpr size_t OFF_X1B = OFF_WMIX;
static_assert(OFF_X1B + (size_t)RX * DM * 2 <= OFF_TC, "X1B must stay inside the dead weight area");
constexpr size_t OFF_YX = OFF_ZT;
constexpr size_t OFF_MERGED = OFF_K;
constexpr size_t OFF_U32 = OFF_ATT;
constexpr size_t OFF_ACT = OFF_CKV;
constexpr size_t OFF_ACTS = OFF_ACT + al256((size_t)SLOTS * 256 * 2);
constexpr size_t OFF_Y = OFF_ACTS + al256((size_t)RT * 256 * 2);
constexpr size_t OFF_YS = OFF_Y + (size_t)SLOTS * DM;
constexpr size_t OFF_END_MOE = OFF_Y + al256((size_t)SLOTS * DM * 2);
static_assert(OFF_END_MOE <= OFF_ATT, "MoE buffers must stay inside regions A+B");
static_assert(OFF_MERGED + (size_t)RT * DM * 2 <= OFF_Q, "MERGED must fit over K,V");
static_assert(OFF_END_MIX < 406000000ull, "workspace too large");

struct Ptrs {
    const float *x, *c, *ctx, *c_ctx, *w_ada, *b_ada, *g_pre_mix, *g_post_mix, *g_pre_ffn, *g_post_ffn, *w_in, *b_gate, *g_q, *w_uq, *g_kv, *w_ukv,
        *w_mla_out, *conv_w, *w_conv_out, *w_four_out, *w_out, *w_router, *b_router, *w_gate_e, *w_up_e, *w_down_e, *w_gate_s, *w_up_s, *w_down_s;
    float* out; char* ws;
};
#define WSP(T, off) ((T*)(P.ws + (off)))

#define LAS __attribute__((address_space(3)))
__device__ __forceinline__ int bid_() { int b = blockIdx.x; asm volatile("" : "+s"(b)); return b; }
typedef short bf16x8 __attribute__((ext_vector_type(8)));
typedef float f32x4 __attribute__((ext_vector_type(4)));
typedef unsigned u32x4 __attribute__((ext_vector_type(4)));
typedef unsigned u32x2 __attribute__((ext_vector_type(2)));
__device__ __forceinline__ unsigned cvt_pk_bf16(float lo, float hi) { unsigned r; asm volatile("v_cvt_pk_bf16_f32 %0, %1, %2" : "=v"(r) : "v"(lo), "v"(hi)); return r; }
__device__ __forceinline__ float bflo(unsigned w) { return __uint_as_float(w << 16); }
__device__ __forceinline__ float bfhi(unsigned w) { return __uint_as_float(w & 0xffff0000u); }

__device__ __forceinline__ int lane_id() { return (int)__builtin_amdgcn_mbcnt_hi(~0u, __builtin_amdgcn_mbcnt_lo(~0u, 0u)); }
__device__ __forceinline__ int uni(int v) { return __builtin_amdgcn_readfirstlane(v); }
__device__ __forceinline__ int hidden_lane() { int lane; asm volatile("v_mbcnt_lo_u32_b32 %0, -1, 0\n\tv_mbcnt_hi_u32_b32 %0, -1, %0" : "=v"(lane)); return lane; }
__device__ __forceinline__ int hidden_tid(int wid) { return wid * 64 + hidden_lane(); }
template <class T> __device__ __forceinline__ T* uni_ptr(T* p) { const unsigned long long v = (unsigned long long)p; const unsigned lo = __builtin_amdgcn_readfirstlane((unsigned)v), hi = __builtin_amdgcn_readfirstlane((unsigned)(v >> 32));
    return (T*)(((unsigned long long)hi << 32) | lo); }
namespace fg {
constexpr int BM = 256, BK = 64, HALF = 128, HTB = HALF * BK * 2, STAGE_BYTES = 8 * HTB, NXCD = 8, WGM = 8;
__host__ __device__ __forceinline__ int lds_byte(int r, int c) { const int st = (r >> 4) * 2 + (c >> 5), rr = r & 15, cc = c & 31, ob = rr * 64 + cc * 2; return st * 1024 + (ob ^ (((ob >> 9) & 1) << 5)); }
__host__ __device__ __forceinline__ void stage_rc(int b, int& R, int& C) { const int st = b / 1024, sb = b % 1024, swz = sb ^ (((sb >> 9) & 1) << 5); R = (st >> 1) * 16 + swz / 64; C = (st & 1) * 32 + (swz % 64) / 2; }
__host__ __device__ __forceinline__ int perm32(int rho) { const int n = rho >> 4, i = rho & 15; return 8 * (i >> 2) + 4 * n + (i & 3); }

struct GU { const char* a; const char* b; const int* gl; int kind, r0, c0, aux, gn; const char* a1; const char* a2; };

__device__ __forceinline__ void tile_order(int L, int nM, int nN, int& pm, int& pn) {
    const int nwg = nM * nN; int wgid = L; { const int q = nwg / NXCD, r = nwg % NXCD, xcd = wgid % NXCD, off = wgid / NXCD; wgid = (xcd < r ? xcd * (q + 1) : r * (q + 1) + (xcd - r) * q) + off; }
    const int nig = WGM * nN, gid = wgid / nig, fm = gid * WGM, gsz = (nM - fm) < WGM ? (nM - fm) : WGM;
    pm = fm + ((wgid % nig) % gsz); pn = (wgid % nig) / gsz;
}

typedef int v8i32 __attribute__((ext_vector_type(8)));
typedef int v4i32 __attribute__((ext_vector_type(4)));
template <class Sched, class Epi, int AM, int BM = 0, bool F8 = false, bool SEG = false>
__device__ __forceinline__ void gemm_phase(LAS unsigned char* lds, const int K, const Sched& S, const Epi& E, const int wid) {
    const int lane = hidden_lane();
    const int tid = wid * 64 + lane, wr = wid >> 2, wc = wid & 3, fr = lane & 15, fq = lane >> 4;
    constexpr bool GATHER = (AM == 1); constexpr int EB = F8 ? 1 : 2;
    constexpr int UNR = F8 ? 1 : 4;
    const int nt = K * EB / (BK * 2); const int KR = SEG ? K / 3 : K;
    unsigned voffA[2], voffB[2];
#pragma unroll
    for (int i = 0; i < 2; ++i) { int R, C; stage_rc(tid * 16 + i * 8192, R, C); const int Rb = (R & ~31) + perm32(R & 31);
        voffA[i] = AM == 2 ? (unsigned)(((R & 31) * 512 + (R >> 5)) * 256 + C * 2) : (unsigned)(R * KR * EB + C * 2);
        voffB[i] = BM == 1 ? (unsigned)(((Rb >> 6) + 32 * (Rb & 63)) * K * EB + C * 2) : (BM == 2 ? (unsigned)(((Rb & 31) * 512 + (Rb >> 5)) * 256 + C * 2) : (unsigned)(Rb * KR * EB + C * 2)); }
    const size_t kstep = (size_t)(BK * 2);
    const size_t hstepA = AM == 2 ? (size_t)1024 : (size_t)HALF * KR * EB;
    const size_t hstep = BM == 1 ? (size_t)2 * K * EB : (BM == 2 ? (size_t)1024 : (size_t)HALF * KR * EB);
    const unsigned ldsw = (unsigned)wid * 1024u;
    const int aoff = lds_byte(wr * 64 + fr, fq * 8), boff = lds_byte(wc * 32 + fr, fq * 8);
#define FG_SA(b, h) (((b) * 2 + (h)) * HTB)
#define FG_SB(b, h) ((4 + (b) * 2 + (h)) * HTB)
#define FG_STAGE(bufoff, gbase, voff) do { _Pragma("unroll") for (int _i = 0; _i < 2; ++_i) { unsigned _keep; \
        asm volatile("s_mov_b32 %0, m0\n\ts_mov_b32 m0, %3\n\ts_nop 0\n\tglobal_load_lds_dwordx4 %1, %2\n\ts_mov_b32 m0, %0" : "=&s"(_keep) : "v"((voff)[_i]), "s"((const char*)(gbase)), "s"((unsigned)(size_t)(lds + (bufoff) + ldsw + _i * 8192)) : "memory"); } } while (0)
#define FG_STAGE_A(bufoff, P, H, NX) do { if constexpr (GATHER) { const u32x2 _g = *(const LAS u32x2*)(gofs + ((NX) ? nsel : cset) * 8192 + (H) * 8); unsigned _o[2] = {_g[0], _g[1]}; FG_STAGE(bufoff, P, _o); } \
        else { FG_STAGE(bufoff, (P) + (H) * hstepA, voffA); } } while (0)
#define FG_LD8(p) __builtin_shufflevector(*(const LAS v4i32*)(p), *(const LAS v4i32*)((p) + 1024), 0, 1, 2, 3, 4, 5, 6, 7)
#define FG_LDA(dst, b, h) do { _Pragma("unroll") for (int m = 0; m < 4; ++m) dst[m] = FG_LD8(lds + FG_SA(b, h) + aoff + m * 2048); } while (0)
#define FG_LDB(dst, b, h) do { _Pragma("unroll") for (int n = 0; n < 2; ++n) dst[n] = FG_LD8(lds + FG_SB(b, h) + boff + n * 2048); } while (0)
#define FG_MMA(ai, bj, At, Bt) do { __builtin_amdgcn_s_setprio(1); _Pragma("unroll") for (int m = 0; m < 4; ++m) _Pragma("unroll") for (int n = 0; n < 2; ++n) { \
        if constexpr (F8) acc[ai][bj][m][n] = __builtin_amdgcn_mfma_scale_f32_16x16x128_f8f6f4(Bt[n], At[m], acc[ai][bj][m][n], 0, 0, 0, 0x7f7f7f7f, 0, 0x7f7f7f7f); \
        else { acc[ai][bj][m][n] = __builtin_amdgcn_mfma_f32_16x16x32_bf16((bf16x8)__builtin_shufflevector(Bt[n], Bt[n], 0, 1, 2, 3), (bf16x8)__builtin_shufflevector(At[m], At[m], 0, 1, 2, 3), acc[ai][bj][m][n], 0, 0, 0); \
               acc[ai][bj][m][n] = __builtin_amdgcn_mfma_f32_16x16x32_bf16((bf16x8)__builtin_shufflevector(Bt[n], Bt[n], 4, 5, 6, 7), (bf16x8)__builtin_shufflevector(At[m], At[m], 4, 5, 6, 7), acc[ai][bj][m][n], 0, 0, 0); } } __builtin_amdgcn_s_setprio(0); } while (0)
#define FG_WAIT_V(n) asm volatile("s_waitcnt vmcnt(" #n ")" ::: "memory")
#define FG_WAIT_L(n) asm volatile("s_waitcnt lgkmcnt(" #n ")" ::: "memory")
#define FG_BAR __builtin_amdgcn_s_barrier()
#define FG_SCHED __builtin_amdgcn_sched_barrier(0)
#define FG_GOFF(SET, U) do { if constexpr (GATHER) { const int _t = wid * 64 + hidden_lane(); u32x4 _q; _Pragma("unroll") for (int _h = 0; _h < 2; ++_h) _Pragma("unroll") for (int _i = 0; _i < 2; ++_i) { \
        int _R, _C; stage_rc(_t * 16 + _i * 8192, _R, _C); int _r = _h * HALF + _R; _r = _r < (U).gn ? _r : (U).gn - 1; _q[_h * 2 + _i] = (unsigned)(U).gl[_r] * (unsigned)(K * EB) + (unsigned)(_C * 2); } \
        *(LAS u32x4*)(gofs + (SET) * 8192) = _q; } } while (0)
#define FG_UNIFY(U) do { (U).a = uni_ptr((U).a); (U).b = uni_ptr((U).b); (U).gl = uni_ptr((U).gl); if constexpr (SEG) { (U).a1 = uni_ptr((U).a1); (U).a2 = uni_ptr((U).a2); asm volatile("" : "+s"((U).a1), "+s"((U).a2)); } (U).kind = uni((U).kind); (U).r0 = uni((U).r0); (U).c0 = uni((U).c0); (U).aux = uni((U).aux); (U).gn = uni((U).gn); \
        asm volatile("" : "+s"((U).a), "+s"((U).b), "+s"((U).gl), "+s"((U).kind), "+s"((U).r0), "+s"((U).c0), "+s"((U).aux), "+s"((U).gn)); } while (0)
    GU cur{}; int ui = 0;
    if (!S.next(0, cur)) return;
    FG_UNIFY(cur);
    LAS unsigned char* const gofs = lds + STAGE_BYTES + 1024 + tid * 16;
    int cset = 0, nsel = 0;
    FG_GOFF(cset, cur);
    f32x4 acc[2][2][4][2];
#pragma unroll
    for (int a = 0; a < 2; ++a)
#pragma unroll
        for (int b = 0; b < 2; ++b)
#pragma unroll
            for (int m = 0; m < 4; ++m)
#pragma unroll
                for (int n = 0; n < 2; ++n) acc[a][b][m][n] = (f32x4){0.f, 0.f, 0.f, 0.f};
    v8i32 At[4], B0[2], B1[2];
    const char* cA = cur.a; const char* cB = cur.b;
    FG_STAGE(FG_SB(0, 0), cB, voffB); FG_STAGE(FG_SB(0, 1), cB + hstep, voffB); FG_STAGE_A(FG_SA(0, 0), cA, 0, false); FG_STAGE_A(FG_SA(0, 1), cA, 1, false);
    if (wr == 1) FG_BAR;
    FG_WAIT_V(2); FG_BAR;
    FG_STAGE(FG_SB(1, 0), cB + kstep, voffB); FG_STAGE_A(FG_SA(1, 0), cA + kstep, 0, false); FG_STAGE(FG_SB(1, 1), cB + hstep + kstep, voffB);
    FG_WAIT_V(6); FG_BAR;
    for (;;) {
        GU nxt{};
        const bool has_next = S.next(ui + 1, nxt);
        FG_UNIFY(nxt);
        const char* nA = has_next ? nxt.a : cA; const char* nB = has_next ? nxt.b : cB;
        if constexpr (GATHER) { if (has_next) { nsel = cset ^ 1; FG_GOFF(nsel, nxt); } else nsel = cset; }
#pragma unroll UNR
        for (int t = 0; t < nt; t += 2) {
            const bool last = (t == nt - 2);
            const char *a1, *a2, *a3, *b2, *b3;
            if constexpr (SEG) { const int ts = nt / 3;
                const int s1 = t / ts, s2 = (t + 2) / ts; const size_t k1 = (size_t)(t + 1 - s1 * ts) * kstep, k2 = (size_t)(t + 2 - s2 * ts) * kstep;
                a1 = (s1 == 0 ? cA : (s1 == 1 ? cur.a1 : cur.a2)) + k1;
                a2 = last ? nA : (s2 == 0 ? cA : (s2 == 1 ? cur.a1 : cur.a2)) + k2; b2 = last ? nB : cB + (size_t)s2 * Epi::SEGB + k2;
                a3 = a2 + kstep; b3 = b2 + kstep;
                if (t > 0 && t % ts == 0) { const int lz = hidden_lane(); E.rescale(acc, cur, t / ts, wid >> 2, wid & 3, lz & 15, lz >> 4); } }
            else { a1 = cA + (size_t)(t + 1) * kstep; a2 = last ? nA : cA + (size_t)(t + 2) * kstep; b2 = last ? nB : cB + (size_t)(t + 2) * kstep; a3 = a2 + kstep; b3 = b2 + kstep; }
            FG_LDB(B0, 0, 0); FG_LDB(B1, 0, 1); FG_SCHED; FG_LDA(At, 0, 0); FG_STAGE_A(FG_SA(1, 1), a1, 1, false);
            FG_WAIT_V(8); FG_WAIT_L(0); FG_BAR; FG_MMA(0, 0, At, B0); FG_MMA(0, 1, At, B1); FG_BAR; FG_SCHED;
            FG_LDA(At, 0, 1); FG_STAGE(FG_SB(0, 0), b2, voffB); FG_STAGE(FG_SB(0, 1), b2 + hstep, voffB); FG_STAGE_A(FG_SA(0, 0), a2, 0, last);
            FG_WAIT_V(8); FG_WAIT_L(0); FG_BAR; FG_MMA(1, 0, At, B0); FG_MMA(1, 1, At, B1); FG_BAR; FG_SCHED;
            FG_LDB(B0, 1, 0); FG_LDB(B1, 1, 1); FG_SCHED; FG_LDA(At, 1, 0); FG_STAGE_A(FG_SA(0, 1), a2, 1, last);
            FG_WAIT_V(8); FG_WAIT_L(0); FG_BAR; FG_MMA(0, 0, At, B0); FG_MMA(0, 1, At, B1); FG_BAR; FG_SCHED;
            FG_LDA(At, 1, 1); FG_STAGE(FG_SB(1, 0), b3, voffB); FG_STAGE(FG_SB(1, 1), b3 + hstep, voffB); FG_STAGE_A(FG_SA(1, 0), a3, 0, last);
            FG_WAIT_V(8); FG_WAIT_L(0); FG_BAR; FG_MMA(1, 0, At, B0); FG_MMA(1, 1, At, B1); FG_BAR; FG_SCHED;
        }
        if (wr == 0) FG_BAR;
        {
            const int lz = hidden_lane();
            E(acc, cur, wid >> 2, wid & 3, lz & 15, lz >> 4); }
        if (!has_next) break;
#pragma unroll
        for (int a = 0; a < 2; ++a)
#pragma unroll
            for (int b = 0; b < 2; ++b)
#pragma unroll
                for (int m = 0; m < 4; ++m)
#pragma unroll
                    for (int n = 0; n < 2; ++n) acc[a][b][m][n] = (f32x4){0.f, 0.f, 0.f, 0.f};
        cur = nxt; cA = nA; cB = nB; ++ui;
        if constexpr (GATHER) cset = nsel;
        if (wr == 1) FG_BAR;
    }
    FG_WAIT_V(0);
    FG_BAR;
#undef FG_SA
#undef FG_SB
#undef FG_STAGE
#undef FG_STAGE_A
#undef FG_LDA
#undef FG_LD8
#undef FG_LDB
#undef FG_MMA
#undef FG_WAIT_V
#undef FG_WAIT_L
#undef FG_BAR
#undef FG_SCHED
#undef FG_GOFF
#undef FG_UNIFY
}
}

constexpr size_t OFF_WGU = OFF_ATT;
constexpr size_t OFF_WD = OFF_WGU + (size_t)33 * 512 * 1024 * 2;
static_assert(OFF_WD + (size_t)33 * 1024 * 256 * 2 <= OFF_END_MIX, "MoE weights must fit region C");

struct Args { Ptrs P; int ph_lo, ph_hi; };

__device__ __forceinline__ u32x4 pk8(const float* v) { u32x4 w; w[0] = cvt_pk_bf16(v[0], v[1]); w[1] = cvt_pk_bf16(v[2], v[3]); w[2] = cvt_pk_bf16(v[4], v[5]); w[3] = cvt_pk_bf16(v[6], v[7]); return w; }
__device__ __forceinline__ float sat8(float v) { return __builtin_amdgcn_fmed3f(v, -448.f, 448.f); }
__device__ __forceinline__ u32x2 pk8_fp8(const float* v, float sc) { int a = __builtin_amdgcn_cvt_pk_fp8_f32(sat8(v[0] * sc), sat8(v[1] * sc), 0, false); a = __builtin_amdgcn_cvt_pk_fp8_f32(sat8(v[2] * sc), sat8(v[3] * sc), a, true);
    int b = __builtin_amdgcn_cvt_pk_fp8_f32(sat8(v[4] * sc), sat8(v[5] * sc), 0, false); b = __builtin_amdgcn_cvt_pk_fp8_f32(sat8(v[6] * sc), sat8(v[7] * sc), b, true); return (u32x2){(unsigned)a, (unsigned)b}; }
constexpr float W8SC = 32.f;
__device__ __forceinline__ int w1_col(int r) {
    const int ct = r >> 8, j = r & 255;
    if (ct == 0) return j;
    if (ct == 1) return KV_END + j;
    if (ct == 2) { if (j < 128) return KV_END + 256 + j;
        if (j < 160) { const int p = j - 128, a = p >> 3, half = (p >> 2) & 1, rr = p & 3; return KV_RANK + half * 16 + 4 * a + rr; }
        return -1; }
    if (ct <= 4) return Q_END + (ct - 3) * 256 + j;
    if (ct <= 8) { const int t = ct - 5; return j < 128 ? CB_END + t * 128 + j : CC_END + t * 128 + (j - 128); }
    return FOUR_END + (ct - 9) * 256 + j;
}
__device__ __forceinline__ int wuq_col(int n) { const int h = n / 96, j = n % 96; if (j < 64) return n; const int p = j - 64, a = p >> 3, half = (p >> 2) & 1, rr = p & 3; return h * 96 + 64 + half * 16 + 4 * a + rr; }
template <int MAP, bool O8 = false>
__device__ __forceinline__ void tr_tile(float* tile, const float* src, int ld, int c0, const float* kscale, bf16_t* dst, int K, int n0, int k0, int wid) {
    const int tid = hidden_tid(wid);
#pragma unroll
    for (int i = 0; i < 4; ++i) { const int e = tid + 512 * i, kk = e >> 4, n4 = (e & 15) * 4; const int n = n0 + n4; const int col = MAP == 0 ? c0 + n : (MAP == 1 ? w1_col(n) : wuq_col(n));
        f32x4 v = {0.f, 0.f, 0.f, 0.f}; if (col >= 0) { v = *(const f32x4*)(src + (size_t)(k0 + kk) * ld + col); if (kscale) v *= kscale[k0 + kk]; }
        *(f32x4*)(tile + kk * 68 + n4) = v; }
    __syncthreads();
#pragma unroll
    for (int i = 0; i < 2; ++i) { const int e = tid + 512 * i, nn = e & 63, kc = (e >> 6) * 8; float v[8];
#pragma unroll
        for (int j = 0; j < 8; ++j) v[j] = tile[(kc + j) * 68 + nn];
        if constexpr (O8) *(u32x2*)((u8*)dst + (size_t)(n0 + nn) * K + k0 + kc) = pk8_fp8(v, W8SC); else *(u32x4*)(dst + (size_t)(n0 + nn) * K + k0 + kc) = pk8(v); }
    __syncthreads();
}
template <int MAP, bool O8 = false>
__device__ __forceinline__ void tr_job(float* tile, int& tbase, const float* src, int ld, int c0, const float* kscale, bf16_t* dst, int N, int K, int wid, int wg0 = 0) {
    const int nk = K / 128, ntile = (N / 64) * nk, G = (int)gridDim.x - wg0; const int me = bid_() - wg0; if (me < 0) { tbase += ntile; return; }
    int first = (me - tbase % G + G) % G;
    for (int t = first; t < ntile; t += G) tr_tile<MAP, O8>(tile, src, ld, c0, kscale, dst, K, (t / nk) * 64, (t % nk) * 128, wid);
    tbase += ntile;
}
__device__ __forceinline__ void prep_mix(const Ptrs& P, int l, float* tile, int& tbase, int wid, int wg0 = 0) {
    char* wm = P.ws + OFF_WMIX + (size_t)l * WMIX_BYTES;
    tr_job<1>(tile, tbase, P.w_in + (size_t)l * DM * PROJ_W, PROJ_W, 0, nullptr, (bf16_t*)(wm + WMIX_W1), 2304, DM, wid, wg0);
    tr_job<0, true>(tile, tbase, P.w_in + (size_t)l * DM * PROJ_W, PROJ_W, FOUR_END, nullptr, (bf16_t*)(P.ws + OFF_W1G8 + (size_t)l * 3072 * 1024), 3072, DM, wid, wg0);
    tr_job<0>(tile, tbase, P.w_ukv + (size_t)l * KV_RANK * 1024, 1024, 0, P.g_kv + l * KV_RANK, (bf16_t*)(wm + WMIX_WUKV), 1024, KV_RANK, wid, wg0);
    tr_job<2>(tile, tbase, P.w_uq + (size_t)l * Q_RANK * 768, 768, 0, P.g_q + l * Q_RANK, (bf16_t*)(wm + WMIX_WUQ), 768, Q_RANK, wid, wg0);
    tr_job<0>(tile, tbase, P.w_mla_out + (size_t)l * 512 * DM, DM, 0, nullptr, (bf16_t*)(wm + WMIX_WA), 1024, 512, wid, wg0);
    tr_job<0>(tile, tbase, P.w_conv_out + (size_t)l * 512 * DM, DM, 0, nullptr, (bf16_t*)(wm + WMIX_WA) + (size_t)1024 * 512, 1024, 512, wid, wg0);
    tr_job<0>(tile, tbase, P.w_four_out + (size_t)l * 512 * DM, DM, 0, nullptr, (bf16_t*)(wm + WMIX_WA) + (size_t)2 * 1024 * 512, 1024, 512, wid, wg0);
    tr_job<0>(tile, tbase, P.w_out + (size_t)l * DM * DM, DM, 0, nullptr, (bf16_t*)(wm + WMIX_WO), 1024, DM, wid, wg0);
}

struct EpiYX { bf16_t* yx; float* ssp;
    __device__ __forceinline__ void operator()(const f32x4 (&acc)[2][2][4][2], const fg::GU& u, int wr, int wc, int fr, int fq) const {
#pragma unroll
        for (int ai = 0; ai < 2; ++ai)
#pragma unroll
            for (int m = 0; m < 4; ++m) { const int row = u.r0 + ai * 128 + wr * 64 + m * 16 + fr; float ss = 0.f;
#pragma unroll
                for (int bj = 0; bj < 2; ++bj) { const f32x4 v0 = acc[ai][bj][m][0], v1 = acc[ai][bj][m][1];
                    ss += v0[0] * v0[0] + v0[1] * v0[1] + v0[2] * v0[2] + v0[3] * v0[3] + v1[0] * v1[0] + v1[1] * v1[1] + v1[2] * v1[2] + v1[3] * v1[3];
                    u32x4 w; w[0] = cvt_pk_bf16(v0[0], v0[1]); w[1] = cvt_pk_bf16(v0[2], v0[3]); w[2] = cvt_pk_bf16(v1[0], v1[1]); w[3] = cvt_pk_bf16(v1[2], v1[3]);
                    *(u32x4*)(yx + (size_t)row * DM + u.c0 + bj * 128 + wc * 32 + 8 * fq) = w; }
                ss += lane_xor<16>(ss); ss = lane_xor32_sum(ss);
                if (fq == 0) ssp[(size_t)row * 16 + (u.c0 >> 8) * 4 + wc] = ss; }
    }
};
struct EpiMerge { static constexpr size_t SEGB = (size_t)1024 * 512 * 2;
    bf16_t* merged; const u8* gates;
    __device__ __forceinline__ static float gv(unsigned w, int j) { return (float)((w >> (8 * j)) & 0xffu); }
    __device__ __forceinline__ void rescale(f32x4 (&acc)[2][2][4][2], const fg::GU& u, int seg, int wr, int wc, int fr, int fq) const {
#pragma unroll
        for (int ai = 0; ai < 2; ++ai) { u32x2 gp[4][2], gn[4][2];
#pragma unroll
            for (int m = 0; m < 4; ++m)
#pragma unroll
                for (int bj = 0; bj < 2; ++bj) { const u8* g = gates + (size_t)(u.r0 + ai * 128 + wr * 64 + m * 16 + fr) * 3072 + (seg - 1) * 1024 + u.c0 + bj * 128 + wc * 32 + 8 * fq;
                    gp[m][bj] = *(const u32x2*)g; gn[m][bj] = *(const u32x2*)(g + 1024); }
#pragma unroll
            for (int m = 0; m < 4; ++m)
#pragma unroll
                for (int bj = 0; bj < 2; ++bj)
#pragma unroll
                    for (int j = 0; j < 8; ++j) acc[ai][bj][m][j >> 2][j & 3] *= gv(gp[m][bj][j >> 2], j & 3) * __builtin_amdgcn_rcpf(gv(gn[m][bj][j >> 2], j & 3)); }
    }
    __device__ __forceinline__ void operator()(const f32x4 (&acc)[2][2][4][2], const fg::GU& u, int wr, int wc, int fr, int fq) const {
#pragma unroll
        for (int ai = 0; ai < 2; ++ai) { u32x2 g[4][2];
#pragma unroll
            for (int m = 0; m < 4; ++m)
#pragma unroll
                for (int bj = 0; bj < 2; ++bj) g[m][bj] = *(const u32x2*)(gates + (size_t)(u.r0 + ai * 128 + wr * 64 + m * 16 + fr) * 3072 + 2048 + u.c0 + bj * 128 + wc * 32 + 8 * fq);
#pragma unroll
            for (int m = 0; m < 4; ++m)
#pragma unroll
                for (int bj = 0; bj < 2; ++bj) { const int row = u.r0 + ai * 128 + wr * 64 + m * 16 + fr, col = u.c0 + bj * 128 + wc * 32 + 8 * fq; float v[8];
#pragma unroll
                    for (int j = 0; j < 8; ++j) v[j] = acc[ai][bj][m][j >> 2][j & 3] * (gv(g[m][bj][j >> 2], j & 3) * (1.f / 255.f));
                    *(u32x4*)(merged + (size_t)row * DM + col) = pk8(v); } }
    }
};

struct SchedPlain { const char* A; const char* Bt; int nM, nN, K;
    __device__ __forceinline__ bool next(int i, fg::GU& u) const { const int L = i * (int)gridDim.x + bid_(); if (L >= nM * nN) return false; int pm, pn; fg::tile_order(L, nM, nN, pm, pn);
        u.a = A + (size_t)pm * 256 * K * 2; u.b = Bt + (size_t)pn * 256 * K * 2; u.r0 = pm * 256; u.c0 = pn * 256; u.kind = 0; u.aux = 0; u.gl = nullptr; u.gn = 256; return true; } };
struct SchedMerge { const char *A0, *A1, *A2; const char* W3; int nM;
    __device__ __forceinline__ bool next(int i, fg::GU& u) const { const int tl = i * (int)gridDim.x + bid_(); if (tl >= nM * 4) return false; int pm, pn; fg::tile_order(tl, nM, 4, pm, pn);
        const size_t ao = (size_t)pm * 256 * 512 * 2; u.a = A0 + ao; u.a1 = A1 + ao; u.a2 = A2 + ao; u.b = W3 + (size_t)pn * 256 * 512 * 2; u.r0 = pm * 256; u.c0 = pn * 256; u.kind = 0; u.aux = 0; u.gl = nullptr; u.gn = 256; return true; } };

__device__ __forceinline__ u32x4 pk8_sw(const float* v) { u32x4 w;
#pragma unroll
    for (int i = 0; i < 4; ++i) w[i] = (unsigned)f2bf(v[2 * i]) | ((unsigned)f2bf(v[2 * i + 1]) << 16);
    return w; }
__device__ __forceinline__ void prep_wz(const Ptrs& P, int l, float* ldsf, int& tbase, int wid, int wg0 = 0) {
    const int G = (int)gridDim.x - wg0, tid = hidden_tid(wid), lane = tid & 63, fr = lane & 15, fq = lane >> 4; float* wt = ldsf;
    const int ntile = 4 * 32;
    const int me = bid_() - wg0; if (me < 0) { tbase += ntile; return; }
    const int first = (me - tbase % G + G) % G;
    u8* WZ = (u8*)(P.ws + OFF_WMIX + (size_t)l * WMIX_BYTES + WMIX_WZ);
    if (first < ntile) {
        bf16x8 bh[2][4], bl[2][4];
#pragma unroll
        for (int j = 0; j < 2; ++j) { const int n = 32 * wid + 16 * j + fr, part = n >> 7, cp = n & 127;
#pragma unroll
            for (int kb = 0; kb < 4; ++kb) { float v[8], lo[8];
#pragma unroll
                for (int e = 0; e < 8; ++e) { const int c = 32 * kb + 8 * fq + e; const float ph = 2.f * (float)((c * cp) & 127) / 128.f;
                    v[e] = (part ? -sinpif(ph) : cospif(ph)) * 0.08838834764831845f; lo[e] = v[e] - bf2f(f2bf(v[e])); }
                const u32x4 ph8 = pk8_sw(v), pl8 = pk8_sw(lo); bh[j][kb] = *reinterpret_cast<const bf16x8*>(&ph8); bl[j][kb] = *reinterpret_cast<const bf16x8*>(&pl8); } }
        for (int t = first; t < ntile; t += G) { const int g = t >> 5, k0 = (t & 31) * 32;
            for (int e = tid; e < 32 * 128; e += 512) { const int kk = e >> 7, c = e & 127; wt[kk * 129 + c] = P.w_in[(size_t)l * DM * PROJ_W + (size_t)(k0 + kk) * PROJ_W + CX_END + g * 128 + c]; }
            __syncthreads();
            f32x4 acc[2][2];
#pragma unroll
            for (int m = 0; m < 2; ++m)
#pragma unroll
                for (int j = 0; j < 2; ++j) acc[m][j] = (f32x4){0.f, 0.f, 0.f, 0.f};
#pragma unroll
            for (int kb = 0; kb < 4; ++kb)
#pragma unroll
                for (int m = 0; m < 2; ++m) { float v[8], lo[8];
#pragma unroll
                    for (int e = 0; e < 8; ++e) { v[e] = wt[(16 * m + fr) * 129 + 32 * kb + 8 * fq + e]; lo[e] = v[e] - bf2f(f2bf(v[e])); }
                    const u32x4 ph8 = pk8_sw(v), pl8 = pk8_sw(lo); const bf16x8 ah = *reinterpret_cast<const bf16x8*>(&ph8), al = *reinterpret_cast<const bf16x8*>(&pl8);
#pragma unroll
                    for (int j = 0; j < 2; ++j) { acc[m][j] = __builtin_amdgcn_mfma_f32_16x16x32_bf16(ah, bh[j][kb], acc[m][j], 0, 0, 0);
                        acc[m][j] = __builtin_amdgcn_mfma_f32_16x16x32_bf16(ah, bl[j][kb], acc[m][j], 0, 0, 0); acc[m][j] = __builtin_amdgcn_mfma_f32_16x16x32_bf16(al, bh[j][kb], acc[m][j], 0, 0, 0); } }
#pragma unroll
            for (int m = 0; m < 2; ++m)
#pragma unroll
                for (int j = 0; j < 2; ++j) { const int n = 32 * wid + 16 * j + fr, part = n >> 7, cp = n & 127; float q[4];
#pragma unroll
                    for (int r = 0; r < 4; ++r) q[r] = __builtin_amdgcn_fmed3f(acc[m][j][r] * W8SC, -448.f, 448.f);
                    int w8 = __builtin_amdgcn_cvt_pk_fp8_f32(q[0], q[1], 0, false); w8 = __builtin_amdgcn_cvt_pk_fp8_f32(q[2], q[3], w8, true);
                    *(unsigned*)(WZ + (size_t)(part * 512 + g * 128 + cp) * DM + k0 + 16 * m + 4 * fq) = (unsigned)w8; }
            __syncthreads(); } }
    tbase += ntile;
}
__device__ __forceinline__ void prep_dft(const Ptrs& P, int wid) {
    bf16_t* TC = WSP(bf16_t, OFF_TC);
    const size_t nthr = (size_t)gridDim.x * 512, gid = (size_t)bid_() * 512 + hidden_tid(wid);
    for (size_t e = gid; e < (size_t)RT; e += nthr) WSP(int, OFF_IDL)[e] = (int)e;
    for (size_t e = gid; e < (size_t)256 * 128; e += nthr) { const int kk = e & 127, rho = e >> 7; float v = 0.f;
        if ((rho & 127) < 64) { const int k2 = rho & 63, po = rho >> 7, part = kk >> 6, n2 = kk & 63; const float ph = 2.f * (float)((n2 * k2) & 63) / 64.f;
            const float c = cospif(ph), sn = sinpif(ph); v = po == 0 ? (part == 0 ? c : sn) : (part == 0 ? -sn : c); }
        WSP(bf16_t, OFF_MA)[e] = f2bf(v); }
    for (size_t e = gid; e < (size_t)256 * 128; e += nthr) { const int kk = e & 127, p = e >> 7; float v = 0.f;
        if (p < 64) { const int hfo = p >> 5, k1 = p & 31, hf = kk >> 6, part = (kk >> 5) & 1, n1 = kk & 31; const float ph = 2.f * (float)((n1 * k1) & 31) / 32.f;
            if (hf == hfo) v = (part == 0 ? cospif(ph) : sinpif(ph)) * 0.02209708691207961f; }
        WSP(bf16_t, OFF_MB)[e] = f2bf(v); }
    for (size_t e = gid; e < (size_t)64 * 32; e += nthr) { const int n1 = e & 31, k2 = e >> 5; const float ph = 2.f * (float)(n1 * k2) / 2048.f; WSP(float, OFF_TW)[2 * e] = cospif(ph); WSP(float, OFF_TW)[2 * e + 1] = sinpif(ph); }
    for (size_t e = gid; e < (size_t)256 * 256; e += nthr) { const int kp = e & 255, m = e >> 8; const int k = 2 * kp; const int kk = k & 255;
        const float p0 = 2.f * (float)((m * kk) & 255) / 256.f, p1 = 2.f * (float)((m * (kk + 1)) & 255) / 256.f; const float s = 0.0625f;
        const float v0 = (k < 256 ? cospif(p0) : sinpif(p0)) * s, v1 = (k < 256 ? cospif(p1) : sinpif(p1)) * s; *(unsigned*)(TC + (size_t)m * 512 + k) = cvt_pk_bf16(v0, v1); }
}

__device__ __forceinline__ float fast_sigmoid(float x) { return __builtin_amdgcn_rcpf(1.f + __builtin_amdgcn_exp2f(-1.4426950408889634f * x)); }
__device__ __forceinline__ u32x4 pack8(const f32x4& v0, const f32x4& v1) { u32x4 w; w[0] = cvt_pk_bf16(v0[0], v0[1]); w[1] = cvt_pk_bf16(v0[2], v0[3]); w[2] = cvt_pk_bf16(v1[0], v1[1]); w[3] = cvt_pk_bf16(v1[2], v1[3]); return w; }
__device__ __forceinline__ float sumsq8(const f32x4& v0, const f32x4& v1) { return v0[0] * v0[0] + v0[1] * v0[1] + v0[2] * v0[2] + v0[3] * v0[3] + v1[0] * v1[0] + v1[1] * v1[1] + v1[2] * v1[2] + v1[3] * v1[3]; }

struct EpiProj { const Ptrs P; int l;
    __device__ __forceinline__ void operator()(const f32x4 (&acc)[2][2][4][2], const fg::GU& u, int wr, int wc, int fr, int fq) const {
        const int kind = u.kind;
        if (kind <= 2) {
            bf16_t* dst = kind == 0 ? WSP(bf16_t, OFF_CKV) : WSP(bf16_t, OFF_CQ); const int ld = kind == 0 ? KV_RANK : Q_RANK; const int cb = kind == 2 ? 256 : 0;
            float* ssp = kind == 0 ? WSP(float, OFF_SSP) : WSP(float, OFF_SSPQ); const int sstride = kind == 0 ? 4 : 8; const int sslot = (kind == 2 ? 4 : 0) + wc;
            const int nbj = kind == 2 ? 1 : 2;
#pragma unroll
            for (int ai = 0; ai < 2; ++ai)
#pragma unroll
                for (int m = 0; m < 4; ++m) { const int row = u.r0 + ai * 128 + wr * 64 + m * 16 + fr; float ss = 0.f;
#pragma unroll
                    for (int bj = 0; bj < 2; ++bj) if (bj < nbj) { ss += sumsq8(acc[ai][bj][m][0], acc[ai][bj][m][1]);
                        *(u32x4*)(dst + (size_t)row * ld + cb + bj * 128 + wc * 32 + 8 * fq) = pack8(acc[ai][bj][m][0], acc[ai][bj][m][1]); }
                    ss += lane_xor<16>(ss); ss = lane_xor32_sum(ss);
                    if (fq == 0) ssp[(size_t)row * sstride + sslot] = ss;
                    if (kind == 2 && wc == 0) {
                        const f32x4 x1 = acc[ai][1][m][0], x2 = acc[ai][1][m][1]; f32x4 o1 = x1, o2 = x2;
                        if (row < RX) { const float* cs = WSP(float, OFF_ROPE) + ((size_t)(row & (SEQ - 1)) * 16 + 4 * fq) * 2; const f32x4 t0 = *(const f32x4*)cs, t1 = *(const f32x4*)(cs + 4);
                            const float c[4] = {t0[0], t0[2], t1[0], t1[2]}, s[4] = {t0[1], t0[3], t1[1], t1[3]};
#pragma unroll
                            for (int j = 0; j < 4; ++j) { o1[j] = x1[j] * c[j] - x2[j] * s[j]; o2[j] = x2[j] * c[j] + x1[j] * s[j]; } }
                        const u32x4 w = pack8(o1, o2); bf16_t* kp = WSP(bf16_t, OFF_K) + (size_t)row * 768 + 64 + 8 * fq;
#pragma unroll
                        for (int h = 0; h < NH; ++h) *(u32x4*)(kp + h * 96) = w; }
                }
        } else if (kind == 3) {
            bf16_t* dst = WSP(bf16_t, OFF_CB);
#pragma unroll
            for (int ai = 0; ai < 2; ++ai)
#pragma unroll
                for (int m = 0; m < 4; ++m) { const int row = u.r0 + ai * 128 + wr * 64 + m * 16 + fr;
#pragma unroll
                    for (int bj = 0; bj < 2; ++bj) *(u32x4*)(dst + (size_t)row * CONVW + u.aux + bj * 128 + wc * 32 + 8 * fq) = pack8(acc[ai][bj][m][0], acc[ai][bj][m][1]); }
        } else if (kind == 4) {
            bf16_t* dst = WSP(bf16_t, OFF_INNER);
#pragma unroll
            for (int ai = 0; ai < 2; ++ai)
#pragma unroll
                for (int m = 0; m < 4; ++m) { const int row = u.r0 + ai * 128 + wr * 64 + m * 16 + fr;
                    const f32x4 p0 = acc[ai][0][m][0] * acc[ai][1][m][0], p1 = acc[ai][0][m][1] * acc[ai][1][m][1];
                    *(u32x4*)(dst + (size_t)row * CONVW + u.aux * 128 + wc * 32 + 8 * fq) = pack8(p0, p1); }
        } else if (kind == 7) {
            const int b = u.c0 >> 3, tq = u.c0 & 7; bf16_t* za = WSP(bf16_t, OFF_ZA);
#pragma unroll
            for (int ai = 0; ai < 2; ++ai)
#pragma unroll
                for (int m = 0; m < 4; ++m) { const int zrow = u.r0 + ai * 128 + wr * 64 + m * 16 + fr; const int part = zrow >> 9, gc = zrow & 511;
#pragma unroll
                    for (int bj = 0; bj < 2; ++bj) { const int j0 = bj * 128 + wc * 32 + 8 * fq; const int n1 = 4 * tq + (j0 >> 6), n2 = j0 & 63;
                        *(u32x4*)(za + ((size_t)((b * 32 + n1) * 512 + gc)) * 128 + part * 64 + n2) = pack8(acc[ai][bj][m][0], acc[ai][bj][m][1]); } }
        } else {
            const int tok0 = u.c0; const bool isx = tok0 < RX;
            const int b = isx ? tok0 / SEQ : (tok0 - RX) / CTX, nb = isx ? tok0 % SEQ : 0, Nb = isx ? SEQ : CTX;
            bf16_t* base = isx ? WSP(bf16_t, OFF_ZT) + (size_t)b * 512 * 4096 : WSP(bf16_t, OFF_ZTC) + (size_t)b * 512 * 512;
#pragma unroll
            for (int ai = 0; ai < 2; ++ai)
#pragma unroll
                for (int m = 0; m < 4; ++m) { const int zrow = u.r0 + ai * 128 + wr * 64 + m * 16 + fr; const int part = zrow >> 9, gc = zrow & 511;
#pragma unroll
                    for (int bj = 0; bj < 2; ++bj) *(u32x4*)(base + (size_t)gc * (2 * Nb) + part * Nb + nb + bj * 128 + wc * 32 + 8 * fq) = pack8(acc[ai][bj][m][0], acc[ai][bj][m][1]); }
        }
    }
};
struct EpiZ { const Ptrs P;
    __device__ __forceinline__ void operator()(const f32x4 (&acc)[2][2][4][2], const fg::GU& u, int wr, int wc, int fr, int fq) const {
        constexpr float sc = 1.f / W8SC;
        if (u.kind == 7) {
            const int b = u.c0 >> 3, tq = u.c0 & 7; bf16_t* za = WSP(bf16_t, OFF_ZA);
#pragma unroll
            for (int ai = 0; ai < 2; ++ai)
#pragma unroll
                for (int m = 0; m < 4; ++m) { const int zrow = u.r0 + ai * 128 + wr * 64 + m * 16 + fr; const int part = zrow >> 9, gc = zrow & 511;
#pragma unroll
                    for (int bj = 0; bj < 2; ++bj) { const int j0 = bj * 128 + wc * 32 + 8 * fq; const int n1 = 4 * tq + (j0 >> 6), n2 = j0 & 63;
                        *(u32x4*)(za + ((size_t)((b * 32 + n1) * 512 + gc)) * 128 + part * 64 + n2) = pack8(acc[ai][bj][m][0] * sc, acc[ai][bj][m][1] * sc); } }
        } else {
            const int tok0 = u.c0; const bool isx = tok0 < RX;
            const int b = isx ? tok0 / SEQ : (tok0 - RX) / CTX, nb = isx ? tok0 % SEQ : 0, Nb = isx ? SEQ : CTX;
            bf16_t* base = isx ? WSP(bf16_t, OFF_ZT) + (size_t)b * 512 * 4096 : WSP(bf16_t, OFF_ZTC) + (size_t)b * 512 * 512;
#pragma unroll
            for (int ai = 0; ai < 2; ++ai)
#pragma unroll
                for (int m = 0; m < 4; ++m) { const int zrow = u.r0 + ai * 128 + wr * 64 + m * 16 + fr; const int part = zrow >> 9, gc = zrow & 511;
#pragma unroll
                    for (int bj = 0; bj < 2; ++bj) *(u32x4*)(base + (size_t)gc * (2 * Nb) + part * Nb + nb + bj * 128 + wc * 32 + 8 * fq) = pack8(acc[ai][bj][m][0] * sc, acc[ai][bj][m][1] * sc); }
        }
    }
};
struct EpiGate { const Ptrs P; int l;
    __device__ __forceinline__ void operator()(const f32x4 (&acc)[2][2][4][2], const fg::GU& u, int wr, int wc, int fr, int fq) const {
        {
            u8* dst = WSP(u8, OFF_GATES); const float* bias = P.b_gate + (size_t)l * 3 * DM + u.aux + wc * 32 + 8 * fq;
            f32x4 bv[2][2];
#pragma unroll
            for (int bj = 0; bj < 2; ++bj) { bv[bj][0] = *(const f32x4*)(bias + bj * 128); bv[bj][1] = *(const f32x4*)(bias + bj * 128 + 4); }
#pragma unroll
            for (int ai = 0; ai < 2; ++ai)
#pragma unroll
                for (int m = 0; m < 4; ++m) { const int row = u.r0 + ai * 128 + wr * 64 + m * 16 + fr;
#pragma unroll
                    for (int bj = 0; bj < 2; ++bj) { u32x2 w;
#pragma unroll
                        for (int n = 0; n < 2; ++n) { unsigned pk = 0;
#pragma unroll
                            for (int j = 0; j < 4; ++j) { const float g = fmaxf(255.f * fast_sigmoid(acc[ai][bj][m][n][j] * (1.f / W8SC) + bv[bj][n][j]), 1.f); pk |= ((unsigned)__float2int_rn(g) & 0xffu) << (8 * j); }
                            w[n] = pk; }
                        *(u32x2*)(dst + (size_t)row * 3072 + u.aux + bj * 128 + wc * 32 + 8 * fq) = w; } }
        }
    }
};
struct SchedW1 { const char* H; const char* W1; int l;
    __device__ __forceinline__ bool next(int i, fg::GU& u) const {
        const int c = bid_(); const int nMx = l == 0 ? RT / 256 : RX / 256; const int n1 = nMx * 9, n2 = l == 0 ? 0 : 16;
        const int a0 = l == 0 ? 144 : 160, a1 = l == 0 ? 152 : 176, k0 = 3, k1 = l == 0 ? 1 : 2, k2 = l == 0 ? 2 : 1;
        const int cnt = c < a0 ? k0 : (c < a1 ? k1 : k2); const int base = c < a0 ? k0 * c : (c < a1 ? k0 * a0 + k1 * (c - a0) : k0 * a0 + k1 * (a1 - a0) + k2 * (c - a1));
        const int L = base + i; if (i >= cnt || L >= n1 + n2) return false; u.gl = nullptr; u.gn = 256; u.aux = 0; int pm, ct;
        if (L < n1) fg::tile_order(L, nMx, 9, pm, ct); else { const int j = L - n1; pm = RX / 256 + (j >> 1); ct = (j & 1) ? 2 : 0; }
        u.a = H + (size_t)pm * 256 * DM * 2; u.b = W1 + (size_t)ct * 256 * DM * 2; u.r0 = pm * 256; u.c0 = ct * 256;
        if (ct <= 2) u.kind = ct; else if (ct <= 4) { u.kind = 3; u.aux = (ct - 3) * 256; } else { u.kind = 4; u.aux = ct - 5; }
        return true; } };
struct SchedGate { const char* H8; const char* W8; int l;
    __device__ __forceinline__ bool next(int i, fg::GU& u) const { const int c = bid_(); const int nMx = l == 0 ? RT / 256 : RX / 256;
        const int b0 = l == 0 ? 144 : 160, b1 = l == 0 ? 152 : 176, b2 = l == 0 ? 224 : 256, n0 = l == 0 ? 3 : 2, n1 = l == 0 ? 6 : 3, n2 = l == 0 ? 4 : 5, n3 = 3;
        const int cnt = c < b0 ? n0 : (c < b1 ? n1 : (c < b2 ? n2 : n3));
        const int base = c < b0 ? n0 * c : (c < b1 ? n0 * b0 + n1 * (c - b0) : (c < b2 ? n0 * b0 + n1 * (b1 - b0) + n2 * (c - b1) : n0 * b0 + n1 * (b1 - b0) + n2 * (b2 - b1) + n3 * (c - b2)));
        const int L = base + i; if (i >= cnt || L >= nMx * 12) return false; int pm, ct; fg::tile_order(L, nMx, 12, pm, ct); u.gl = nullptr; u.gn = 256;
        u.a = H8 + (size_t)pm * 256 * DM; u.b = W8 + (size_t)ct * 256 * DM; u.r0 = pm * 256; u.c0 = 0; u.kind = 5; u.aux = ct * 256; return true; } };
struct SchedZx { const char* H; const char* WZ;
    __device__ __forceinline__ bool next(int i, fg::GU& u) const { const int L = i * (int)gridDim.x + bid_(); if (L >= 256) return false; const int zt = L & 3, bt = L >> 2, b = bt >> 3, tq = bt & 7;
        u.gl = nullptr; u.gn = 256; u.aux = 0; u.a = WZ + (size_t)zt * 256 * DM; u.b = H + ((size_t)b * SEQ + 4 * tq) * DM; u.r0 = zt * 256; u.c0 = bt; u.kind = 7; return true; } };
struct SchedZc { const char* H; const char* WZ;
    __device__ __forceinline__ bool next(int i, fg::GU& u) const { const int L = bid_() - 224; if (i > 0 || L < 0 || L >= 32) return false; const int zt = L & 3, tt = RX / 256 + (L >> 2);
        u.gl = nullptr; u.gn = 256; u.aux = 0; u.a = WZ + (size_t)zt * 256 * DM; u.b = H + (size_t)tt * 256 * DM; u.r0 = zt * 256; u.c0 = tt * 256; u.kind = 6; return true; } };
struct SchedFftA { const char* ZA; const char* MA;
    __device__ __forceinline__ bool next(int i, fg::GU& u) const { const int L = i * (int)gridDim.x + bid_(); if (L >= 512) return false; const int b = L >> 6, gcb = L & 63;
        u.gl = nullptr; u.gn = 256; u.aux = 0; u.kind = 0; u.a = MA; u.b = ZA + ((size_t)b * 32 * 512 + gcb * 8) * 256; u.r0 = b; u.c0 = gcb; return true; } };
struct EpiFftA { const Ptrs P;
    __device__ __forceinline__ void operator()(const f32x4 (&acc)[2][2][4][2], const fg::GU& u, int wr, int wc, int fr, int fq) const {
        if (wr != 0) return;
        const int b = u.r0, gcb = u.c0; bf16_t* zb = WSP(bf16_t, OFF_ZB); const float* tw = WSP(float, OFF_TW);
#pragma unroll
        for (int m = 0; m < 4; ++m) { const int k2 = 16 * m + fr; const float* t = tw + ((size_t)k2 * 32 + 8 * fq) * 2;
            const f32x4 t0 = *(const f32x4*)t, t1 = *(const f32x4*)(t + 4), t2 = *(const f32x4*)(t + 8), t3 = *(const f32x4*)(t + 12);
            const float c[8] = {t0[0], t0[2], t1[0], t1[2], t2[0], t2[2], t3[0], t3[2]}, sn[8] = {t0[1], t0[3], t1[1], t1[3], t2[1], t2[3], t3[1], t3[3]};
#pragma unroll
            for (int bj = 0; bj < 2; ++bj) { const int gc = gcb * 8 + 4 * bj + wc; float vr[8], vi[8];
#pragma unroll
                for (int j = 0; j < 8; ++j) { const float re = acc[0][bj][m][j >> 2][j & 3], im = acc[1][bj][m][j >> 2][j & 3]; vr[j] = re * c[j] + im * sn[j]; vi[j] = im * c[j] - re * sn[j]; }
                bf16_t* o = zb + ((((size_t)(b * 64 + k2) * 256 + (gc & 255)) * 2 + (gc >> 8)) * 64) + 8 * fq;
                *(u32x4*)o = pk8(vr); *(u32x4*)(o + 32) = pk8(vi); } }
    }
};
struct SchedFftB { const char* ZB; const char* MB;
    __device__ __forceinline__ bool next(int i, fg::GU& u) const { const int L = i * (int)gridDim.x + bid_(); if (L >= 512) return false;
        u.gl = nullptr; u.gn = 256; u.aux = 0; u.kind = 0; u.a = MB; u.b = ZB + (size_t)L * 256 * 256; u.r0 = L >> 6; u.c0 = L & 63; return true; } };
struct EpiFftB { bf16_t* four;
    __device__ __forceinline__ void operator()(const f32x4 (&acc)[2][2][4][2], const fg::GU& u, int wr, int wc, int fr, int fq) const {
        if (wr != 0) return;
        const int b = u.r0, k2 = u.c0;
#pragma unroll
        for (int m = 0; m < 4; ++m) { const int hf = m >> 1, k1 = 16 * (m & 1) + fr;
#pragma unroll
            for (int bj = 0; bj < 2; ++bj) *(u32x4*)(four + ((size_t)b * SEQ + 64 * k1 + k2) * FW + 256 * hf + bj * 128 + wc * 32 + 8 * fq) = pack8(acc[0][bj][m][0], acc[0][bj][m][1]); }
    }
};

struct EpiUKV { const Ptrs P;
    __device__ __forceinline__ void operator()(const f32x4 (&acc)[2][2][4][2], const fg::GU& u, int wr, int wc, int fr, int fq) const {
#pragma unroll
        for (int ai = 0; ai < 2; ++ai)
#pragma unroll
            for (int m = 0; m < 4; ++m) { const int row = u.r0 + ai * 128 + wr * 64 + m * 16 + fr;
                const f32x4 sp = *(const f32x4*)(WSP(float, OFF_SSP) + (size_t)row * 4); const float r = rsqrtf((sp[0] + sp[1] + sp[2] + sp[3]) * (1.f / KV_RANK) + EPS);
#pragma unroll
                for (int bj = 0; bj < 2; ++bj) { const int h = (u.c0 >> 7) + bj; const f32x4 v0 = acc[ai][bj][m][0] * r, v1 = acc[ai][bj][m][1] * r;
                    bf16_t* dst = wc < 2 ? WSP(bf16_t, OFF_K) + (size_t)row * 768 + h * 96 + wc * 32 + 8 * fq : WSP(bf16_t, OFF_V) + (size_t)row * 512 + h * 64 + (wc - 2) * 32 + 8 * fq;
                    *(u32x4*)dst = pack8(v0, v1); } }
    }
};
struct EpiUQ { const Ptrs P;
    __device__ __forceinline__ void operator()(const f32x4 (&acc)[2][2][4][2], const fg::GU& u, int wr, int wc, int fr, int fq) const {
#pragma unroll
        for (int ai = 0; ai < 2; ++ai)
#pragma unroll
            for (int m = 0; m < 4; ++m) { const int row = u.r0 + ai * 128 + wr * 64 + m * 16 + fr;
                const float* spp = WSP(float, OFF_SSPQ) + (size_t)row * 8; const f32x4 s0 = *(const f32x4*)spp, s1 = *(const f32x4*)(spp + 4);
                const float r = rsqrtf((((s0[0] + s0[1]) + (s0[2] + s0[3])) + ((s1[0] + s1[1]) + (s1[2] + s1[3]))) * (1.f / Q_RANK) + EPS) * QSCALE;
#pragma unroll
                for (int bj = 0; bj < 2; ++bj) { const int col = u.c0 + bj * 128 + wc * 32; const int part = (col >> 5) % 3;
                    f32x4 v0 = acc[ai][bj][m][0] * r, v1 = acc[ai][bj][m][1] * r;
                    if (part == 2 && row < RX) { const float* cs = WSP(float, OFF_ROPE) + ((size_t)(row & (SEQ - 1)) * 16 + 4 * fq) * 2; const f32x4 t0 = *(const f32x4*)cs, t1 = *(const f32x4*)(cs + 4);
                        const float c[4] = {t0[0], t0[2], t1[0], t1[2]}, s[4] = {t0[1], t0[3], t1[1], t1[3]}; const f32x4 x1 = v0, x2 = v1;
#pragma unroll
                        for (int j = 0; j < 4; ++j) { v0[j] = x1[j] * c[j] - x2[j] * s[j]; v1[j] = x2[j] * c[j] + x1[j] * s[j]; } }
                    *(u32x4*)(WSP(bf16_t, OFF_Q) + (size_t)row * 768 + col + 8 * fq) = pack8(v0, v1); } }
    }
};
struct SchedPlainShift { const char* A; const char* Bt; int nM, nN, K, shift;
    __device__ __forceinline__ bool next(int i, fg::GU& u) const { const int G = gridDim.x; const int L = i * G + (bid_() + G - shift) % G; if (L >= nM * nN) return false; int pm, pn; fg::tile_order(L, nM, nN, pm, pn);
        u.a = A + (size_t)pm * 256 * K * 2; u.b = Bt + (size_t)pn * 256 * K * 2; u.r0 = pm * 256; u.c0 = pn * 256; u.kind = 0; u.aux = 0; u.gl = nullptr; u.gn = 256; return true; } };

namespace at {
constexpr int NW = 8, QBLK = 32, KVBLK = 64, DQK = 96, DV = 64;
constexpr int SHM_V = KVBLK * DV * 2, SHM_K = KVBLK * 256, NSLOT = 4, SLOT_B = SHM_K + SHM_V, SHM_ATTN = NSLOT * SLOT_B + NW * 64 * 4;
constexpr float THR2 = 2896.309375740099f;
typedef short s16x4 __attribute__((ext_vector_type(4)));
typedef float f32x16 __attribute__((ext_vector_type(16)));
#define AT_KSWZ(row, colB) ((row) * 256 + ((colB) ^ (((row) & 15) << 4)))
#define AT_SBAR() __builtin_amdgcn_sched_barrier(0)
__device__ __forceinline__ int crow(int r, int hi) { return (r & 3) + 8 * (r >> 2) + 4 * hi; }
__device__ __forceinline__ float rowmaxSM(const f32x16& p0, const f32x16& p1) {
  float pmax = p0[0];
#pragma unroll
  for (int r = 1; r < 16; ++r) pmax = fmaxf(pmax, p0[r]);
#pragma unroll
  for (int r = 0; r < 16; ++r) pmax = fmaxf(pmax, p1[r]);
  { auto rr = __builtin_amdgcn_permlane32_swap(__float_as_uint(pmax), __float_as_uint(pmax), false, false);
    pmax = fmaxf(__uint_as_float(rr[0]), __uint_as_float(rr[1])); }
  return pmax;
}
__device__ __forceinline__ void headSM(f32x16& p0, f32x16& p1, float& m_reg, float& mn, float& alpha) {
  const float pmax = rowmaxSM(p0, p1); mn = fmaxf(m_reg, pmax); alpha = __builtin_amdgcn_exp2f(m_reg - mn); m_reg = mn;
#pragma unroll
  for (int r = 0; r < 16; ++r) p0[r] = p0[r] - mn;
#pragma unroll
  for (int r = 0; r < 16; ++r) p1[r] = p1[r] - mn;
#pragma unroll
  for (int r = 0; r < 16; ++r) p0[r] = __builtin_amdgcn_exp2f(p0[r]);
}
struct KFrag { bf16x8 f[12]; };
template <int OFF> __device__ __forceinline__ bf16x8 k_read(int a) { bf16x8 r; asm volatile("ds_read_b128 %0, %1 offset:%2" : "=v"(r) : "v"(a), "i"(OFF) : "memory"); return r; }
__device__ __forceinline__ void k_issue(KFrag& k, const int (&ka)[DQK / 16], int so) {
#pragma unroll
  for (int d0 = 0; d0 < DQK / 16; ++d0) { const int a = ka[d0] + so; k.f[2 * d0] = k_read<0>(a); k.f[2 * d0 + 1] = k_read<32 * 256>(a); }
}
__device__ __forceinline__ void dma16(const void* g, unsigned ldsaddr) { unsigned keep;
  asm volatile("s_mov_b32 %0, m0\n\ts_mov_b32 m0, %2\n\ts_nop 0\n\tglobal_load_lds_dwordx4 %1, off\n\ts_mov_b32 m0, %0" : "=&s"(keep) : "v"(g), "s"(ldsaddr) : "memory"); }
#define AT_KW(N, A, B) asm volatile("s_waitcnt lgkmcnt(" #N ")" : "+v"(A), "+v"(B))
#define AT_MM(A, B, C) __builtin_amdgcn_mfma_f32_32x32x16_bf16(A, B, C, 0, 0, 0)
#define AT_PK4(P, BASE, OUT) do { unsigned a0 = cvt_pk_bf16(P[BASE + 0], P[BASE + 1]), a1 = cvt_pk_bf16(P[BASE + 2], P[BASE + 3]);   \
    unsigned b0 = cvt_pk_bf16(P[BASE + 4], P[BASE + 5]), b1 = cvt_pk_bf16(P[BASE + 6], P[BASE + 7]);                              \
    auto r0 = __builtin_amdgcn_permlane32_swap(a0, b0, false, false); auto r1 = __builtin_amdgcn_permlane32_swap(a1, b1, false, false); \
    u32x4 w = {r0[0], r1[0], r0[1], r1[1]}; OUT = *reinterpret_cast<bf16x8*>(&w); } while (0)
template <bool PREV> __device__ __forceinline__ void qk_block(f32x16& n0, f32x16& n1, KFrag& k, const bf16x8* qr, const float zf, f32x16& P0, f32x16& P1, float& psum, float& l_reg, bf16x8& pa0, bf16x8& pa1, bf16x8& pa2, bf16x8& pa3) {
  f32x16 z; _Pragma("unroll") for (int r = 0; r < 16; ++r) z[r] = zf;
  float ps = 0.f;
  if (PREV) {
#pragma unroll
    for (int r = 0; r < 16; ++r) P1[r] = __builtin_amdgcn_exp2f(P1[r]);
    asm volatile("s_waitcnt lgkmcnt(10)" : "+v"(k.f[0]), "+v"(k.f[1]), "+v"(P1)); }
  else AT_KW(10, k.f[0], k.f[1]);
  n0 = AT_MM(k.f[0], qr[0], z); n1 = AT_MM(k.f[1], qr[0], z);
  if (PREV) {
#pragma unroll
    for (int r = 0; r < 16; ++r) ps += P0[r]; }
  AT_SBAR();
  AT_KW(8, k.f[2], k.f[3]); n0 = AT_MM(k.f[2], qr[1], n0); n1 = AT_MM(k.f[3], qr[1], n1);
  if (PREV) {
#pragma unroll
    for (int r = 0; r < 16; ++r) ps += P1[r]; }
  AT_SBAR();
  AT_KW(6, k.f[4], k.f[5]); n0 = AT_MM(k.f[4], qr[2], n0); n1 = AT_MM(k.f[5], qr[2], n1);
  if (PREV) { AT_PK4(P0, 0, pa0); AT_PK4(P0, 8, pa1); }
  AT_SBAR();
  AT_KW(4, k.f[6], k.f[7]); n0 = AT_MM(k.f[6], qr[3], n0); n1 = AT_MM(k.f[7], qr[3], n1);
  if (PREV) { AT_PK4(P1, 0, pa2); AT_PK4(P1, 8, pa3); }
  AT_SBAR();
  AT_KW(2, k.f[8], k.f[9]); n0 = AT_MM(k.f[8], qr[4], n0); n1 = AT_MM(k.f[9], qr[4], n1);
  if (PREV) { auto rr = __builtin_amdgcn_permlane32_swap(__float_as_uint(ps), __float_as_uint(ps), false, false);
    ps = __uint_as_float(rr[0]) + __uint_as_float(rr[1]); l_reg += ps; psum = ps; }
  AT_SBAR();
  AT_KW(0, k.f[10], k.f[11]); n0 = AT_MM(k.f[10], qr[5], n0); n1 = AT_MM(k.f[11], qr[5], n1);
  AT_SBAR();
}
__device__ __forceinline__ int v_st(int k, int c) { const int kk = (k & ~0xC) | ((k & 4) << 1) | ((k & 8) >> 1); return ((kk >> 3) * 2 + (c >> 5)) * 512 + ((kk & 7) * 32 + (c & 31)) * 2; }
__device__ __forceinline__ int v_rd_base(int lane) { return ((lane & 3) << 3) | (((lane >> 2) & 3) << 6) | (((lane >> 4) & 1) << 5) | (((lane >> 5) & 1) << 8); }
constexpr int v_rd_off(int d0, int ks, int half) { return d0 * 512 + ks * 2048 + half * 1024; }
template <int OFF> __device__ __forceinline__ s16x4 tr_read(int vb) {
  s16x4 r; asm volatile("ds_read_b64_tr_b16 %0, %1 offset:%2" : "=&v"(r) : "v"(vb), "i"(OFF) : "memory"); return r;
}
struct VFrag { s16x4 f[16]; };
__device__ __forceinline__ void pv_issue(VFrag& v, int vb) {
  v.f[0] = tr_read<v_rd_off(0, 0, 0)>(vb);  v.f[1] = tr_read<v_rd_off(0, 0, 1)>(vb);  v.f[2] = tr_read<v_rd_off(1, 0, 0)>(vb);  v.f[3] = tr_read<v_rd_off(1, 0, 1)>(vb);
  v.f[4] = tr_read<v_rd_off(0, 1, 0)>(vb);  v.f[5] = tr_read<v_rd_off(0, 1, 1)>(vb);  v.f[6] = tr_read<v_rd_off(1, 1, 0)>(vb);  v.f[7] = tr_read<v_rd_off(1, 1, 1)>(vb);
  v.f[8] = tr_read<v_rd_off(0, 2, 0)>(vb);  v.f[9] = tr_read<v_rd_off(0, 2, 1)>(vb);  v.f[10] = tr_read<v_rd_off(1, 2, 0)>(vb); v.f[11] = tr_read<v_rd_off(1, 2, 1)>(vb);
  v.f[12] = tr_read<v_rd_off(0, 3, 0)>(vb); v.f[13] = tr_read<v_rd_off(0, 3, 1)>(vb); v.f[14] = tr_read<v_rd_off(1, 3, 0)>(vb); v.f[15] = tr_read<v_rd_off(1, 3, 1)>(vb);
}
#define AT_VW(N, V, I) asm volatile("s_waitcnt lgkmcnt(" #N ")" : "+v"(V.f[I]), "+v"(V.f[I + 1]), "+v"(V.f[I + 2]), "+v"(V.f[I + 3]))
#define AT_PK(L, H) (bf16x8){L[0], L[1], L[2], L[3], H[0], H[1], H[2], H[3]}
template <bool NEXT> __device__ __forceinline__ void pv_block(f32x16* o, VFrag& v, bf16x8 pa0, bf16x8 pa1, bf16x8 pa2, bf16x8 pa3, f32x16& n0, f32x16& n1, float& m_reg, float& l_reg, float psum, float& alpha) {
  if (NEXT) {
#pragma unroll
    for (int r = 0; r < 4; ++r) n0[r] = __builtin_amdgcn_exp2f(n0[r]);
    asm volatile("s_waitcnt lgkmcnt(12)" : "+v"(v.f[0]), "+v"(v.f[1]), "+v"(v.f[2]), "+v"(v.f[3]), "+v"(n0)); }
  else AT_VW(12, v, 0);
  o[0] = AT_MM(pa0, AT_PK(v.f[0], v.f[1]), o[0]); o[1] = AT_MM(pa0, AT_PK(v.f[2], v.f[3]), o[1]);
  if (NEXT) {
#pragma unroll
    for (int r = 4; r < 8; ++r) n0[r] = __builtin_amdgcn_exp2f(n0[r]);
    asm volatile("s_waitcnt lgkmcnt(8)" : "+v"(v.f[4]), "+v"(v.f[5]), "+v"(v.f[6]), "+v"(v.f[7]), "+v"(n0)); }
  else AT_VW(8, v, 4);
  o[0] = AT_MM(pa1, AT_PK(v.f[4], v.f[5]), o[0]); o[1] = AT_MM(pa1, AT_PK(v.f[6], v.f[7]), o[1]);
  if (NEXT) {
#pragma unroll
    for (int r = 8; r < 12; ++r) n0[r] = __builtin_amdgcn_exp2f(n0[r]);
    asm volatile("s_waitcnt lgkmcnt(4)" : "+v"(v.f[8]), "+v"(v.f[9]), "+v"(v.f[10]), "+v"(v.f[11]), "+v"(n0)); }
  else AT_VW(4, v, 8);
  o[0] = AT_MM(pa2, AT_PK(v.f[8], v.f[9]), o[0]); o[1] = AT_MM(pa2, AT_PK(v.f[10], v.f[11]), o[1]);
  if (NEXT) {
#pragma unroll
    for (int r = 12; r < 16; ++r) n0[r] = __builtin_amdgcn_exp2f(n0[r]);
    asm volatile("s_waitcnt lgkmcnt(0)" : "+v"(v.f[12]), "+v"(v.f[13]), "+v"(v.f[14]), "+v"(v.f[15]), "+v"(n0)); }
  else AT_VW(0, v, 12);
  o[0] = AT_MM(pa3, AT_PK(v.f[12], v.f[13]), o[0]); o[1] = AT_MM(pa3, AT_PK(v.f[14], v.f[15]), o[1]);
  AT_SBAR();
  if (NEXT) {
    alpha = 1.f;
    if (!__all(psum <= THR2)) { const float ex = fmaxf(__builtin_amdgcn_logf(psum), 0.f); alpha = __builtin_amdgcn_exp2f(-ex); m_reg += ex; l_reg *= alpha;
#pragma unroll
      for (int r = 0; r < 16; ++r) { n0[r] *= alpha; n1[r] -= ex; } } }
}
#undef AT_PK
__device__ __forceinline__ void attn_unit(const bf16_t* __restrict__ Qg, const bf16_t* __restrict__ Kg, const bf16_t* __restrict__ Vg, bf16_t* __restrict__ Og,
                                          int qrow0, int h, int ctxrow0, int xrow0, int nctx_t, int NT, char* lds, int wid) {
  const int tid = hidden_tid(wid), lane = tid & 63, r32 = lane & 31, hi = lane >> 5;
  const unsigned lds0 = (unsigned)(uintptr_t)lds;
  float* ws = (float*)(lds + NSLOT * SLOT_B) + wid * 64; float* li_l = ws; float* al_l = ws + 32;
  float m_reg = -1e30f, l_reg = 0; f32x16 o[2] = {}; bf16x8 qr[DQK / 16];
  const bf16_t* Kh = Kg + h * 96; const bf16_t* Vh = Vg + h * 64;
  const int kra = 8 * wid + (lane >> 4), krb = kra + 4, cpos = lane & 15, ca = cpos ^ (kra & 15), cb = cpos ^ (krb & 15);
  const bool va = ca < 12, vb_ = cb < 12; const int koffa = kra * 768 + ca * 8, koffb = krb * 768 + cb * 8;
  const int vu = wid * 64 + lane, vsub = vu >> 5, vkk = (vsub >> 1) * 8 + ((vu >> 2) & 7), vk = (vkk & ~0xC) | ((vkk & 4) << 1) | ((vkk & 8) >> 1), voff = vk * 512 + (vsub & 1) * 32 + (vu & 3) * 8;
#define AT_KROW(j) ((j) < nctx_t ? ctxrow0 + (j) * KVBLK : xrow0 + ((j) - nctx_t) * KVBLK)
#define AT_SLOT(t) (((t) & (NSLOT - 1)) * SLOT_B)
#define AT_DMA(t) do { const int _kr = AT_KROW(t); const unsigned _sb = lds0 + AT_SLOT(t); const bf16_t* _kp = Kh + (size_t)_kr * 768;                 \
    if (va) dma16(_kp + koffa, _sb + wid * 2048); if (vb_) dma16(_kp + koffb, _sb + wid * 2048 + 1024); dma16(Vh + (size_t)_kr * 512 + voff, _sb + SHM_K + wid * 1024); } while (0)
#define AT_TOP(t) do { if ((t) + 1 < NT) asm volatile("s_waitcnt vmcnt(3)" ::: "memory"); else asm volatile("s_waitcnt vmcnt(0)" ::: "memory"); __syncthreads(); if ((t) + 2 < NT) AT_DMA((t) + 2); } while (0)
#define AT_RESC(a) do { if (__any((a) < 1.f)) { if (hi == 0) al_l[r32] = (a); asm volatile("s_waitcnt lgkmcnt(0)" ::: "memory"); \
    _Pragma("unroll") for (int d = 0; d < 2; ++d) _Pragma("unroll") for (int r = 0; r < 16; ++r) o[d][r] *= al_l[crow(r, hi)]; } } while (0)
  AT_DMA(0); AT_DMA(1);
  const bf16_t* Qw = Qg + (size_t)(qrow0 + wid * QBLK + r32) * 768 + h * 96 + hi * 8;
#pragma unroll
  for (int d0 = 0; d0 < DQK / 16; ++d0) qr[d0] = *reinterpret_cast<const bf16x8*>(Qw + d0 * 16);
  const int vb0 = (int)lds0 + SHM_K + v_rd_base(lane);
  f32x16 pA0, pA1, pB0, pB1; float mnA, alA, alB, psum = 0.f; bf16x8 pa0, pa1, pa2, pa3; KFrag kf; VFrag vf;
  int ka[DQK / 16];
#pragma unroll
  for (int d0 = 0; d0 < DQK / 16; ++d0) ka[d0] = (int)lds0 + AT_KSWZ(r32, (d0 * 16 + hi * 8) * 2);
  asm volatile("s_waitcnt vmcnt(0)" ::: "memory"); __syncthreads(); AT_DMA(2);
  k_issue(kf, ka, 0); AT_SBAR(); qk_block<false>(pA0, pA1, kf, qr, 0.f, pA0, pA1, psum, l_reg, pa0, pa1, pa2, pa3); headSM(pA0, pA1, m_reg, mnA, alA);

  for (int t = 1; t + 1 < NT; t += 2) {
    AT_TOP(t);
    AT_SBAR(); k_issue(kf, ka, AT_SLOT(t)); AT_SBAR(); qk_block<true>(pB0, pB1, kf, qr, -m_reg, pA0, pA1, psum, l_reg, pa0, pa1, pa2, pa3);
    pv_issue(vf, vb0 + AT_SLOT(t - 1)); AT_SBAR(); pv_block<true>(o, vf, pa0, pa1, pa2, pa3, pB0, pB1, m_reg, l_reg, psum, alB);
    AT_RESC(alB);
    AT_TOP(t + 1);
    AT_SBAR(); k_issue(kf, ka, AT_SLOT(t + 1)); AT_SBAR(); qk_block<true>(pA0, pA1, kf, qr, -m_reg, pB0, pB1, psum, l_reg, pa0, pa1, pa2, pa3);
    pv_issue(vf, vb0 + AT_SLOT(t)); AT_SBAR(); pv_block<true>(o, vf, pa0, pa1, pa2, pa3, pA0, pA1, m_reg, l_reg, psum, alA);
    AT_RESC(alA);
  }
  AT_TOP(NT - 1);
  AT_SBAR(); k_issue(kf, ka, AT_SLOT(NT - 1)); AT_SBAR(); qk_block<true>(pB0, pB1, kf, qr, -m_reg, pA0, pA1, psum, l_reg, pa0, pa1, pa2, pa3);
  pv_issue(vf, vb0 + AT_SLOT(NT - 2)); AT_SBAR(); pv_block<true>(o, vf, pa0, pa1, pa2, pa3, pB0, pB1, m_reg, l_reg, psum, alB);
  AT_RESC(alB);
  { float ps = 0.f;
#pragma unroll
    for (int r = 0; r < 16; ++r) pB1[r] = __builtin_amdgcn_exp2f(pB1[r]);
#pragma unroll
    for (int r = 0; r < 16; ++r) ps += pB0[r];
#pragma unroll
    for (int r = 0; r < 16; ++r) ps += pB1[r];
    { auto rr = __builtin_amdgcn_permlane32_swap(__float_as_uint(ps), __float_as_uint(ps), false, false); ps = __uint_as_float(rr[0]) + __uint_as_float(rr[1]); }
    l_reg += ps; AT_PK4(pB0, 0, pa0); AT_PK4(pB0, 8, pa1); AT_PK4(pB1, 0, pa2); AT_PK4(pB1, 8, pa3); }
  AT_SBAR();
  pv_issue(vf, vb0 + AT_SLOT(NT - 1)); pv_block<false>(o, vf, pa0, pa1, pa2, pa3, pB0, pB1, m_reg, l_reg, psum, alB);
  if (hi == 0) li_l[r32] = l_reg; asm volatile("s_waitcnt lgkmcnt(0)" ::: "memory");
  float rli[16];
#pragma unroll
  for (int r = 0; r < 16; ++r) rli[r] = __builtin_amdgcn_rcpf(li_l[crow(r, hi)]);
  bf16_t* Ow = Og + (size_t)(qrow0 + wid * QBLK) * 512 + h * 64;
  { const unsigned obase = lds0 + (wid < 7 ? (unsigned)(NSLOT * SLOT_B + 2048 + wid * 4096) : (unsigned)(fg::STAGE_BYTES + 1024));
    LAS bf16_t* ot = (LAS bf16_t*)(size_t)obase;
#pragma unroll
    for (int r = 0; r < 16; ++r) { const int orow = crow(r, hi);
#pragma unroll
      for (int d0 = 0; d0 < 2; ++d0) ot[orow * 64 + d0 * 32 + r32] = f2bf(o[d0][r] * rli[r]); }
#pragma unroll
    for (int i = 0; i < 4; ++i) { const int q = i * 64 + lane, row = q >> 3, c16 = q & 7;
      const u32x4 w = *(const LAS u32x4*)(size_t)(obase + row * 128 + c16 * 16); *(u32x4*)(Ow + (size_t)row * 512 + c16 * 8) = w; } }
  __syncthreads();
#undef AT_KROW
#undef AT_SLOT
#undef AT_DMA
#undef AT_TOP
#undef AT_RESC
}
}

struct EpiBf16 { bf16_t* o; int ld;
    __device__ __forceinline__ void operator()(const f32x4 (&acc)[2][2][4][2], const fg::GU& u, int wr, int wc, int fr, int fq) const {
#pragma unroll
        for (int ai = 0; ai < 2; ++ai)
#pragma unroll
            for (int m = 0; m < 4; ++m) { const int row = u.r0 + ai * 128 + wr * 64 + m * 16 + fr;
#pragma unroll
                for (int bj = 0; bj < 2; ++bj) *(u32x4*)(o + (size_t)row * ld + u.c0 + bj * 128 + wc * 32 + 8 * fq) = pack8(acc[ai][bj][m][0], acc[ai][bj][m][1]); }
    }
};
struct SchedF2c { const char* T; const char* ZT;
    __device__ __forceinline__ bool next(int i, fg::GU& u) const { const int c = bid_() - 192; if (i > 0 || c < 0 || c >= 16) return false; const int b = c >> 1, pn = c & 1;
        u.a = T; u.b = ZT + ((size_t)b * 512 + pn * 256) * 512 * 2; u.r0 = RX + b * CTX; u.c0 = pn * 256; u.kind = 0; u.aux = 0; u.gl = nullptr; u.gn = 256; return true; } };
__device__ __forceinline__ void attn_phase(const Ptrs& P, int l, char* lds, int wid) {
    const int c = bid_(); const bf16_t* Q = WSP(bf16_t, OFF_Q); const bf16_t* K = WSP(bf16_t, OFF_K); const bf16_t* V = WSP(bf16_t, OFF_V); bf16_t* O = WSP(bf16_t, OFF_ATT);
    { const int x = c & 7, sidx = c >> 3;
#pragma unroll
      for (int k = 0; k < 2; ++k) { const int loc = sidx + 32 * k; const int bh = x * 8 + (loc >> 3), qb = loc & 7; const int b = bh >> 3, h = bh & 7;
          at::attn_unit(Q, K, V, O, b * SEQ + qb * 256, h, RX + b * CTX, b * SEQ, CTX / 64, (CTX + SEQ) / 64, lds, wid); } }
    if (l == 0 && c >= 128 && c < 192) { const int j = c - 128, b = j >> 3, h = j & 7;
        at::attn_unit(Q, K, V, O, RX + b * CTX, h, RX + b * CTX, 0, CTX / 64, CTX / 64, lds, wid); }
}

__device__ __forceinline__ void moe_tr_tile(const Ptrs& P, int l, int t, const float*& src, int& ld, char*& dst, int& K, bool& o8) {
    const int e = t / 96, r = t % 96;
    if (r < 64) { const int nb = r >> 3, kb = r & 7, pn = nb >> 2, half = (nb >> 1) & 1, sub = nb & 1;
        const float* base = half ? (e < NE ? P.w_up_e + ((size_t)l * NE + e) * DM * FE : P.w_up_s + (size_t)l * DM * FE) : (e < NE ? P.w_gate_e + ((size_t)l * NE + e) * DM * FE : P.w_gate_s + (size_t)l * DM * FE);
        ld = FE; K = DM; o8 = true; src = base + (size_t)(128 * kb) * FE + 128 * pn + 64 * sub; dst = P.ws + OFF_WGU + ((size_t)e * 512 + 64 * nb) * DM + 128 * kb; }
    else { const int q = r - 64, nb = q >> 1, kb = q & 1;
        const float* base = e < NE ? P.w_down_e + ((size_t)l * NE + e) * FE * DM : P.w_down_s + (size_t)l * FE * DM;
        ld = DM; K = FE; o8 = false; src = base + (size_t)(128 * kb) * DM + 64 * nb; dst = P.ws + OFF_WD + (((size_t)e * DM + 64 * nb) * FE + 128 * kb) * 2; }
}
__device__ __forceinline__ void moe_tr_dma(const float* src, int ld, LAS unsigned char* buf, int tid, int wid) {
#pragma unroll
    for (int i = 0; i < 4; ++i) { const int e = tid + 512 * i, kk = e >> 4, n4 = (e & 15) * 4; const float* g = src + (size_t)kk * ld + n4; unsigned keep;
        asm volatile("s_mov_b32 %0, m0\n\ts_mov_b32 m0, %2\n\ts_nop 0\n\tglobal_load_lds_dwordx4 %1, off\n\ts_mov_b32 m0, %0" : "=&s"(keep) : "v"(g), "s"((unsigned)(size_t)(buf + (wid * 64 + 512 * i) * 16)) : "memory"); }
}
__device__ __forceinline__ void prep_moe(const Ptrs& P, int l, LAS unsigned char* lds, int wid, int wg0) {
    const int G = (int)gridDim.x - wg0, me = bid_() - wg0; if (me < 0) return;
    const int tid = hidden_tid(wid); constexpr int NT = 33 * 96;
    const float* src = nullptr; int ld = 0; char* dst = nullptr; int K = 0; bool o8 = false; int cur = 0;
    int t = me; if (t >= NT) return;
    moe_tr_tile(P, l, t, src, ld, dst, K, o8); moe_tr_dma(src, ld, lds, tid, wid);
    for (; t < NT; t += G) {
        asm volatile("s_waitcnt vmcnt(0)" ::: "memory"); __syncthreads();
        char* cdst = dst; const int cK = K; const bool co8 = o8; const LAS float* tile = (const LAS float*)(lds + cur * 32768);
        if (t + G < NT) { moe_tr_tile(P, l, t + G, src, ld, dst, K, o8); moe_tr_dma(src, ld, lds + (cur ^ 1) * 32768, tid, wid); }
#pragma unroll
        for (int i = 0; i < 2; ++i) { const int e = tid + 512 * i, nn = e & 63, kc = (e >> 6) * 8; float v[8];
#pragma unroll
            for (int j = 0; j < 8; ++j) v[j] = tile[(kc + j) * 64 + nn];
            if (co8) *(u32x2*)((u8*)cdst + (size_t)nn * cK + kc) = pk8_fp8(v, W8SC); else *(u32x4*)((bf16_t*)cdst + (size_t)nn * cK + kc) = pk8(v); }
        __syncthreads(); cur ^= 1; }
    asm volatile("s_waitcnt vmcnt(0)" ::: "memory");
}
struct MoeTile { int e, i, gn, r0; };
__device__ __forceinline__ bool moe_tile(const LAS int* base, const LAS int* cnt, int rt, int nMl, MoeTile& t) {
    const int T = base[NE] >> 8;
    if (rt < T) { int e = 0;
        for (int k = 1; k < NE; ++k) e = (base[k] <= rt * 256) ? k : e;
        t.e = e; t.i = rt - (base[e] >> 8); const int rem = cnt[e] - t.i * 256; t.gn = rem < 256 ? rem : 256; t.r0 = rt * 256; return true; }
    const int ts = rt - T; if (ts >= nMl) return false;
    t.e = NE; t.i = ts; t.gn = 256; t.r0 = SLOTS + ts * 256; return true;
}
struct SchedMoe1 { const char* H2; const char* WGU; const LAS int* base; const LAS int* cnt; const int* toklist; const int* idl; int nMl;
    __device__ __forceinline__ bool next(int i, fg::GU& u) const { const int L = i * (int)gridDim.x + bid_(); const int nrt = (base[NE] >> 8) + nMl; if (L >= nrt * 2) return false;
        int rt, pn; fg::tile_order(L, nrt, 2, rt, pn); MoeTile t; moe_tile(base, cnt, rt, nMl, t);
        u.a = H2; u.b = WGU + ((size_t)t.e * 512 + pn * 256) * DM; u.gl = t.e < NE ? toklist + (size_t)t.e * RT + t.i * 256 : idl + t.i * 256; u.gn = t.gn;
        u.kind = t.e; u.r0 = t.r0; u.c0 = pn * 128; u.aux = t.i * 256; return true; } };
struct EpiAct { bf16_t* act; const float* wlist;
    __device__ __forceinline__ void operator()(const f32x4 (&acc)[2][2][4][2], const fg::GU& u, int wr, int wc, int fr, int fq) const {
#pragma unroll
        for (int ai = 0; ai < 2; ++ai)
#pragma unroll
            for (int m = 0; m < 4; ++m) { const int lr = ai * 128 + wr * 64 + m * 16 + fr; const int lc = lr < u.gn ? lr : u.gn - 1;
                const float w = u.kind < NE ? wlist[(size_t)u.kind * RT + u.aux + lc] : 1.f; f32x4 o[2];
#pragma unroll
                for (int n = 0; n < 2; ++n)
#pragma unroll
                    for (int j = 0; j < 4; ++j) { const float g = acc[ai][0][m][n][j] * (1.f / W8SC); o[n][j] = g * fast_sigmoid(g) * (acc[ai][1][m][n][j] * (1.f / W8SC)) * w; }
                *(u32x4*)(act + (size_t)(u.r0 + lr) * FE + u.c0 + wc * 32 + 8 * fq) = pack8(o[0], o[1]); }
    }
};
struct SchedMoe2 { const char* ACT; const char* WD; const LAS int* base; const LAS int* cnt; int nMl;
    __device__ __forceinline__ bool next(int i, fg::GU& u) const { const int L = i * (int)gridDim.x + bid_(); const int nrt = (base[NE] >> 8) + nMl; if (L >= nrt * 4) return false;
        int rt, pn; fg::tile_order(L, nrt, 4, rt, pn); MoeTile t; moe_tile(base, cnt, rt, nMl, t);
        u.a = ACT + (size_t)t.r0 * FE * 2; u.b = WD + ((size_t)t.e * DM + pn * 256) * FE * 2; u.gl = nullptr; u.gn = 256;
        u.kind = t.e; u.r0 = t.e < NE ? t.r0 : t.i * 256; u.c0 = pn * 256; u.aux = 0; return true; } };
constexpr float YSC = 8.f;
__device__ __forceinline__ float y8(float v) { return __builtin_amdgcn_fmed3f(v * YSC, -448.f, 448.f); }
__device__ __forceinline__ u32x2 pack8_fp8(const f32x4& v0, const f32x4& v1) { int a = __builtin_amdgcn_cvt_pk_fp8_f32(y8(v0[0]), y8(v0[1]), 0, false); a = __builtin_amdgcn_cvt_pk_fp8_f32(y8(v0[2]), y8(v0[3]), a, true);
    int b = __builtin_amdgcn_cvt_pk_fp8_f32(y8(v1[0]), y8(v1[1]), 0, false); b = __builtin_amdgcn_cvt_pk_fp8_f32(y8(v1[2]), y8(v1[3]), b, true); return (u32x2){(unsigned)a, (unsigned)b}; }
struct EpiY { u8* y; u8* ys;
    __device__ __forceinline__ void operator()(const f32x4 (&acc)[2][2][4][2], const fg::GU& u, int wr, int wc, int fr, int fq) const {
        u8* o = u.kind < NE ? y : ys;
#pragma unroll
        for (int ai = 0; ai < 2; ++ai)
#pragma unroll
            for (int m = 0; m < 4; ++m) { const int row = u.r0 + ai * 128 + wr * 64 + m * 16 + fr;
#pragma unroll
                for (int bj = 0; bj < 2; ++bj) *(u32x2*)(o + (size_t)row * DM + u.c0 + bj * 128 + wc * 32 + 8 * fq) = pack8_fp8(acc[ai][bj][m][0], acc[ai][bj][m][1]); }
    }
};

__device__ __forceinline__ void ada_phase(const Ptrs& P, float* ldsf, int wid) {
    const int tid = hidden_tid(wid); float* sl = ldsf; float* red = ldsf + 9 * DM;
    for (int e = tid; e < 9 * DM; e += 512) { const int ar = e >> 10, k = e & 1023; const float v = ar < NB ? P.c[ar * DM + k] : P.c_ctx[k]; sl[e] = v * sigmoidf_(v); }
    __syncthreads();
    constexpr int CW = 48, NCH = 6144 / CW;
    for (int ch = bid_(); ch < 2 * NCH; ch += gridDim.x) { const int l = ch / NCH, c0 = (ch % NCH) * CW, cc = tid & 63, kg = tid >> 6; const bool act = cc < CW;
        const float* w = P.w_ada + (size_t)l * DM * 6144 + (size_t)(kg * 128) * 6144 + c0 + (act ? cc : 0); float acc[9];
#pragma unroll
        for (int r = 0; r < 9; ++r) acc[r] = 0.f;
#pragma unroll 1
        for (int k0 = 0; k0 < 128; k0 += 32) { float wv[32];
#pragma unroll
            for (int j = 0; j < 32; ++j) wv[j] = w[(size_t)(k0 + j) * 6144];
#pragma unroll
            for (int j4 = 0; j4 < 8; ++j4)
#pragma unroll
                for (int r = 0; r < 9; ++r) { const f32x4 s4 = *(const f32x4*)(sl + r * DM + kg * 128 + k0 + 4 * j4);
#pragma unroll
                    for (int q = 0; q < 4; ++q) acc[r] += s4[q] * wv[4 * j4 + q]; } }
        if (act) {
#pragma unroll
            for (int r = 0; r < 9; ++r) red[(kg * 9 + r) * 64 + cc] = acc[r]; }
        __syncthreads();
        for (int e = tid; e < 9 * CW; e += 512) { const int r = e / CW, c = e % CW; float s = 0.f;
#pragma unroll
            for (int g = 0; g < 8; ++g) s += red[(g * 9 + r) * 64 + c];
            WSP(float, OFF_ADA)[((size_t)l * 9 + r) * 6144 + c0 + c] = s + P.b_ada[l * 6144 + c0 + c]; }
        __syncthreads(); }
}
__device__ __forceinline__ void misc_prep(const Ptrs& P, int wid) {
    const size_t nthr = (size_t)gridDim.x * 512, gid = (size_t)bid_() * 512 + hidden_tid(wid);
    for (size_t idx = gid; idx < (size_t)SEQ * 16; idx += nthr) { const int n = idx / 16, i = idx % 16; const int r = n / 64, col = n % 64;
        const float inv = powf(10000.f, -(float)(i & 7) / 8.f); const float ang = (float)(i < 8 ? r : col) * inv;
        float* t = WSP(float, OFF_ROPE) + idx * 2; t[0] = (float)cos((double)ang); t[1] = (float)sin((double)ang); }
    for (size_t idx = gid; idx < (size_t)2 * NE * DM; idx += nthr) { const int k = idx & 1023, e = (idx >> 10) & 31, l = idx >> 15; const float w = P.w_router[(size_t)l * DM * NE + (size_t)k * NE + e];
        const bf16_t hi = f2bf(w); const bf16_t lo = f2bf(w - bf2f(hi)); bf16_t* wr = WSP(bf16_t, OFF_WR) + (size_t)l * 2 * NE * DM; wr[e * DM + k] = hi; wr[NE * DM + e * DM + k] = lo; }
}
__device__ __forceinline__ void ld16_f32(const float* p, int lane, float (&v)[16]) {
#pragma unroll
    for (int c = 0; c < 2; ++c) { const f32x4 a = *(const f32x4*)(p + c * 512 + lane * 8), b = *(const f32x4*)(p + c * 512 + lane * 8 + 4);
#pragma unroll
        for (int j = 0; j < 4; ++j) { v[c * 8 + j] = a[j]; v[c * 8 + 4 + j] = b[j]; } } }
__device__ __forceinline__ void ld16_bf16(const bf16_t* p, int lane, float (&v)[16]) {
#pragma unroll
    for (int c = 0; c < 2; ++c) { const u32x4 w = *(const u32x4*)(p + c * 512 + lane * 8);
#pragma unroll
        for (int t = 0; t < 4; ++t) { v[c * 8 + 2 * t] = bflo(w[t]); v[c * 8 + 2 * t + 1] = bfhi(w[t]); } } }
__device__ __forceinline__ void ld16_fp8(const u8* p, int lane, float (&v)[16]) {
#pragma unroll
    for (int c = 0; c < 2; ++c) { const u32x2 w = *(const u32x2*)(p + c * 512 + lane * 8);
#pragma unroll
        for (int t = 0; t < 2; ++t) { const auto lo = __builtin_amdgcn_cvt_pk_f32_fp8((int)w[t], false), hi = __builtin_amdgcn_cvt_pk_f32_fp8((int)w[t], true);
            v[c * 8 + 4 * t] = lo[0]; v[c * 8 + 4 * t + 1] = lo[1]; v[c * 8 + 4 * t + 2] = hi[0]; v[c * 8 + 4 * t + 3] = hi[1]; } } }
__device__ __forceinline__ void st16_f32(float* p, int lane, const float (&v)[16]) {
#pragma unroll
    for (int c = 0; c < 2; ++c) { *(f32x4*)(p + c * 512 + lane * 8) = (f32x4){v[c * 8], v[c * 8 + 1], v[c * 8 + 2], v[c * 8 + 3]}; *(f32x4*)(p + c * 512 + lane * 8 + 4) = (f32x4){v[c * 8 + 4], v[c * 8 + 5], v[c * 8 + 6], v[c * 8 + 7]}; } }
__device__ __forceinline__ void st16_fp8(u8* p, int lane, const float (&v)[16]) {
#pragma unroll
    for (int c = 0; c < 2; ++c) *(u32x2*)(p + c * 512 + lane * 8) = pk8_fp8(v + c * 8, 1.f); }
__device__ __forceinline__ void st16_bf16(bf16_t* p, int lane, const float (&v)[16]) {
#pragma unroll
    for (int c = 0; c < 2; ++c) *(u32x4*)(p + c * 512 + lane * 8) = pk8(v + c * 8); }
__device__ __forceinline__ void normmod0_phase(const Ptrs& P, int wid) {
    const int lane = hidden_tid(wid) & 63; const int stride = (int)gridDim.x * 8;
    float g[16]; ld16_f32(P.g_pre_mix, lane, g);
    for (int rowA = bid_() * 8 + wid; rowA < RT; rowA += 2 * stride) {
        const bool hasB = rowA + stride < RT; const int rows[2] = {rowA, hasB ? rowA + stride : rowA};
        float v[2][16], sh[2][16], sc[2][16];
#pragma unroll
        for (int q = 0; q < 2; ++q) { const int row = rows[q]; const float* src = row < RX ? P.x + (size_t)row * DM : P.ctx + (size_t)(row - RX) * DM;
            const float* ada = WSP(float, OFF_ADA) + (size_t)row_arow(row) * 6144; ld16_f32(src, lane, v[q]); ld16_f32(ada, lane, sh[q]); ld16_f32(ada + 1024, lane, sc[q]); }
#pragma unroll
        for (int q = 0; q < 2; ++q) { float ss = 0.f;
#pragma unroll
            for (int i = 0; i < 16; ++i) ss += v[q][i] * v[q][i];
            ss = wave_sum(ss); const float r = rsqrtf(ss / DM + EPS);
#pragma unroll
            for (int i = 0; i < 16; ++i) v[q][i] = v[q][i] * r * g[i] * (1.f + sc[q][i]) + sh[q][i]; }
#pragma unroll
        for (int q = 0; q < 2; ++q) if (q == 0 || hasB) { st16_bf16(WSP(bf16_t, OFF_H) + (size_t)rows[q] * DM, lane, v[q]); st16_fp8(WSP(u8, OFF_H8) + (size_t)rows[q] * DM, lane, v[q]); } }
}
__device__ __forceinline__ void conv_phase(const Ptrs& P, int l, int nrows, int wid) {
    const size_t nthr = (size_t)gridDim.x * 512, gid = (size_t)bid_() * 512 + hidden_tid(wid);
    const bf16_t* in = WSP(bf16_t, OFF_INNER); const bf16_t* cb = WSP(bf16_t, OFF_CB); bf16_t* out = WSP(bf16_t, OFF_CONV); const float* w = P.conv_w + (size_t)l * 3 * 512;
    for (size_t e = gid; e < (size_t)nrows * 64; e += nthr) { const int row = e >> 6, j = (e & 63) * 8; const bool isx = row < RX; const int len = isx ? SEQ : CTX; const int n = isx ? (row & (SEQ - 1)) : ((row - RX) & (CTX - 1));
        float y[8];
#pragma unroll
        for (int t = 0; t < 8; ++t) y[t] = 0.f;
#pragma unroll
        for (int d = 0; d < 3; ++d) { const int nn = n + d - 1; if (nn >= 0 && nn < len) { const u32x4 iv = *(const u32x4*)(in + (size_t)(row + d - 1) * 512 + j);
                const f32x4 w0 = *(const f32x4*)(w + d * 512 + j), w1 = *(const f32x4*)(w + d * 512 + j + 4);
#pragma unroll
                for (int t = 0; t < 4; ++t) { y[2 * t] += (t < 2 ? w0[2 * t] : w1[2 * t - 4]) * bflo(iv[t]); y[2 * t + 1] += (t < 2 ? w0[2 * t + 1] : w1[2 * t - 3]) * bfhi(iv[t]); } } }
        const u32x4 cv = *(const u32x4*)(cb + (size_t)row * 512 + j); u32x4 o;
#pragma unroll
        for (int t = 0; t < 4; ++t) o[t] = cvt_pk_bf16(bflo(cv[t]) * y[2 * t], bfhi(cv[t]) * y[2 * t + 1]);
        *(u32x4*)(out + (size_t)row * 512 + j) = o; }
}
template <int K> __device__ __forceinline__ int lane_xor_i(int v) { return __builtin_amdgcn_ds_swizzle(v, (K << 10) | 0x1f); }
__device__ __forceinline__ void post_mix_phase(const Ptrs& P, int l, int nrows, LAS unsigned char* lds, int wid) {
    constexpr int TS = 2064;
    const int tid = hidden_tid(wid), lane = tid & 63;
    LAS unsigned char* tHi = lds; LAS unsigned char* tLo = lds + 16 * TS; LAS float* red = (LAS float*)(lds + 32 * TS);
    LAS int* lcount = (LAS int*)(lds + 32 * TS + 16384); LAS int* gbase = lcount + 32; LAS int* pend = lcount + 64;
    if (tid < 64) lcount[tid] = 0;
    __syncthreads();
    int gi = 0;
    const bf16_t* wr = WSP(bf16_t, OFF_WR) + (size_t)l * 2 * NE * DM;
    bf16x8 bh[4][2], bl[4][2];
#pragma unroll
    for (int ks = 0; ks < 4; ++ks)
#pragma unroll
        for (int nt = 0; nt < 2; ++nt) { const size_t off = (size_t)(nt * 16 + (lane & 15)) * DM + wid * 128 + ks * 32 + 8 * (lane >> 4);
            bh[ks][nt] = *(const bf16x8*)(wr + off); bl[ks][nt] = *(const bf16x8*)(wr + (size_t)NE * DM + off); }
    const float* gpm = P.g_post_mix + l * DM; const float* gpf = P.g_pre_ffn + l * DM;
    const float brt = P.b_router[l * NE + (lane & 31)];
    int* cnt = WSP(int, OFF_CNT2) + l * 64; int* tl = WSP(int, OFF_TOKLIST); float* wl = WSP(float, OFF_WLIST);
    float gpmv[16], gpfv[16]; ld16_f32(gpm, lane, gpmv); ld16_f32(gpf, lane, gpfv);
    for (int g = bid_(); g < nrows / 16; g += gridDim.x, ++gi) {
        const int row0 = g * 16 + 2 * wid; const bool isx = row0 < RX;
        const float* ada = WSP(float, OFF_ADA) + ((size_t)l * 9 + row_arow(row0)) * 6144;
        float xv[2][16], yv[2][16], g1[16], sc2[16], sh2[16], ry[2];
        ld16_f32(ada + 2048, lane, g1); ld16_f32(ada + 4096, lane, sc2); ld16_f32(ada + 3072, lane, sh2);
#pragma unroll
        for (int rr = 0; rr < 2; ++rr) { const int row = row0 + rr;
            if (l == 0) ld16_f32(isx ? P.x + (size_t)row * DM : P.ctx + (size_t)(row - RX) * DM, lane, xv[rr]);
            else ld16_bf16(isx ? (const bf16_t*)P.out + (size_t)row * DM : WSP(bf16_t, OFF_CTXRES) + (size_t)(row - RX) * DM, lane, xv[rr]);
            ld16_bf16(WSP(bf16_t, OFF_YX) + (size_t)row * DM, lane, yv[rr]);
            const float* sp = WSP(float, OFF_SSPY) + (size_t)row * 16; const f32x4 s0 = *(const f32x4*)sp, s1 = *(const f32x4*)(sp + 4), s2 = *(const f32x4*)(sp + 8), s3 = *(const f32x4*)(sp + 12); float ssy = 0.f;
#pragma unroll
            for (int i = 0; i < 4; ++i) ssy += s0[i];
#pragma unroll
            for (int i = 0; i < 4; ++i) ssy += s1[i];
#pragma unroll
            for (int i = 0; i < 4; ++i) ssy += s2[i];
#pragma unroll
            for (int i = 0; i < 4; ++i) ssy += s3[i];
            ry[rr] = rsqrtf(ssy / DM + EPS); }
#pragma unroll
        for (int rr = 0; rr < 2; ++rr) { const int rl = 2 * wid + rr, row = row0 + rr; float ss = 0.f;
            bf16_t* dst = l == 1 ? WSP(bf16_t, OFF_X1B) + (size_t)row * DM : isx ? (bf16_t*)P.out + (size_t)row * DM : WSP(bf16_t, OFF_CTXRES) + (size_t)(row - RX) * DM;
#pragma unroll
            for (int i = 0; i < 16; ++i) { xv[rr][i] = xv[rr][i] + g1[i] * (yv[rr][i] * ry[rr] * gpmv[i]); ss += xv[rr][i] * xv[rr][i]; }
            st16_bf16(dst, lane, xv[rr]);
            ss = wave_sum(ss); const float r = rsqrtf(ss / DM + EPS);
            float hl[16];
#pragma unroll
            for (int i = 0; i < 16; ++i) { const float hv = xv[rr][i] * r * gpfv[i] * (1.f + sc2[i]) + sh2[i]; const float hh = bf2f(f2bf(hv)); yv[rr][i] = hh; hl[i] = hv - hh; }
            st16_fp8(WSP(u8, OFF_H) + (size_t)row * DM, lane, yv[rr]);
#pragma unroll
            for (int c = 0; c < 2; ++c) { *(LAS u32x4*)(tHi + rl * TS + (c * 512 + lane * 8) * 2) = pk8(yv[rr] + c * 8); *(LAS u32x4*)(tLo + rl * TS + (c * 512 + lane * 8) * 2) = pk8(hl + c * 8); } }
        __syncthreads();
        f32x4 acc[2] = {(f32x4){0.f, 0.f, 0.f, 0.f}, (f32x4){0.f, 0.f, 0.f, 0.f}};
#pragma unroll
        for (int ks = 0; ks < 4; ++ks) { const int ao = (lane & 15) * TS + (wid * 128 + ks * 32 + 8 * (lane >> 4)) * 2;
            const bf16x8 ah = *(const LAS bf16x8*)(tHi + ao), al = *(const LAS bf16x8*)(tLo + ao);
#pragma unroll
            for (int nt = 0; nt < 2; ++nt) { acc[nt] = __builtin_amdgcn_mfma_f32_16x16x32_bf16(ah, bh[ks][nt], acc[nt], 0, 0, 0);
                acc[nt] = __builtin_amdgcn_mfma_f32_16x16x32_bf16(ah, bl[ks][nt], acc[nt], 0, 0, 0); acc[nt] = __builtin_amdgcn_mfma_f32_16x16x32_bf16(al, bh[ks][nt], acc[nt], 0, 0, 0); } }
#pragma unroll
        for (int nt = 0; nt < 2; ++nt)
#pragma unroll
            for (int j = 0; j < 4; ++j) red[(wid * 16 + 4 * (lane >> 4) + j) * 32 + nt * 16 + (lane & 15)] = acc[nt][j];
        __syncthreads();
        {
            const int e = lane & 31, rl = 2 * wid + (lane >> 5), row = g * 16 + rl; float lg = 0.f;
#pragma unroll
            for (int w = 0; w < 8; ++w) lg += red[(w * 16 + rl) * 32 + e];
            const float sc = sigmoidf_(lg); float key = sc + brt; int sel[TOPK]; float selw[TOPK]; float ssum = 0.f;
#pragma unroll
            for (int j = 0; j < TOPK; ++j) { float bk = key, bs = sc; int bi = e;
#define PM_STEP(KX) { const float ok = lane_xor<KX>(bk), os = lane_xor<KX>(bs); const int oi = lane_xor_i<KX>(bi); const bool take = (ok > bk) || (ok == bk && oi < bi); bk = take ? ok : bk; bs = take ? os : bs; bi = take ? oi : bi; }
                PM_STEP(1) PM_STEP(2) PM_STEP(4) PM_STEP(8) PM_STEP(16)
#undef PM_STEP
                sel[j] = bi; selw[j] = bs; ssum += bs; key = (e == bi) ? -1e30f : key; }
#pragma unroll
            for (int j = 0; j < TOPK; ++j) if (e == sel[j]) { const int lr = __hip_atomic_fetch_add(lcount + e, 1, __ATOMIC_RELAXED, __HIP_MEMORY_SCOPE_WORKGROUP); LAS int* pe = pend + ((gi * 16 + rl) * TOPK + j) * 4;
                pe[0] = e; pe[1] = lr; pe[2] = __float_as_int(selw[j] / ssum * 2.5f); pe[3] = row; } }
        __syncthreads(); }
    if (tid < NE) gbase[tid] = atomicAdd(cnt + tid, lcount[tid]);
    __syncthreads();
    { int* ti = WSP(int, OFF_TOKINFO);
      for (int p = tid; p < gi * 16 * TOPK; p += 512) { const LAS int* pe = pend + p * 4; const int e = pe[0], rank = gbase[e] + pe[1], row = pe[3]; const int j = p & (TOPK - 1);
          tl[(size_t)e * RT + rank] = row; wl[(size_t)e * RT + rank] = __int_as_float(pe[2]); ti[(size_t)row * 8 + 2 * j] = e; ti[(size_t)row * 8 + 2 * j + 1] = rank; } }
    __syncthreads();
}
__device__ __forceinline__ void moe_setup(const Ptrs& P, int l, LAS int* lbase, LAS int* lcnt, int wid) {
    __syncthreads();
    if (hidden_tid(wid) == 0) { const int* cnt = WSP(int, OFF_CNT2) + l * 64; int acc = 0; for (int e = 0; e < NE; ++e) { const int c = cnt[e]; lcnt[e] = c; lbase[e] = acc; acc += (c + 255) / 256 * 256; } lbase[NE] = acc; }
    __syncthreads();
}
__device__ __forceinline__ void acc8_fp8(u32x2 w, float* v) {
#pragma unroll
    for (int t = 0; t < 2; ++t) { const auto lo = __builtin_amdgcn_cvt_pk_f32_fp8((int)w[t], false), hi = __builtin_amdgcn_cvt_pk_f32_fp8((int)w[t], true);
        v[4 * t] += lo[0]; v[4 * t + 1] += lo[1]; v[4 * t + 2] += hi[0]; v[4 * t + 3] += hi[1]; } }
__device__ __forceinline__ void post_moe_phase(const Ptrs& P, int l, int nrows, const LAS int* lbase, int wid) {
    const int lane = hidden_tid(wid) & 63; const int stride = (int)gridDim.x * 8;
    float gp[16]; ld16_f32(P.g_post_ffn + l * DM, lane, gp);
    for (int rowA = bid_() * 8 + wid; rowA < nrows; rowA += 2 * stride) {
        const bool hasB = rowA + stride < nrows; int rows[2] = {rowA, hasB ? rowA + stride : rowA};
        u32x2 yr[2][5][2]; float xv[2][16], g2[2][16]; bf16_t* xr[2]; const float* ada[2];
#pragma unroll
        for (int q = 0; q < 2; ++q) { const int row = rows[q]; const bool isx = row < RX; xr[q] = l == 1 ? WSP(bf16_t, OFF_X1B) + (size_t)row * DM : isx ? (bf16_t*)P.out + (size_t)row * DM : WSP(bf16_t, OFF_CTXRES) + (size_t)(row - RX) * DM;
            ada[q] = WSP(float, OFF_ADA) + ((size_t)l * 9 + row_arow(row)) * 6144;
            const int* ti = WSP(int, OFF_TOKINFO) + (size_t)row * 8; const u8* Y = WSP(u8, OFF_Y);
            const u32x4 ta = *(const u32x4*)ti, tb = *(const u32x4*)(ti + 4);
            const int sl[4] = {lbase[ta[0]] + (int)ta[1], lbase[ta[2]] + (int)ta[3], lbase[tb[0]] + (int)tb[1], lbase[tb[2]] + (int)tb[3]};
            const u8* ys = WSP(u8, OFF_YS) + (size_t)row * DM;
#pragma unroll
            for (int c = 0; c < 2; ++c) { yr[q][0][c] = *(const u32x2*)(ys + c * 512 + lane * 8);
#pragma unroll
                for (int j = 0; j < 4; ++j) yr[q][1 + j][c] = *(const u32x2*)(Y + (size_t)sl[j] * DM + c * 512 + lane * 8); }
            ld16_bf16(xr[q], lane, xv[q]);
            ld16_f32(ada[q] + 5120, lane, g2[q]); }
        float v[2][16], r[2], ss2[2];
#pragma unroll
        for (int q = 0; q < 2; ++q) { float ss = 0.f;
#pragma unroll
            for (int i = 0; i < 16; ++i) v[q][i] = 0.f;
#pragma unroll
            for (int j = 0; j < 5; ++j)
#pragma unroll
                for (int c = 0; c < 2; ++c) acc8_fp8(yr[q][j][c], v[q] + c * 8);
#pragma unroll
            for (int i = 0; i < 16; ++i) { v[q][i] *= (1.f / YSC); ss += v[q][i] * v[q][i]; }
            ss = wave_sum(ss); r[q] = rsqrtf(ss / DM + EPS); ss2[q] = 0.f;
#pragma unroll
            for (int i = 0; i < 16; ++i) { v[q][i] = xv[q][i] + g2[q][i] * (v[q][i] * r[q] * gp[i]); ss2[q] += v[q][i] * v[q][i]; } }
#pragma unroll
        for (int q = 0; q < 2; ++q) if (q == 0 || hasB) { if (l == 1) st16_f32(P.out + (size_t)rows[q] * DM, lane, v[q]); else st16_bf16(xr[q], lane, v[q]);
            if (l == 0) { const float s2 = wave_sum(ss2[q]); const float r2 = rsqrtf(s2 / DM + EPS); const float* ada1 = ada[q] + 9 * 6144; float t0[16], t1[16], t2[16];
                ld16_f32(P.g_pre_mix + DM, lane, t0); ld16_f32(ada1 + 1024, lane, t1); ld16_f32(ada1, lane, t2);
#pragma unroll
                for (int i = 0; i < 16; ++i) v[q][i] = v[q][i] * r2 * t0[i] * (1.f + t1[i]) + t2[i];
                st16_bf16(WSP(bf16_t, OFF_H) + (size_t)rows[q] * DM, lane, v[q]); st16_fp8(WSP(u8, OFF_H8) + (size_t)rows[q] * DM, lane, v[q]); } }
    }
}

#define XB_TMO      128
#define XB_XCNT(j)  (256  + 64 * (j))
#define XB_XSUB(j)  (1280 + 64 * (j))
#define XB_XGEN(j)  (2304 + 64 * (j))
#define XB_TOP      3328
#define XB_TOPGEN   3392
#define XCD_BAR_WORDS 3456
#define XB_SPIN_CAP (1u << 18)
#define LAS __attribute__((address_space(3)))

__device__ __forceinline__ unsigned xb_ld(unsigned* p)              { return __hip_atomic_load(p, __ATOMIC_RELAXED, __HIP_MEMORY_SCOPE_AGENT); }
__device__ __forceinline__ unsigned xb_add(unsigned* p, unsigned v) { return __hip_atomic_fetch_add(p, v, __ATOMIC_RELAXED, __HIP_MEMORY_SCOPE_AGENT); }
__device__ __forceinline__ unsigned xb_xcc_id() { return (unsigned)__builtin_amdgcn_s_getreg((3 << 11) | 20) & 0xFu; }
#define XB_SPIN(cond, bar) do { unsigned _sp = 0; while (cond) { __builtin_amdgcn_s_sleep(1); \
    if ((++_sp & 255u) == 0u) { if (xb_ld(&(bar)[XB_TMO])) break; if (_sp > XB_SPIN_CAP) { atomicAdd(&(bar)[XB_TMO], 1u); break; } } } } while (0)

struct XcdBarrier {
    int wid;
    unsigned* bar; unsigned x;
    volatile LAS unsigned* st;
};

__device__ __forceinline__ XcdBarrier xcd_barrier_post(unsigned* bar, volatile LAS unsigned* st) {
    XcdBarrier b; b.wid = uni((int)threadIdx.x >> 6); b.bar = bar; b.x = xb_xcc_id(); b.st = st;
    if (b.wid == 0 && hidden_lane() == 0) (void)xb_add(&bar[XB_XCNT(b.x)], 1u);
    return b;
}
__device__ __forceinline__ void xcd_barrier_complete(unsigned* bar, unsigned x, unsigned& nloc, unsigned& nx) {
    const unsigned G = gridDim.x * gridDim.y * gridDim.z;
    unsigned sum, cnt, mine, sp = 0u;
    for (;;) {
        sum = 0u; cnt = 0u; mine = 0u;
#pragma unroll
        for (unsigned j = 0; j < 16; ++j) { const unsigned c = xb_ld(&bar[XB_XCNT(j)]); sum += c; cnt += (c > 0u) ? 1u : 0u; mine = (j == x) ? c : mine; }
        if (sum == G) break;
        __builtin_amdgcn_s_sleep(1);
        if ((++sp & 255u) == 0u) { if (xb_ld(&bar[XB_TMO])) break; if (sp > XB_SPIN_CAP) { atomicAdd(&bar[XB_TMO], 1u); break; } }
    }
    nloc = mine > 0u ? mine : 1u; nx = cnt > 0u ? cnt : 1u;
}

__device__ __forceinline__ void xcd_barrier(const XcdBarrier& b) {
    asm volatile("s_waitcnt vmcnt(0)" ::: "memory");
    __syncthreads();
    if (b.wid == 0 && hidden_lane() == 0) {
        unsigned* bar = b.bar;
        __builtin_amdgcn_s_waitcnt(0);
        unsigned nloc = b.st[0], nx = b.st[1];
        if (nloc == 0u) { xcd_barrier_complete(bar, b.x, nloc, nx); b.st[0] = nloc; b.st[1] = nx; }
        const unsigned old = xb_add(&bar[XB_XSUB(b.x)], 1u);
        const unsigned gen = old / nloc;
        if (old + 1u == (gen + 1u) * nloc) {
            __builtin_amdgcn_fence(__ATOMIC_RELEASE, "agent");
            asm volatile("s_waitcnt vmcnt(0)" ::: "memory");
            const unsigned og = xb_add(&bar[XB_TOP], 1u);
            const unsigned tg = og / nx;
            if (og + 1u == (tg + 1u) * nx) xb_add(&bar[XB_TOPGEN], 1u);
            else XB_SPIN(xb_ld(&bar[XB_TOPGEN]) == tg, bar);
            __builtin_amdgcn_fence(__ATOMIC_ACQUIRE, "agent");
            xb_add(&bar[XB_XGEN(b.x)], 1u);
            asm volatile("s_waitcnt vmcnt(0)" ::: "memory");
        } else {
            XB_SPIN(xb_ld(&bar[XB_XGEN(b.x)]) == gen, bar);
            __builtin_amdgcn_fence(__ATOMIC_ACQUIRE, "agent");
            asm volatile("s_waitcnt vmcnt(0)" ::: "memory");
        }
    }
    __syncthreads();
}

constexpr int N_PHASES = 20;
constexpr int MISC_OFF = fg::STAGE_BYTES;
constexpr int MK_LDS = fg::STAGE_BYTES + 1024 + 16384;
__global__ void __launch_bounds__(512, 2) mk_fwd(Args a) {
    extern __shared__ __attribute__((aligned(16))) unsigned char lds_raw[];
    LAS unsigned char* lds = (LAS unsigned char*)lds_raw;
    const Ptrs& P = a.P; const int lo = a.ph_lo, hi = a.ph_hi;
    const int wid_s = __builtin_amdgcn_readfirstlane((int)threadIdx.x >> 6);
    { const int t0 = hidden_tid(wid_s); if (t0 < 4) ((LAS unsigned*)(lds + MISC_OFF))[t0] = 0u; }
    __syncthreads();
    XcdBarrier bar; bar.wid = wid_s; bar.bar = WSP(unsigned, OFF_CTL); bar.x = 0; bar.st = nullptr;
    if (hi - lo > 1) bar = xcd_barrier_post(WSP(unsigned, OFF_CTL), (volatile LAS unsigned*)(lds + MISC_OFF));
#define IN(k) (lo <= (k) && (k) < hi)
#define SEAM(k) do { if (IN(k) && IN((k) + 1)) { XcdBarrier _b = bar; asm volatile("" : "+s"(_b.bar), "+s"(_b.x)); xcd_barrier(_b); } } while (0)
#define PHASE_P(Q) Ptrs Q = P; { char* _w = Q.ws; asm volatile("" : "+s"(_w)); Q.ws = _w; } LAS unsigned char* ldq = lds; asm volatile("" : "+s"(ldq)); int wq = wid_s; asm volatile("" : "+s"(wq)); \
    char* const ldg = (char*)ldq; LAS int* const lbase = (LAS int*)(ldq + MISC_OFF + 64); LAS int* const lcnt = (LAS int*)(ldq + MISC_OFF + 256); (void)ldg; (void)lbase; (void)lcnt
    if (IN(0)) { PHASE_P(Q); int tbase = 0; prep_mix(Q, 0, (float*)ldg, tbase, wq); prep_wz(Q, 0, (float*)ldg, tbase, wq); prep_dft(Q, wq);
        misc_prep(Q, wq); ada_phase(Q, (float*)ldg, wq); }
    SEAM(0);
    if (IN(1)) { PHASE_P(Q); normmod0_phase(Q, wq); }
    SEAM(1);
    for (int l = 0; l < 2; ++l) {
        const int pb = 2 + 9 * l; const int nMl = (l == 0 ? RT : RX) / 256, Rl = l == 0 ? RT : RX;
        if (IN(pb + 0)) { PHASE_P(Q); char* wm = Q.ws + OFF_WMIX + (size_t)l * WMIX_BYTES; EpiProj E{Q, l};
            { SchedW1 S{Q.ws + OFF_H, wm + WMIX_W1, l}; fg::gemm_phase<SchedW1, EpiProj, 0>(ldq, DM, S, E, wq); }
            { SchedGate S{Q.ws + OFF_H8, Q.ws + OFF_W1G8 + (size_t)l * 3072 * 1024, l}; EpiGate EG{Q, l}; fg::gemm_phase<SchedGate, EpiGate, 0, 0, true>(ldq, DM, S, EG, wq); }
            { SchedZx S{Q.ws + OFF_H8, wm + WMIX_WZ}; EpiZ EZ{Q}; fg::gemm_phase<SchedZx, EpiZ, 0, 1, true>(ldq, DM, S, EZ, wq); }
            if (l == 0) { SchedZc S{Q.ws + OFF_H8, wm + WMIX_WZ}; EpiZ EZ{Q}; fg::gemm_phase<SchedZc, EpiZ, 0, 0, true>(ldq, DM, S, EZ, wq); } }
        SEAM(pb + 0);
        if (IN(pb + 1)) { PHASE_P(Q); char* wm = Q.ws + OFF_WMIX + (size_t)l * WMIX_BYTES;
            { SchedPlainShift S{Q.ws + OFF_CKV, wm + WMIX_WUKV, RT / 256, 4, KV_RANK, 0}; EpiUKV E{Q}; fg::gemm_phase<SchedPlainShift, EpiUKV, 0>(ldq, KV_RANK, S, E, wq); }
            { SchedPlainShift S{Q.ws + OFF_CQ, wm + WMIX_WUQ, nMl, 3, Q_RANK, 32}; EpiUQ E{Q}; fg::gemm_phase<SchedPlainShift, EpiUQ, 0>(ldq, Q_RANK, S, E, wq); }
            { SchedFftA S{Q.ws + OFF_ZA, Q.ws + OFF_MA}; EpiFftA E{Q}; fg::gemm_phase<SchedFftA, EpiFftA, 0, 2>(ldq, 128, S, E, wq); }
            conv_phase(Q, l, Rl, wq); }
        SEAM(pb + 1);
        if (IN(pb + 2)) { PHASE_P(Q);
            { SchedFftB S{Q.ws + OFF_ZB, Q.ws + OFF_MB}; EpiFftB E{(bf16_t*)(Q.ws + OFF_FOUR)}; fg::gemm_phase<SchedFftB, EpiFftB, 0>(ldq, 128, S, E, wq); }
            if (l == 0) { SchedF2c S{Q.ws + OFF_TC, Q.ws + OFF_ZTC}; EpiBf16 E{(bf16_t*)(Q.ws + OFF_FOUR), FW}; fg::gemm_phase<SchedF2c, EpiBf16, 0>(ldq, 2 * CTX, S, E, wq); }
            attn_phase(Q, l, ldg, wq); }
        SEAM(pb + 2);
        if (IN(pb + 3)) { PHASE_P(Q); char* wm = Q.ws + OFF_WMIX + (size_t)l * WMIX_BYTES;
            SchedMerge S{Q.ws + OFF_ATT, Q.ws + OFF_CONV, Q.ws + OFF_FOUR, wm + WMIX_WA, nMl}; EpiMerge E{(bf16_t*)(Q.ws + OFF_MERGED), (const u8*)(Q.ws + OFF_GATES)};
            fg::gemm_phase<SchedMerge, EpiMerge, 0, 0, false, true>(ldq, 1536, S, E, wq);
            if (l == 0) { int tbase = 0; prep_mix(Q, 1, (float*)ldg, tbase, wq, 32); prep_wz(Q, 1, (float*)ldg, tbase, wq, 32); } }
        SEAM(pb + 3);
        if (IN(pb + 4)) { PHASE_P(Q); char* wm = Q.ws + OFF_WMIX + (size_t)l * WMIX_BYTES;
            SchedPlain S{Q.ws + OFF_MERGED, wm + WMIX_WO, nMl, 4, DM}; EpiYX E{(bf16_t*)(Q.ws + OFF_YX), (float*)(Q.ws + OFF_SSPY)}; fg::gemm_phase<SchedPlain, EpiYX, 0>(ldq, DM, S, E, wq);
            prep_moe(Q, l, ldq, wq, l == 0 ? 32 : 0); }
        SEAM(pb + 4);
        if (IN(pb + 5)) { PHASE_P(Q); post_mix_phase(Q, l, Rl, ldq, wq); }
        SEAM(pb + 5);
        if (IN(pb + 6)) { PHASE_P(Q); moe_setup(Q, l, lbase, lcnt, wq);
            SchedMoe1 S{Q.ws + OFF_H, Q.ws + OFF_WGU, lbase, lcnt, (const int*)(Q.ws + OFF_TOKLIST), (const int*)(Q.ws + OFF_IDL), nMl}; EpiAct E{(bf16_t*)(Q.ws + OFF_ACT), (const float*)(Q.ws + OFF_WLIST)};
            fg::gemm_phase<SchedMoe1, EpiAct, 1, 0, true>(ldq, DM, S, E, wq); }
        SEAM(pb + 6);
        if (IN(pb + 7)) { PHASE_P(Q); moe_setup(Q, l, lbase, lcnt, wq);
            SchedMoe2 S{Q.ws + OFF_ACT, Q.ws + OFF_WD, lbase, lcnt, nMl}; EpiY E{(u8*)(Q.ws + OFF_Y), (u8*)(Q.ws + OFF_YS)}; fg::gemm_phase<SchedMoe2, EpiY, 0>(ldq, FE, S, E, wq); }
        SEAM(pb + 7);
        if (IN(pb + 8)) { PHASE_P(Q); moe_setup(Q, l, lbase, lcnt, wq); post_moe_phase(Q, l, Rl, lbase, wq); }
        if (l == 0) SEAM(pb + 8);
    }
#undef PHASE_P
#undef IN
#undef SEAM
}

#ifndef MK_N_LAUNCHES
#define MK_N_LAUNCHES 1
#endif
extern "C" void kernel_launch(void* const* d_in, const int* in_sizes, int n_in, void* d_out, int out_size, void* d_ws, size_t ws_size, hipStream_t stream) {
    static int ready = 0;
    if (ready == 0) {
        if (n_in != 29 || out_size != RX * DM || ws_size < OFF_END_MIX) { fprintf(stderr, "kernel_launch: unexpected shapes (n_in %d out %d ws %zu need %zu)\n", n_in, out_size, ws_size, (size_t)OFF_END_MIX); ready = -1; return; }
        if (hipFuncSetAttribute((const void*)mk_fwd, hipFuncAttributeMaxDynamicSharedMemorySize, MK_LDS) != hipSuccess) { fprintf(stderr, "kernel_launch: hipFuncSetAttribute failed\n"); ready = -1; return; }
        int dev = 0, cus = 0, per_cu = 0;
        if (hipGetDevice(&dev) != hipSuccess || hipDeviceGetAttribute(&cus, hipDeviceAttributeMultiprocessorCount, dev) != hipSuccess) { ready = -1; return; }
        if (hipOccupancyMaxActiveBlocksPerMultiprocessor(&per_cu, (const void*)mk_fwd, 512, MK_LDS) != hipSuccess || per_cu < 1) { fprintf(stderr, "kernel_launch: occupancy query says %d blocks per CU\n", per_cu); }
        (void)hipGetLastError();
        if (cus != 256) fprintf(stderr, "kernel_launch: %d CUs (built for 256)\n", cus);
        ready = 1;
    }
    if (ready < 0) return;
    Ptrs P{};
    const float** pp = (const float**)&P; for (int i = 0; i < 29; ++i) pp[i] = (const float*)d_in[i];
    P.out = (float*)d_out; P.ws = (char*)d_ws;
    if (hipMemsetAsync((char*)d_ws + OFF_CTL, 0, CTL_BYTES, stream) != hipSuccess) { fprintf(stderr, "kernel_launch: memset failed\n"); return; }
    Args a{}; a.P = P;
    if (MK_N_LAUNCHES == 1) { a.ph_lo = 0; a.ph_hi = N_PHASES; hipLaunchKernelGGL(mk_fwd, dim3(256), dim3(512), MK_LDS, stream, a); }
    else for (int p = 0; p < N_PHASES; ++p) { a.ph_lo = p; a.ph_hi = p + 1; hipLaunchKernelGGL(mk_fwd, dim3(256), dim3(512), MK_LDS, stream, a); }
    const hipError_t le = hipPeekAtLastError(); if (le != hipSuccess) fprintf(stderr, "kernel_launch: launch failed: %s\n", hipGetErrorName(le));
}
```

```cpp
#include <hip/hip_runtime.h>
#include <stdint.h>
#include <stdio.h>

typedef unsigned short bf16_t;
typedef unsigned char u8;

constexpr int DM = 1024, NB = 8, SEQ = 2048, CTX = 256, NH = 8;
constexpr int RX = NB * SEQ, RC = NB * CTX, RT = RX + RC;
constexpr int QK_NOPE = 64, QK_ROPE = 32, V_DIM = 64, Q_RANK = 384, KV_RANK = 256, QK_DIM = 96;
constexpr int CONVW = 512, FW = 512, NE = 32, TOPK = 4, FE = 256;
constexpr int KV_END = 288, Q_END = 672, CB_END = 1184, CC_END = 1696, CX_END = 2208, FOUR_END = 2720, PROJ_W = 5792;
constexpr float EPS = 1e-6f;
constexpr float QSCALE = 0.10206207261596575f * 1.4426950408889634f;
constexpr int SLOTS = 73728 + 32 * 256;

__device__ __forceinline__ bf16_t f2bf(float f) { unsigned u = __float_as_uint(f); u += 0x7FFFu + ((u >> 16) & 1u); return (bf16_t)(u >> 16); }
__device__ __forceinline__ float bf2f(bf16_t b) { return __uint_as_float(((unsigned)b) << 16); }
__device__ __forceinline__ float sigmoidf_(float x) { return 1.f / (1.f + __expf(-x)); }
template <int K> __device__ __forceinline__ float lane_xor(float v) { return __int_as_float(__builtin_amdgcn_ds_swizzle(__float_as_int(v), (K << 10) | 0x1f)); }
__device__ __forceinline__ float lane_xor32_sum(float v) { auto rr = __builtin_amdgcn_permlane32_swap(__float_as_uint(v), __float_as_uint(v), false, false); return __uint_as_float(rr[0]) + __uint_as_float(rr[1]); }
__device__ __forceinline__ float lane_xor32_max(float v) { auto rr = __builtin_amdgcn_permlane32_swap(__float_as_uint(v), __float_as_uint(v), false, false); return fmaxf(__uint_as_float(rr[0]), __uint_as_float(rr[1])); }
__device__ __forceinline__ float wave_sum(float v) { v += lane_xor<1>(v); v += lane_xor<2>(v); v += lane_xor<4>(v); v += lane_xor<8>(v); v += lane_xor<16>(v); return lane_xor32_sum(v); }
__device__ __forceinline__ float wave_max(float v) { v = fmaxf(v, lane_xor<1>(v)); v = fmaxf(v, lane_xor<2>(v)); v = fmaxf(v, lane_xor<4>(v)); v = fmaxf(v, lane_xor<8>(v)); v = fmaxf(v, lane_xor<16>(v)); return lane_xor32_max(v); }
__device__ __forceinline__ int row_arow(int row) { return row < RX ? row / SEQ : NB; }
__device__ __forceinline__ int pe_pos(int half, int i) { return 8 * (i >> 2) + 4 * half + (i & 3); }

constexpr size_t al256(size_t x) { return (x + 255) / 256 * 256; }
constexpr size_t OFF_ADA = 0;
constexpr size_t OFF_ROPE = OFF_ADA + al256(2 * 9 * 6144 * 4);
constexpr size_t OFF_CTXRES = OFF_ROPE + al256(2048 * 16 * 2 * 4);
constexpr size_t OFF_SS = OFF_CTXRES + al256((size_t)RC * DM * 4);
constexpr size_t OFF_CNT = OFF_SS + al256((size_t)3 * RT * 4);
constexpr size_t OFF_BASE = OFF_CNT + 256;
constexpr size_t OFF_TOKLIST = OFF_BASE + 256;
constexpr size_t OFF_WLIST = OFF_TOKLIST + al256((size_t)NE * RT * 4);
constexpr size_t OFF_TOKINFO = OFF_WLIST + al256((size_t)NE * RT * 4);
constexpr size_t OFF_PERSIST_END = OFF_TOKINFO + al256((size_t)RT * 4 * 8);
constexpr size_t WMIX_W1 = 0;
constexpr size_t WMIX_WZ = WMIX_W1 + (size_t)2304 * 1024 * 2;
constexpr size_t WMIX_WUKV = WMIX_WZ + (size_t)1024 * 1024 * 2;
constexpr size_t WMIX_WUQ = WMIX_WUKV + (size_t)1024 * 256 * 2;
constexpr size_t WMIX_WA = WMIX_WUQ + (size_t)768 * 384 * 2;
constexpr size_t WMIX_WO = WMIX_WA + (size_t)3 * 1024 * 512 * 2;
constexpr size_t WMIX_BYTES = WMIX_WO + (size_t)1024 * 1024 * 2;
constexpr size_t OFF_WMIX = OFF_PERSIST_END;
constexpr size_t OFF_MA = OFF_WMIX + 2 * WMIX_BYTES;
constexpr size_t OFF_MB = OFF_MA + 256 * 128 * 2;
constexpr size_t OFF_TW = OFF_MB + 256 * 128 * 2;
constexpr size_t OFF_W1G8 = OFF_TW + 32 * 64 * 2 * 4;
constexpr size_t OFF_H8 = OFF_W1G8 + (size_t)2 * 3072 * 1024;
constexpr size_t OFF_TC = OFF_H8 + (size_t)RT * DM;
constexpr size_t OFF_SSP = OFF_TC + (size_t)256 * 512 * 2;
constexpr size_t OFF_SSPQ = OFF_SSP + (size_t)RT * 4 * 4;
constexpr size_t OFF_SSPY = OFF_SSPQ + (size_t)RT * 8 * 4;
constexpr size_t OFF_IDL = OFF_SSPY + (size_t)RT * 16 * 4;
constexpr size_t OFF_WR = OFF_IDL + (size_t)RT * 4;
constexpr size_t OFF_CTL = OFF_WR + (size_t)2 * 2 * NE * DM * 2;
constexpr size_t CTL_BYTES = 16384;
constexpr size_t OFF_CNT2 = OFF_CTL + 14336;
constexpr size_t OFF_FAST_END = OFF_CTL + CTL_BYTES;
constexpr size_t OFF_H = al256(OFF_FAST_END);
constexpr size_t OFF_CKV = OFF_H + al256((size_t)RT * DM * 2);
constexpr size_t OFF_CQ = OFF_CKV + al256((size_t)RT * 256 * 2);
constexpr size_t OFF_CB = OFF_CQ + al256((size_t)RT * 384 * 2);
constexpr size_t OFF_INNER = OFF_CB + al256((size_t)RT * 512 * 2);
constexpr size_t OFF_GATES = OFF_INNER + al256((size_t)RT * 512 * 2);
constexpr size_t OFF_ZT = OFF_GATES + al256((size_t)RT * 3072);
constexpr size_t OFF_ZTC = OFF_ZT + (size_t)NB * 512 * 4096 * 2;
constexpr size_t OFF_K = OFF_ZT + al256((size_t)RT * DM * 2);
constexpr size_t OFF_V = OFF_K + al256((size_t)RT * 768 * 2);
constexpr size_t OFF_Q = OFF_V + al256((size_t)RT * 512 * 2);
constexpr size_t OFF_ATT = OFF_Q + al256((size_t)RT * 768 * 2);
constexpr size_t OFF_CONV = OFF_ATT + al256((size_t)RT * 512 * 2);
constexpr size_t OFF_FOUR = OFF_CONV + al256((size_t)RT * 512 * 2);
constexpr size_t OFF_END_MIX = OFF_FOUR + al256((size_t)RT * 512 * 2);
constexpr size_t OFF_ZA = OFF_ZT;
constexpr size_t OFF_ZB = OFF_H;
constexpr size_t OFF_X1B = OFF_WMIX;
static_assert(OFF_X1B + (size_t)RX * DM * 2 <= OFF_TC, "X1B must stay inside the dead weight area");
constexpr size_t OFF_YX = OFF_ZT;
constexpr size_t OFF_MERGED = OFF_K;
constexpr size_t OFF_U32 = OFF_ATT;
constexpr size_t OFF_ACT = OFF_CKV;
constexpr size_t OFF_ACTS = OFF_ACT + al256((size_t)SLOTS * 256 * 2);
constexpr size_t OFF_Y = OFF_ACTS + al256((size_t)RT * 256 * 2);
constexpr size_t OFF_YS = OFF_Y + (size_t)SLOTS * DM;
constexpr size_t OFF_END_MOE = OFF_Y + al256((size_t)SLOTS * DM * 2);
static_assert(OFF_END_MOE <= OFF_ATT, "MoE buffers must stay inside regions A+B");
static_assert(OFF_MERGED + (size_t)RT * DM * 2 <= OFF_Q, "MERGED must fit over K,V");
static_assert(OFF_END_MIX < 406000000ull, "workspace too large");

struct Ptrs {
    const float *x, *c, *ctx, *c_ctx, *w_ada, *b_ada, *g_pre_mix, *g_post_mix, *g_pre_ffn, *g_post_ffn, *w_in, *b_gate, *g_q, *w_uq, *g_kv, *w_ukv,
        *w_mla_out, *conv_w, *w_conv_out, *w_four_out, *w_out, *w_router, *b_router, *w_gate_e, *w_up_e, *w_down_e, *w_gate_s, *w_up_s, *w_down_s;
    float* out; char* ws;
};
#define WSP(T, off) ((T*)(P.ws + (off)))

#define LAS __attribute__((address_space(3)))
__device__ __forceinline__ int bid_() { int b = blockIdx.x; asm volatile("" : "+s"(b)); return b; }
typedef short bf16x8 __attribute__((ext_vector_type(8)));
typedef float f32x4 __attribute__((ext_vector_type(4)));
typedef unsigned u32x4 __attribute__((ext_vector_type(4)));
typedef unsigned u32x2 __attribute__((ext_vector_type(2)));
__device__ __forceinline__ unsigned cvt_pk_bf16(float lo, float hi) { unsigned r; asm volatile("v_cvt_pk_bf16_f32 %0, %1, %2" : "=v"(r) : "v"(lo), "v"(hi)); return r; }
__device__ __forceinline__ float bflo(unsigned w) { return __uint_as_float(w << 16); }
__device__ __forceinline__ float bfhi(unsigned w) { return __uint_as_float(w & 0xffff0000u); }

__device__ __forceinline__ int lane_id() { return (int)__builtin_amdgcn_mbcnt_hi(~0u, __builtin_amdgcn_mbcnt_lo(~0u, 0u)); }
__device__ __forceinline__ int uni(int v) { return __builtin_amdgcn_readfirstlane(v); }
__device__ __forceinline__ int hidden_lane() { int lane; asm volatile("v_mbcnt_lo_u32_b32 %0, -1, 0\n\tv_mbcnt_hi_u32_b32 %0, -1, %0" : "=v"(lane)); return lane; }
__device__ __forceinline__ int hidden_tid(int wid) { return wid * 64 + hidden_lane(); }
template <class T> __device__ __forceinline__ T* uni_ptr(T* p) { const unsigned long long v = (unsigned long long)p; const unsigned lo = __builtin_amdgcn_readfirstlane((unsigned)v), hi = __builtin_amdgcn_readfirstlane((unsigned)(v >> 32));
    return (T*)(((unsigned long long)hi << 32) | lo); }
namespace fg {
constexpr int BM = 256, BK = 64, HALF = 128, HTB = HALF * BK * 2, STAGE_BYTES = 8 * HTB, NXCD = 8, WGM = 8;
__host__ __device__ __forceinline__ int lds_byte(int r, int c) { const int st = (r >> 4) * 2 + (c >> 5), rr = r & 15, cc = c & 31, ob = rr * 64 + cc * 2; return st * 1024 + (ob ^ (((ob >> 9) & 1) << 5)); }
__host__ __device__ __forceinline__ void stage_rc(int b, int& R, int& C) { const int st = b / 1024, sb = b % 1024, swz = sb ^ (((sb >> 9) & 1) << 5); R = (st >> 1) * 16 + swz / 64; C = (st & 1) * 32 + (swz % 64) / 2; }
__host__ __device__ __forceinline__ int perm32(int rho) { const int n = rho >> 4, i = rho & 15; return 8 * (i >> 2) + 4 * n + (i & 3); }

struct GU { const char* a; const char* b; const int* gl; int kind, r0, c0, aux, gn; const char* a1; const char* a2; };

__device__ __forceinline__ void tile_order(int L, int nM, int nN, int& pm, int& pn) {
    const int nwg = nM * nN; int wgid = L; { const int q = nwg / NXCD, r = nwg % NXCD, xcd = wgid % NXCD, off = wgid / NXCD; wgid = (xcd < r ? xcd * (q + 1) : r * (q + 1) + (xcd - r) * q) + off; }
    const int nig = WGM * nN, gid = wgid / nig, fm = gid * WGM, gsz = (nM - fm) < WGM ? (nM - fm) : WGM;
    pm = fm + ((wgid % nig) % gsz); pn = (wgid % nig) / gsz;
}

typedef int v8i32 __attribute__((ext_vector_type(8)));
typedef int v4i32 __attribute__((ext_vector_type(4)));
template <class Sched, class Epi, int AM, int BM = 0, bool F8 = false, bool SEG = false>
__device__ __forceinline__ void gemm_phase(LAS unsigned char* lds, const int K, const Sched& S, const Epi& E, const int wid) {
    const int lane = hidden_lane();
    const int tid = wid * 64 + lane, wr = wid >> 2, wc = wid & 3, fr = lane & 15, fq = lane >> 4;
    constexpr bool GATHER = (AM == 1); constexpr int EB = F8 ? 1 : 2;
    constexpr int UNR = F8 ? 1 : 4;
    const int nt = K * EB / (BK * 2); const int KR = SEG ? K / 3 : K;
    unsigned voffA[2], voffB[2];
#pragma unroll
    for (int i = 0; i < 2; ++i) { int R, C; stage_rc(tid * 16 + i * 8192, R, C); const int Rb = (R & ~31) + perm32(R & 31);
        voffA[i] = AM == 2 ? (unsigned)(((R & 31) * 512 + (R >> 5)) * 256 + C * 2) : (unsigned)(R * KR * EB + C * 2);
        voffB[i] = BM == 1 ? (unsigned)(((Rb >> 6) + 32 * (Rb & 63)) * K * EB + C * 2) : (BM == 2 ? (unsigned)(((Rb & 31) * 512 + (Rb >> 5)) * 256 + C * 2) : (unsigned)(Rb * KR * EB + C * 2)); }
    const size_t kstep = (size_t)(BK * 2);
    const size_t hstepA = AM == 2 ? (size_t)1024 : (size_t)HALF * KR * EB;
    const size_t hstep = BM == 1 ? (size_t)2 * K * EB : (BM == 2 ? (size_t)1024 : (size_t)HALF * KR * EB);
    const unsigned ldsw = (unsigned)wid * 1024u;
    const int aoff = lds_byte(wr * 64 + fr, fq * 8), boff = lds_byte(wc * 32 + fr, fq * 8);
#define FG_SA(b, h) (((b) * 2 + (h)) * HTB)
#define FG_SB(b, h) ((4 + (b) * 2 + (h)) * HTB)
#define FG_STAGE(bufoff, gbase, voff) do { _Pragma("unroll") for (int _i = 0; _i < 2; ++_i) { unsigned _keep; \
        asm volatile("s_mov_b32 %0, m0\n\ts_mov_b32 m0, %3\n\ts_nop 0\n\tglobal_load_lds_dwordx4 %1, %2\n\ts_mov_b32 m0, %0" : "=&s"(_keep) : "v"((voff)[_i]), "s"((const char*)(gbase)), "s"((unsigned)(size_t)(lds + (bufoff) + ldsw + _i * 8192)) : "memory"); } } while (0)
#define FG_STAGE_A(bufoff, P, H, NX) do { if constexpr (GATHER) { const u32x2 _g = *(const LAS u32x2*)(gofs + ((NX) ? nsel : cset) * 8192 + (H) * 8); unsigned _o[2] = {_g[0], _g[1]}; FG_STAGE(bufoff, P, _o); } \
        else { FG_STAGE(bufoff, (P) + (H) * hstepA, voffA); } } while (0)
#define FG_LD8(p) __builtin_shufflevector(*(const LAS v4i32*)(p), *(const LAS v4i32*)((p) + 1024), 0, 1, 2, 3, 4, 5, 6, 7)
#define FG_LDA(dst, b, h) do { _Pragma("unroll") for (int m = 0; m < 4; ++m) dst[m] = FG_LD8(lds + FG_SA(b, h) + aoff + m * 2048); } while (0)
#define FG_LDB(dst, b, h) do { _Pragma("unroll") for (int n = 0; n < 2; ++n) dst[n] = FG_LD8(lds + FG_SB(b, h) + boff + n * 2048); } while (0)
#define FG_MMA(ai, bj, At, Bt) do { __builtin_amdgcn_s_setprio(1); _Pragma("unroll") for (int m = 0; m < 4; ++m) _Pragma("unroll") for (int n = 0; n < 2; ++n) { \
        if constexpr (F8) acc[ai][bj][m][n] = __builtin_amdgcn_mfma_scale_f32_16x16x128_f8f6f4(Bt[n], At[m], acc[ai][bj][m][n], 0, 0, 0, 0x7f7f7f7f, 0, 0x7f7f7f7f); \
        else { acc[ai][bj][m][n] = __builtin_amdgcn_mfma_f32_16x16x32_bf16((bf16x8)__builtin_shufflevector(Bt[n], Bt[n], 0, 1, 2, 3), (bf16x8)__builtin_shufflevector(At[m], At[m], 0, 1, 2, 3), acc[ai][bj][m][n], 0, 0, 0); \
               acc[ai][bj][m][n] = __builtin_amdgcn_mfma_f32_16x16x32_bf16((bf16x8)__builtin_shufflevector(Bt[n], Bt[n], 4, 5, 6, 7), (bf16x8)__builtin_shufflevector(At[m], At[m], 4, 5, 6, 7), acc[ai][bj][m][n], 0, 0, 0); } } __builtin_amdgcn_s_setprio(0); } while (0)
#define FG_WAIT_V(n) asm volatile("s_waitcnt vmcnt(" #n ")" ::: "memory")
#define FG_WAIT_L(n) asm volatile("s_waitcnt lgkmcnt(" #n ")" ::: "memory")
#define FG_BAR __builtin_amdgcn_s_barrier()
#define FG_SCHED __builtin_amdgcn_sched_barrier(0)
#define FG_GOFF(SET, U) do { if constexpr (GATHER) { const int _t = wid * 64 + hidden_lane(); u32x4 _q; _Pragma("unroll") for (int _h = 0; _h < 2; ++_h) _Pragma("unroll") for (int _i = 0; _i < 2; ++_i) { \
        int _R, _C; stage_rc(_t * 16 + _i * 8192, _R, _C); int _r = _h * HALF + _R; _r = _r < (U).gn ? _r : (U).gn - 1; _q[_h * 2 + _i] = (unsigned)(U).gl[_r] * (unsigned)(K * EB) + (unsigned)(_C * 2); } \
        *(LAS u32x4*)(gofs + (SET) * 8192) = _q; } } while (0)
#define FG_UNIFY(U) do { (U).a = uni_ptr((U).a); (U).b = uni_ptr((U).b); (U).gl = uni_ptr((U).gl); if constexpr (SEG) { (U).a1 = uni_ptr((U).a1); (U).a2 = uni_ptr((U).a2); asm volatile("" : "+s"((U).a1), "+s"((U).a2)); } (U).kind = uni((U).kind); (U).r0 = uni((U).r0); (U).c0 = uni((U).c0); (U).aux = uni((U).aux); (U).gn = uni((U).gn); \
        asm volatile("" : "+s"((U).a), "+s"((U).b), "+s"((U).gl), "+s"((U).kind), "+s"((U).r0), "+s"((U).c0), "+s"((U).aux), "+s"((U).gn)); } while (0)
    GU cur{}; int ui = 0;
    if (!S.next(0, cur)) return;
    FG_UNIFY(cur);
    LAS unsigned char* const gofs = lds + STAGE_BYTES + 1024 + tid * 16;
    int cset = 0, nsel = 0;
    FG_GOFF(cset, cur);
    f32x4 acc[2][2][4][2];
#pragma unroll
    for (int a = 0; a < 2; ++a)
#pragma unroll
        for (int b = 0; b < 2; ++b)
#pragma unroll
            for (int m = 0; m < 4; ++m)
#pragma unroll
                for (int n = 0; n < 2; ++n) acc[a][b][m][n] = (f32x4){0.f, 0.f, 0.f, 0.f};
    v8i32 At[4], B0[2], B1[2];
    const char* cA = cur.a; const char* cB = cur.b;
    FG_STAGE(FG_SB(0, 0), cB, voffB); FG_STAGE(FG_SB(0, 1), cB + hstep, voffB); FG_STAGE_A(FG_SA(0, 0), cA, 0, false); FG_STAGE_A(FG_SA(0, 1), cA, 1, false);
    if (wr == 1) FG_BAR;
    FG_WAIT_V(2); FG_BAR;
    FG_STAGE(FG_SB(1, 0), cB + kstep, voffB); FG_STAGE_A(FG_SA(1, 0), cA + kstep, 0, false); FG_STAGE(FG_SB(1, 1), cB + hstep + kstep, voffB);
    FG_WAIT_V(6); FG_BAR;
    for (;;) {
        GU nxt{};
        const bool has_next = S.next(ui + 1, nxt);
        FG_UNIFY(nxt);
        const char* nA = has_next ? nxt.a : cA; const char* nB = has_next ? nxt.b : cB;
        if constexpr (GATHER) { if (has_next) { nsel = cset ^ 1; FG_GOFF(nsel, nxt); } else nsel = cset; }
#pragma unroll UNR
        for (int t = 0; t < nt; t += 2) {
            const bool last = (t == nt - 2);
            const char *a1, *a2, *a3, *b2, *b3;
            if constexpr (SEG) { const int ts = nt / 3;
                const int s1 = t / ts, s2 = (t + 2) / ts; const size_t k1 = (size_t)(t + 1 - s1 * ts) * kstep, k2 = (size_t)(t + 2 - s2 * ts) * kstep;
                a1 = (s1 == 0 ? cA : (s1 == 1 ? cur.a1 : cur.a2)) + k1;
                a2 = last ? nA : (s2 == 0 ? cA : (s2 == 1 ? cur.a1 : cur.a2)) + k2; b2 = last ? nB : cB + (size_t)s2 * Epi::SEGB + k2;
                a3 = a2 + kstep; b3 = b2 + kstep;
                if (t > 0 && t % ts == 0) { const int lz = hidden_lane(); E.rescale(acc, cur, t / ts, wid >> 2, wid & 3, lz & 15, lz >> 4); } }
            else { a1 = cA + (size_t)(t + 1) * kstep; a2 = last ? nA : cA + (size_t)(t + 2) * kstep; b2 = last ? nB : cB + (size_t)(t + 2) * kstep; a3 = a2 + kstep; b3 = b2 + kstep; }
            FG_LDB(B0, 0, 0); FG_LDB(B1, 0, 1); FG_SCHED; FG_LDA(At, 0, 0); FG_STAGE_A(FG_SA(1, 1), a1, 1, false);
            FG_WAIT_V(8); FG_WAIT_L(0); FG_BAR; FG_MMA(0, 0, At, B0); FG_MMA(0, 1, At, B1); FG_BAR; FG_SCHED;
            FG_LDA(At, 0, 1); FG_STAGE(FG_SB(0, 0), b2, voffB); FG_STAGE(FG_SB(0, 1), b2 + hstep, voffB); FG_STAGE_A(FG_SA(0, 0), a2, 0, last);
            FG_WAIT_V(8); FG_WAIT_L(0); FG_BAR; FG_MMA(1, 0, At, B0); FG_MMA(1, 1, At, B1); FG_BAR; FG_SCHED;
            FG_LDB(B0, 1, 0); FG_LDB(B1, 1, 1); FG_SCHED; FG_LDA(At, 1, 0); FG_STAGE_A(FG_SA(0, 1), a2, 1, last);
            FG_WAIT_V(8); FG_WAIT_L(0); FG_BAR; FG_MMA(0, 0, At, B0); FG_MMA(0, 1, At, B1); FG_BAR; FG_SCHED;
            FG_LDA(At, 1, 1); FG_STAGE(FG_SB(1, 0), b3, voffB); FG_STAGE(FG_SB(1, 1), b3 + hstep, voffB); FG_STAGE_A(FG_SA(1, 0), a3, 0, last);
            FG_WAIT_V(8); FG_WAIT_L(0); FG_BAR; FG_MMA(1, 0, At, B0); FG_MMA(1, 1, At, B1); FG_BAR; FG_SCHED;
        }
        if (wr == 0) FG_BAR;
        {
            const int lz = hidden_lane();
            E(acc, cur, wid >> 2, wid & 3, lz & 15, lz >> 4); }
        if (!has_next) break;
#pragma unroll
        for (int a = 0; a < 2; ++a)
#pragma unroll
            for (int b = 0; b < 2; ++b)
#pragma unroll
                for (int m = 0; m < 4; ++m)
#pragma unroll
                    for (int n = 0; n < 2; ++n) acc[a][b][m][n] = (f32x4){0.f, 0.f, 0.f, 0.f};
        cur = nxt; cA = nA; cB = nB; ++ui;
        if constexpr (GATHER) cset = nsel;
        if (wr == 1) FG_BAR;
    }
    FG_WAIT_V(0);
    FG_BAR;
#undef FG_SA
#undef FG_SB
#undef FG_STAGE
#undef FG_STAGE_A
#undef FG_LDA
#undef FG_LD8
#undef FG_LDB
#undef FG_MMA
#undef FG_WAIT_V
#undef FG_WAIT_L
#undef FG_BAR
#undef FG_SCHED
#undef FG_GOFF
#undef FG_UNIFY
}
}

constexpr size_t OFF_WGU = OFF_ATT;
constexpr size_t OFF_WD = OFF_WGU + (size_t)33 * 512 * 1024 * 2;
static_assert(OFF_WD + (size_t)33 * 1024 * 256 * 2 <= OFF_END_MIX, "MoE weights must fit region C");
constexpr size_t MOE_WBLK = (size_t)512 * 1024;

struct Args { Ptrs P; int ph_lo, ph_hi; };

__device__ __forceinline__ u32x4 pk8(const float* v) { u32x4 w; w[0] = cvt_pk_bf16(v[0], v[1]); w[1] = cvt_pk_bf16(v[2], v[3]); w[2] = cvt_pk_bf16(v[4], v[5]); w[3] = cvt_pk_bf16(v[6], v[7]); return w; }
__device__ __forceinline__ float sat8(float v) { return __builtin_amdgcn_fmed3f(v, -448.f, 448.f); }
__device__ __forceinline__ u32x2 pk8_fp8(const float* v, float sc) { int a = __builtin_amdgcn_cvt_pk_fp8_f32(sat8(v[0] * sc), sat8(v[1] * sc), 0, false); a = __builtin_amdgcn_cvt_pk_fp8_f32(sat8(v[2] * sc), sat8(v[3] * sc), a, true);
    int b = __builtin_amdgcn_cvt_pk_fp8_f32(sat8(v[4] * sc), sat8(v[5] * sc), 0, false); b = __builtin_amdgcn_cvt_pk_fp8_f32(sat8(v[6] * sc), sat8(v[7] * sc), b, true); return (u32x2){(unsigned)a, (unsigned)b}; }
constexpr float W8SC = 32.f;
__device__ __forceinline__ int w1_col(int r) {
    const int ct = r >> 8, j = r & 255;
    if (ct == 0) return j;
    if (ct == 1) return KV_END + j;
    if (ct == 2) { if (j < 128) return KV_END + 256 + j;
        if (j < 160) { const int p = j - 128, a = p >> 3, half = (p >> 2) & 1, rr = p & 3; return KV_RANK + half * 16 + 4 * a + rr; }
        return -1; }
    if (ct <= 4) return Q_END + (ct - 3) * 256 + j;
    if (ct <= 8) { const int t = ct - 5; return j < 128 ? CB_END + t * 128 + j : CC_END + t * 128 + (j - 128); }
    return FOUR_END + (ct - 9) * 256 + j;
}
__device__ __forceinline__ int wuq_col(int n) { const int h = n / 96, j = n % 96; if (j < 64) return n; const int p = j - 64, a = p >> 3, half = (p >> 2) & 1, rr = p & 3; return h * 96 + 64 + half * 16 + 4 * a + rr; }
template <int MAP, bool O8 = false>
__device__ __forceinline__ void tr_tile(float* tile, const float* src, int ld, int c0, const float* kscale, bf16_t* dst, int K, int n0, int k0, int wid) {
    const int tid = hidden_tid(wid);
    f32x4 tv[4]; float tm[4];
#pragma unroll
    for (int i = 0; i < 4; ++i) { const int e = tid + 512 * i, kk = e >> 4, n4 = (e & 15) * 4; const int n = n0 + n4; const int col = MAP == 0 ? c0 + n : (MAP == 1 ? w1_col(n) : wuq_col(n));
        tv[i] = *(const f32x4*)(src + (size_t)(k0 + kk) * ld + (col >= 0 ? col : 0)); tm[i] = col >= 0 ? 1.f : 0.f; }
    if (kscale) {
#pragma unroll
        for (int i = 0; i < 4; ++i) { const int kk = (tid + 512 * i) >> 4; tm[i] *= kscale[k0 + kk]; } }
#pragma unroll
    for (int i = 0; i < 4; ++i) { const int e = tid + 512 * i, kk = e >> 4, n4 = (e & 15) * 4; *(f32x4*)(tile + kk * 68 + n4) = tv[i] * tm[i]; }
    __syncthreads();
#pragma unroll
    for (int i = 0; i < 2; ++i) { const int e = tid + 512 * i, nn = e & 63, kc = (e >> 6) * 8; float v[8];
#pragma unroll
        for (int j = 0; j < 8; ++j) v[j] = tile[(kc + j) * 68 + nn];
        if constexpr (O8) *(u32x2*)((u8*)dst + (size_t)(n0 + nn) * K + k0 + kc) = pk8_fp8(v, W8SC); else *(u32x4*)(dst + (size_t)(n0 + nn) * K + k0 + kc) = pk8(v); }
    __syncthreads();
}
template <int MAP, bool O8 = false>
__device__ __forceinline__ void tr_job(float* tile, int& tbase, const float* src, int ld, int c0, const float* kscale, bf16_t* dst, int N, int K, int wid, int wg0 = 0) {
    const int nk = K / 128, ntile = (N / 64) * nk, G = (int)gridDim.x - wg0; const int me = bid_() - wg0; if (me < 0) { tbase += ntile; return; }
    int first = (me - tbase % G + G) % G;
    for (int t = first; t < ntile; t += G) tr_tile<MAP, O8>(tile, src, ld, c0, kscale, dst, K, (t / nk) * 64, (t % nk) * 128, wid);
    tbase += ntile;
}
__device__ __forceinline__ void prep_mix(const Ptrs& P, int l, float* tile, int& tbase, int wid, int wg0 = 0) {
    char* wm = P.ws + OFF_WMIX + (size_t)l * WMIX_BYTES;
    tr_job<1>(tile, tbase, P.w_in + (size_t)l * DM * PROJ_W, PROJ_W, 0, nullptr, (bf16_t*)(wm + WMIX_W1), 2304, DM, wid, wg0);
    tr_job<0, true>(tile, tbase, P.w_in + (size_t)l * DM * PROJ_W, PROJ_W, FOUR_END, nullptr, (bf16_t*)(P.ws + OFF_W1G8 + (size_t)l * 3072 * 1024), 3072, DM, wid, wg0);
    tr_job<0>(tile, tbase, P.w_ukv + (size_t)l * KV_RANK * 1024, 1024, 0, P.g_kv + l * KV_RANK, (bf16_t*)(wm + WMIX_WUKV), 1024, KV_RANK, wid, wg0);
    tr_job<2>(tile, tbase, P.w_uq + (size_t)l * Q_RANK * 768, 768, 0, P.g_q + l * Q_RANK, (bf16_t*)(wm + WMIX_WUQ), 768, Q_RANK, wid, wg0);
    tr_job<0>(tile, tbase, P.w_mla_out + (size_t)l * 512 * DM, DM, 0, nullptr, (bf16_t*)(wm + WMIX_WA), 1024, 512, wid, wg0);
    tr_job<0>(tile, tbase, P.w_conv_out + (size_t)l * 512 * DM, DM, 0, nullptr, (bf16_t*)(wm + WMIX_WA) + (size_t)1024 * 512, 1024, 512, wid, wg0);
    tr_job<0>(tile, tbase, P.w_four_out + (size_t)l * 512 * DM, DM, 0, nullptr, (bf16_t*)(wm + WMIX_WA) + (size_t)2 * 1024 * 512, 1024, 512, wid, wg0);
    tr_job<0>(tile, tbase, P.w_out + (size_t)l * DM * DM, DM, 0, nullptr, (bf16_t*)(wm + WMIX_WO), 1024, DM, wid, wg0);
}

struct EpiYX { bf16_t* yx; float* ssp;
    __device__ __forceinline__ void operator()(const f32x4 (&acc)[2][2][4][2], const fg::GU& u, int wr, int wc, int fr, int fq) const {
#pragma unroll
        for (int ai = 0; ai < 2; ++ai)
#pragma unroll
            for (int m = 0; m < 4; ++m) { const int row = u.r0 + ai * 128 + wr * 64 + m * 16 + fr; float ss = 0.f;
#pragma unroll
                for (int bj = 0; bj < 2; ++bj) { const f32x4 v0 = acc[ai][bj][m][0], v1 = acc[ai][bj][m][1];
                    ss += v0[0] * v0[0] + v0[1] * v0[1] + v0[2] * v0[2] + v0[3] * v0[3] + v1[0] * v1[0] + v1[1] * v1[1] + v1[2] * v1[2] + v1[3] * v1[3];
                    u32x4 w; w[0] = cvt_pk_bf16(v0[0], v0[1]); w[1] = cvt_pk_bf16(v0[2], v0[3]); w[2] = cvt_pk_bf16(v1[0], v1[1]); w[3] = cvt_pk_bf16(v1[2], v1[3]);
                    *(u32x4*)(yx + (size_t)row * DM + u.c0 + bj * 128 + wc * 32 + 8 * fq) = w; }
                ss += lane_xor<16>(ss); ss = lane_xor32_sum(ss);
                if (fq == 0) ssp[(size_t)row * 16 + (u.c0 >> 8) * 4 + wc] = ss; }
    }
};
struct EpiMerge { static constexpr size_t SEGB = (size_t)1024 * 512 * 2;
    bf16_t* merged; const u8* gates;
    __device__ __forceinline__ static float gv(unsigned w, int j) { return (float)((w >> (8 * j)) & 0xffu); }
    __device__ __forceinline__ void rescale(f32x4 (&acc)[2][2][4][2], const fg::GU& u, int seg, int wr, int wc, int fr, int fq) const {
#pragma unroll
        for (int ai = 0; ai < 2; ++ai) { u32x2 gp[4][2], gn[4][2];
#pragma unroll
            for (int m = 0; m < 4; ++m)
#pragma unroll
                for (int bj = 0; bj < 2; ++bj) { const u8* g = gates + (size_t)(u.r0 + ai * 128 + wr * 64 + m * 16 + fr) * 3072 + (seg - 1) * 1024 + u.c0 + bj * 128 + wc * 32 + 8 * fq;
                    gp[m][bj] = *(const u32x2*)g; gn[m][bj] = *(const u32x2*)(g + 1024); }
#pragma unroll
            for (int m = 0; m < 4; ++m)
#pragma unroll
                for (int bj = 0; bj < 2; ++bj)
#pragma unroll
                    for (int j = 0; j < 8; ++j) acc[ai][bj][m][j >> 2][j & 3] *= gv(gp[m][bj][j >> 2], j & 3) * __builtin_amdgcn_rcpf(gv(gn[m][bj][j >> 2], j & 3)); }
    }
    __device__ __forceinline__ void operator()(const f32x4 (&acc)[2][2][4][2], const fg::GU& u, int wr, int wc, int fr, int fq) const {
#pragma unroll
        for (int ai = 0; ai < 2; ++ai) { u32x2 g[4][2];
#pragma unroll
            for (int m = 0; m < 4; ++m)
#pragma unroll
                for (int bj = 0; bj < 2; ++bj) g[m][bj] = *(const u32x2*)(gates + (size_t)(u.r0 + ai * 128 + wr * 64 + m * 16 + fr) * 3072 + 2048 + u.c0 + bj * 128 + wc * 32 + 8 * fq);
#pragma unroll
            for (int m = 0; m < 4; ++m)
#pragma unroll
                for (int bj = 0; bj < 2; ++bj) { const int row = u.r0 + ai * 128 + wr * 64 + m * 16 + fr, col = u.c0 + bj * 128 + wc * 32 + 8 * fq; float v[8];
#pragma unroll
                    for (int j = 0; j < 8; ++j) v[j] = acc[ai][bj][m][j >> 2][j & 3] * (gv(g[m][bj][j >> 2], j & 3) * (1.f / 255.f));
                    *(u32x4*)(merged + (size_t)row * DM + col) = pk8(v); } }
    }
};

struct SchedPlain { const char* A; const char* Bt; int nM, nN, K;
    __device__ __forceinline__ bool next(int i, fg::GU& u) const { const int L = i * (int)gridDim.x + bid_(); if (L >= nM * nN) return false; int pm, pn; fg::tile_order(L, nM, nN, pm, pn);
        u.a = A + (size_t)pm * 256 * K * 2; u.b = Bt + (size_t)pn * 256 * K * 2; u.r0 = pm * 256; u.c0 = pn * 256; u.kind = 0; u.aux = 0; u.gl = nullptr; u.gn = 256; return true; } };
struct SchedMerge { const char *A0, *A1, *A2; const char* W3; int nM;
    __device__ __forceinline__ bool next(int i, fg::GU& u) const { const int tl = i * (int)gridDim.x + bid_(); if (tl >= nM * 4) return false; int pm, pn; fg::tile_order(tl, nM, 4, pm, pn);
        const size_t ao = (size_t)pm * 256 * 512 * 2; u.a = A0 + ao; u.a1 = A1 + ao; u.a2 = A2 + ao; u.b = W3 + (size_t)pn * 256 * 512 * 2; u.r0 = pm * 256; u.c0 = pn * 256; u.kind = 0; u.aux = 0; u.gl = nullptr; u.gn = 256; return true; } };

__device__ __forceinline__ u32x4 pk8_sw(const float* v) { u32x4 w;
#pragma unroll
    for (int i = 0; i < 4; ++i) w[i] = (unsigned)f2bf(v[2 * i]) | ((unsigned)f2bf(v[2 * i + 1]) << 16);
    return w; }
__device__ __forceinline__ void prep_wz(const Ptrs& P, int l, float* ldsf, int& tbase, int wid, int wg0 = 0) {
    const int G = (int)gridDim.x - wg0, tid = hidden_tid(wid), lane = tid & 63, fr = lane & 15, fq = lane >> 4; float* wt = ldsf;
    const int ntile = 4 * 32;
    const int me = bid_() - wg0; if (me < 0) { tbase += ntile; return; }
    const int first = (me - tbase % G + G) % G;
    u8* WZ = (u8*)(P.ws + OFF_WMIX + (size_t)l * WMIX_BYTES + WMIX_WZ);
    if (first < ntile) {
        bf16x8 bh[2][4], bl[2][4];
#pragma unroll
        for (int j = 0; j < 2; ++j) { const int n = 32 * wid + 16 * j + fr, part = n >> 7, cp = n & 127;
#pragma unroll
            for (int kb = 0; kb < 4; ++kb) { float v[8], lo[8];
#pragma unroll
                for (int e = 0; e < 8; ++e) { const int c = 32 * kb + 8 * fq + e; const float ph = 2.f * (float)((c * cp) & 127) / 128.f;
                    v[e] = (part ? -sinpif(ph) : cospif(ph)) * 0.08838834764831845f; lo[e] = v[e] - bf2f(f2bf(v[e])); }
                const u32x4 ph8 = pk8_sw(v), pl8 = pk8_sw(lo); bh[j][kb] = *reinterpret_cast<const bf16x8*>(&ph8); bl[j][kb] = *reinterpret_cast<const bf16x8*>(&pl8); } }
        for (int t = first; t < ntile; t += G) { const int g = t >> 5, k0 = (t & 31) * 32;
#pragma unroll 1
            for (int h = 0; h < 2; ++h) { float tw[4];
#pragma unroll
              for (int i = 0; i < 4; ++i) { const int e = tid + 512 * (4 * h + i), kk = e >> 7, c = e & 127; tw[i] = P.w_in[(size_t)l * DM * PROJ_W + (size_t)(k0 + kk) * PROJ_W + CX_END + g * 128 + c]; }
#pragma unroll
              for (int i = 0; i < 4; ++i) { const int e = tid + 512 * (4 * h + i), kk = e >> 7, c = e & 127; wt[kk * 129 + c] = tw[i]; } }
            __syncthreads();
            f32x4 acc[2][2];
#pragma unroll
            for (int m = 0; m < 2; ++m)
#pragma unroll
                for (int j = 0; j < 2; ++j) acc[m][j] = (f32x4){0.f, 0.f, 0.f, 0.f};
#pragma unroll
            for (int kb = 0; kb < 4; ++kb)
#pragma unroll
                for (int m = 0; m < 2; ++m) { float v[8], lo[8];
#pragma unroll
                    for (int e = 0; e < 8; ++e) { v[e] = wt[(16 * m + fr) * 129 + 32 * kb + 8 * fq + e]; lo[e] = v[e] - bf2f(f2bf(v[e])); }
                    const u32x4 ph8 = pk8_sw(v), pl8 = pk8_sw(lo); const bf16x8 ah = *reinterpret_cast<const bf16x8*>(&ph8), al = *reinterpret_cast<const bf16x8*>(&pl8);
#pragma unroll
                    for (int j = 0; j < 2; ++j) { acc[m][j] = __builtin_amdgcn_mfma_f32_16x16x32_bf16(ah, bh[j][kb], acc[m][j], 0, 0, 0);
                        acc[m][j] = __builtin_amdgcn_mfma_f32_16x16x32_bf16(ah, bl[j][kb], acc[m][j], 0, 0, 0); acc[m][j] = __builtin_amdgcn_mfma_f32_16x16x32_bf16(al, bh[j][kb], acc[m][j], 0, 0, 0); } }
#pragma unroll
            for (int m = 0; m < 2; ++m)
#pragma unroll
                for (int j = 0; j < 2; ++j) { const int n = 32 * wid + 16 * j + fr, part = n >> 7, cp = n & 127; float q[4];
#pragma unroll
                    for (int r = 0; r < 4; ++r) q[r] = __builtin_amdgcn_fmed3f(acc[m][j][r] * W8SC, -448.f, 448.f);
                    int w8 = __builtin_amdgcn_cvt_pk_fp8_f32(q[0], q[1], 0, false); w8 = __builtin_amdgcn_cvt_pk_fp8_f32(q[2], q[3], w8, true);
                    *(unsigned*)(WZ + (size_t)(part * 512 + g * 128 + cp) * DM + k0 + 16 * m + 4 * fq) = (unsigned)w8; }
            __syncthreads(); } }
    tbase += ntile;
}
__device__ __forceinline__ void prep_dft(const Ptrs& P, int wid, int wg0 = 0) {
    bf16_t* TC = WSP(bf16_t, OFF_TC);
    if (bid_() < wg0) return;
    const size_t nthr = (size_t)((int)gridDim.x - wg0) * 512, gid = (size_t)(bid_() - wg0) * 512 + hidden_tid(wid);
    for (size_t e = gid; e < (size_t)RT; e += nthr) WSP(int, OFF_IDL)[e] = (int)e;
    for (size_t e = gid; e < (size_t)256 * 128; e += nthr) { const int kk = e & 127, rho = e >> 7; float v = 0.f;
        if ((rho & 127) < 64) { const int k2 = rho & 63, po = rho >> 7, part = kk >> 6, n2 = kk & 63; const float ph = 2.f * (float)((n2 * k2) & 63) / 64.f;
            const float c = cospif(ph), sn = sinpif(ph); v = po == 0 ? (part == 0 ? c : sn) : (part == 0 ? -sn : c); }
        WSP(bf16_t, OFF_MA)[e] = f2bf(v); }
    for (size_t e = gid; e < (size_t)256 * 128; e += nthr) { const int kk = e & 127, p = e >> 7; float v = 0.f;
        if (p < 64) { const int hfo = p >> 5, k1 = p & 31, hf = kk >> 6, part = (kk >> 5) & 1, n1 = kk & 31; const float ph = 2.f * (float)((n1 * k1) & 31) / 32.f;
            if (hf == hfo) v = (part == 0 ? cospif(ph) : sinpif(ph)) * 0.02209708691207961f; }
        WSP(bf16_t, OFF_MB)[e] = f2bf(v); }
    for (size_t e = gid; e < (size_t)64 * 32; e += nthr) { const int n1 = e & 31, k2 = e >> 5; const float ph = 2.f * (float)(n1 * k2) / 2048.f; WSP(float, OFF_TW)[2 * e] = cospif(ph); WSP(float, OFF_TW)[2 * e + 1] = sinpif(ph); }
    for (size_t e = gid; e < (size_t)256 * 256; e += nthr) { const int kp = e & 255, m = e >> 8; const int k = 2 * kp; const int kk = k & 255;
        const float p0 = 2.f * (float)((m * kk) & 255) / 256.f, p1 = 2.f * (float)((m * (kk + 1)) & 255) / 256.f; const float s = 0.0625f;
        const float v0 = (k < 256 ? cospif(p0) : sinpif(p0)) * s, v1 = (k < 256 ? cospif(p1) : sinpif(p1)) * s; *(unsigned*)(TC + (size_t)m * 512 + k) = cvt_pk_bf16(v0, v1); }
}

__device__ __forceinline__ float fast_sigmoid(float x) { return __builtin_amdgcn_rcpf(1.f + __builtin_amdgcn_exp2f(-1.4426950408889634f * x)); }
__device__ __forceinline__ u32x4 pack8(const f32x4& v0, const f32x4& v1) { u32x4 w; w[0] = cvt_pk_bf16(v0[0], v0[1]); w[1] = cvt_pk_bf16(v0[2], v0[3]); w[2] = cvt_pk_bf16(v1[0], v1[1]); w[3] = cvt_pk_bf16(v1[2], v1[3]); return w; }
__device__ __forceinline__ float sumsq8(const f32x4& v0, const f32x4& v1) { return v0[0] * v0[0] + v0[1] * v0[1] + v0[2] * v0[2] + v0[3] * v0[3] + v1[0] * v1[0] + v1[1] * v1[1] + v1[2] * v1[2] + v1[3] * v1[3]; }

struct EpiProj { const Ptrs P; int l;
    __device__ __forceinline__ void operator()(const f32x4 (&acc)[2][2][4][2], const fg::GU& u, int wr, int wc, int fr, int fq) const {
        const int kind = u.kind;
        if (kind <= 2) {
            bf16_t* dst = kind == 0 ? WSP(bf16_t, OFF_CKV) : WSP(bf16_t, OFF_CQ); const int ld = kind == 0 ? KV_RANK : Q_RANK; const int cb = kind == 2 ? 256 : 0;
            float* ssp = kind == 0 ? WSP(float, OFF_SSP) : WSP(float, OFF_SSPQ); const int sstride = kind == 0 ? 4 : 8; const int sslot = (kind == 2 ? 4 : 0) + wc;
            const int nbj = kind == 2 ? 1 : 2;
#pragma unroll
            for (int ai = 0; ai < 2; ++ai) { f32x4 rt0[4], rt1[4];
#pragma unroll
                for (int m = 0; m < 4; ++m) { rt0[m] = (f32x4){1.f, 0.f, 1.f, 0.f}; rt1[m] = rt0[m]; }
                if (kind == 2 && wc == 0) {
#pragma unroll
                    for (int m = 0; m < 4; ++m) { const int row = u.r0 + ai * 128 + wr * 64 + m * 16 + fr; const int rr = row < RX ? row : 0;
                        const float* cs = WSP(float, OFF_ROPE) + ((size_t)(rr & (SEQ - 1)) * 16 + 4 * fq) * 2; rt0[m] = *(const f32x4*)cs; rt1[m] = *(const f32x4*)(cs + 4); } }
#pragma unroll
                for (int m = 0; m < 4; ++m) { const int row = u.r0 + ai * 128 + wr * 64 + m * 16 + fr; float ss = 0.f;
#pragma unroll
                    for (int bj = 0; bj < 2; ++bj) if (bj < nbj) { ss += sumsq8(acc[ai][bj][m][0], acc[ai][bj][m][1]);
                        *(u32x4*)(dst + (size_t)row * ld + cb + bj * 128 + wc * 32 + 8 * fq) = pack8(acc[ai][bj][m][0], acc[ai][bj][m][1]); }
                    ss += lane_xor<16>(ss); ss = lane_xor32_sum(ss);
                    if (fq == 0) ssp[(size_t)row * sstride + sslot] = ss;
                    if (kind == 2 && wc == 0) {
                        const f32x4 x1 = acc[ai][1][m][0], x2 = acc[ai][1][m][1]; f32x4 o1 = x1, o2 = x2;
                        if (row < RX) { const f32x4 t0 = rt0[m], t1 = rt1[m];
                            const float c[4] = {t0[0], t0[2], t1[0], t1[2]}, s[4] = {t0[1], t0[3], t1[1], t1[3]};
#pragma unroll
                            for (int j = 0; j < 4; ++j) { o1[j] = x1[j] * c[j] - x2[j] * s[j]; o2[j] = x2[j] * c[j] + x1[j] * s[j]; } }
                        const u32x4 w = pack8(o1, o2); bf16_t* kp = WSP(bf16_t, OFF_K) + (size_t)row * 768 + 64 + 8 * fq;
#pragma unroll
                        for (int h = 0; h < NH; ++h) *(u32x4*)(kp + h * 96) = w; }
                } }
        } else if (kind == 3) {
            bf16_t* dst = WSP(bf16_t, OFF_CB);
#pragma unroll
            for (int ai = 0; ai < 2; ++ai)
#pragma unroll
                for (int m = 0; m < 4; ++m) { const int row = u.r0 + ai * 128 + wr * 64 + m * 16 + fr;
#pragma unroll
                    for (int bj = 0; bj < 2; ++bj) *(u32x4*)(dst + (size_t)row * CONVW + u.aux + bj * 128 + wc * 32 + 8 * fq) = pack8(acc[ai][bj][m][0], acc[ai][bj][m][1]); }
        } else if (kind == 4) {
            bf16_t* dst = WSP(bf16_t, OFF_INNER);
#pragma unroll
            for (int ai = 0; ai < 2; ++ai)
#pragma unroll
                for (int m = 0; m < 4; ++m) { const int row = u.r0 + ai * 128 + wr * 64 + m * 16 + fr;
                    const f32x4 p0 = acc[ai][0][m][0] * acc[ai][1][m][0], p1 = acc[ai][0][m][1] * acc[ai][1][m][1];
                    *(u32x4*)(dst + (size_t)row * CONVW + u.aux * 128 + wc * 32 + 8 * fq) = pack8(p0, p1); }
        } else if (kind == 7) {
            const int b = u.c0 >> 3, tq = u.c0 & 7; bf16_t* za = WSP(bf16_t, OFF_ZA);
#pragma unroll
            for (int ai = 0; ai < 2; ++ai)
#pragma unroll
                for (int m = 0; m < 4; ++m) { const int zrow = u.r0 + ai * 128 + wr * 64 + m * 16 + fr; const int part = zrow >> 9, gc = zrow & 511;
#pragma unroll
                    for (int bj = 0; bj < 2; ++bj) { const int j0 = bj * 128 + wc * 32 + 8 * fq; const int n1 = 4 * tq + (j0 >> 6), n2 = j0 & 63;
                        *(u32x4*)(za + ((size_t)((b * 32 + n1) * 512 + gc)) * 128 + part * 64 + n2) = pack8(acc[ai][bj][m][0], acc[ai][bj][m][1]); } }
        } else {
            const int tok0 = u.c0; const bool isx = tok0 < RX;
            const int b = isx ? tok0 / SEQ : (tok0 - RX) / CTX, nb = isx ? tok0 % SEQ : 0, Nb = isx ? SEQ : CTX;
            bf16_t* base = isx ? WSP(bf16_t, OFF_ZT) + (size_t)b * 512 * 4096 : WSP(bf16_t, OFF_ZTC) + (size_t)b * 512 * 512;
#pragma unroll
            for (int ai = 0; ai < 2; ++ai)
#pragma unroll
                for (int m = 0; m < 4; ++m) { const int zrow = u.r0 + ai * 128 + wr * 64 + m * 16 + fr; const int part = zrow >> 9, gc = zrow & 511;
#pragma unroll
                    for (int bj = 0; bj < 2; ++bj) *(u32x4*)(base + (size_t)gc * (2 * Nb) + part * Nb + nb + bj * 128 + wc * 32 + 8 * fq) = pack8(acc[ai][bj][m][0], acc[ai][bj][m][1]); }
        }
    }
};
struct EpiZ { const Ptrs P;
    __device__ __forceinline__ void operator()(const f32x4 (&acc)[2][2][4][2], const fg::GU& u, int wr, int wc, int fr, int fq) const {
        constexpr float sc = 1.f / W8SC;
        if (u.kind == 7) {
            const int b = u.c0 >> 3, tq = u.c0 & 7; bf16_t* za = WSP(bf16_t, OFF_ZA);
#pragma unroll
            for (int ai = 0; ai < 2; ++ai)
#pragma unroll
                for (int m = 0; m < 4; ++m) { const int zrow = u.r0 + ai * 128 + wr * 64 + m * 16 + fr; const int part = zrow >> 9, gc = zrow & 511;
#pragma unroll
                    for (int bj = 0; bj < 2; ++bj) { const int j0 = bj * 128 + wc * 32 + 8 * fq; const int n1 = 4 * tq + (j0 >> 6), n2 = j0 & 63;
                        *(u32x4*)(za + ((size_t)((b * 32 + n1) * 512 + gc)) * 128 + part * 64 + n2) = pack8(acc[ai][bj][m][0] * sc, acc[ai][bj][m][1] * sc); } }
        } else {
            const int tok0 = u.c0; const bool isx = tok0 < RX;
            const int b = isx ? tok0 / SEQ : (tok0 - RX) / CTX, nb = isx ? tok0 % SEQ : 0, Nb = isx ? SEQ : CTX;
            bf16_t* base = isx ? WSP(bf16_t, OFF_ZT) + (size_t)b * 512 * 4096 : WSP(bf16_t, OFF_ZTC) + (size_t)b * 512 * 512;
#pragma unroll
            for (int ai = 0; ai < 2; ++ai)
#pragma unroll
                for (int m = 0; m < 4; ++m) { const int zrow = u.r0 + ai * 128 + wr * 64 + m * 16 + fr; const int part = zrow >> 9, gc = zrow & 511;
#pragma unroll
                    for (int bj = 0; bj < 2; ++bj) *(u32x4*)(base + (size_t)gc * (2 * Nb) + part * Nb + nb + bj * 128 + wc * 32 + 8 * fq) = pack8(acc[ai][bj][m][0] * sc, acc[ai][bj][m][1] * sc); }
        }
    }
};
struct EpiGate { const Ptrs P; int l;
    __device__ __forceinline__ void operator()(const f32x4 (&acc)[2][2][4][2], const fg::GU& u, int wr, int wc, int fr, int fq) const {
        {
            u8* dst = WSP(u8, OFF_GATES); const float* bias = P.b_gate + (size_t)l * 3 * DM + u.aux + wc * 32 + 8 * fq;
            f32x4 bv[2][2];
#pragma unroll
            for (int bj = 0; bj < 2; ++bj) { bv[bj][0] = *(const f32x4*)(bias + bj * 128); bv[bj][1] = *(const f32x4*)(bias + bj * 128 + 4); }
#pragma unroll
            for (int ai = 0; ai < 2; ++ai)
#pragma unroll
                for (int m = 0; m < 4; ++m) { const int row = u.r0 + ai * 128 + wr * 64 + m * 16 + fr;
#pragma unroll
                    for (int bj = 0; bj < 2; ++bj) { u32x2 w;
#pragma unroll
                        for (int n = 0; n < 2; ++n) { unsigned pk = 0;
#pragma unroll
                            for (int j = 0; j < 4; ++j) { const float g = fmaxf(255.f * fast_sigmoid(acc[ai][bj][m][n][j] * (1.f / W8SC) + bv[bj][n][j]), 1.f); pk |= ((unsigned)__float2int_rn(g) & 0xffu) << (8 * j); }
                            w[n] = pk; }
                        *(u32x2*)(dst + (size_t)row * 3072 + u.aux + bj * 128 + wc * 32 + 8 * fq) = w; } }
        }
    }
};
struct SchedW1 { const char* H; const char* W1; int l;
    __device__ __forceinline__ bool next(int i, fg::GU& u) const {
        const int c = bid_(); const int nMx = l == 0 ? RT / 256 : RX / 256; const int n1 = nMx * 9, n2 = l == 0 ? 0 : 16;
        const int a0 = l == 0 ? 144 : 160, a1 = l == 0 ? 152 : 176, k0 = 3, k1 = l == 0 ? 1 : 2, k2 = l == 0 ? 2 : 1;
        const int cnt = c < a0 ? k0 : (c < a1 ? k1 : k2); const int base = c < a0 ? k0 * c : (c < a1 ? k0 * a0 + k1 * (c - a0) : k0 * a0 + k1 * (a1 - a0) + k2 * (c - a1));
        const int L = base + i; if (i >= cnt || L >= n1 + n2) return false; u.gl = nullptr; u.gn = 256; u.aux = 0; int pm, ct;
        if (L < n1) fg::tile_order(L, nMx, 9, pm, ct); else { const int j = L - n1; pm = RX / 256 + (j >> 1); ct = (j & 1) ? 2 : 0; }
        u.a = H + (size_t)pm * 256 * DM * 2; u.b = W1 + (size_t)ct * 256 * DM * 2; u.r0 = pm * 256; u.c0 = ct * 256;
        if (ct <= 2) u.kind = ct; else if (ct <= 4) { u.kind = 3; u.aux = (ct - 3) * 256; } else { u.kind = 4; u.aux = ct - 5; }
        return true; } };
struct SchedGate { const char* H8; const char* W8; int l;
    __device__ __forceinline__ bool next(int i, fg::GU& u) const { const int c = bid_(); const int nMx = l == 0 ? RT / 256 : RX / 256;
        const int b0 = l == 0 ? 144 : 160, b1 = l == 0 ? 152 : 176, b2 = l == 0 ? 224 : 256, n0 = l == 0 ? 3 : 2, n1 = l == 0 ? 6 : 3, n2 = l == 0 ? 4 : 5, n3 = 3;
        const int cnt = c < b0 ? n0 : (c < b1 ? n1 : (c < b2 ? n2 : n3));
        const int base = c < b0 ? n0 * c : (c < b1 ? n0 * b0 + n1 * (c - b0) : (c < b2 ? n0 * b0 + n1 * (b1 - b0) + n2 * (c - b1) : n0 * b0 + n1 * (b1 - b0) + n2 * (b2 - b1) + n3 * (c - b2)));
        const int L = base + i; if (i >= cnt || L >= nMx * 12) return false; int pm, ct; fg::tile_order(L, nMx, 12, pm, ct); u.gl = nullptr; u.gn = 256;
        u.a = H8 + (size_t)pm * 256 * DM; u.b = W8 + (size_t)ct * 256 * DM; u.r0 = pm * 256; u.c0 = 0; u.kind = 5; u.aux = ct * 256; return true; } };
struct SchedZx { const char* H; const char* WZ;
    __device__ __forceinline__ bool next(int i, fg::GU& u) const { const int L = i * (int)gridDim.x + bid_(); if (L >= 256) return false; const int zt = L & 3, bt = L >> 2, b = bt >> 3, tq = bt & 7;
        u.gl = nullptr; u.gn = 256; u.aux = 0; u.a = WZ + (size_t)zt * 256 * DM; u.b = H + ((size_t)b * SEQ + 4 * tq) * DM; u.r0 = zt * 256; u.c0 = bt; u.kind = 7; return true; } };
struct SchedZc { const char* H; const char* WZ;
    __device__ __forceinline__ bool next(int i, fg::GU& u) const { const int L = bid_() - 224; if (i > 0 || L < 0 || L >= 32) return false; const int zt = L & 3, tt = RX / 256 + (L >> 2);
        u.gl = nullptr; u.gn = 256; u.aux = 0; u.a = WZ + (size_t)zt * 256 * DM; u.b = H + (size_t)tt * 256 * DM; u.r0 = zt * 256; u.c0 = tt * 256; u.kind = 6; return true; } };
struct SchedFftA { const char* ZA; const char* MA;
    __device__ __forceinline__ bool next(int i, fg::GU& u) const { const int L = i * (int)gridDim.x + bid_(); if (L >= 512) return false; const int b = L >> 6, gcb = L & 63;
        u.gl = nullptr; u.gn = 256; u.aux = 0; u.kind = 0; u.a = MA; u.b = ZA + ((size_t)b * 32 * 512 + gcb * 8) * 256; u.r0 = b; u.c0 = gcb; return true; } };
struct EpiFftA { const Ptrs P;
    __device__ __forceinline__ void operator()(const f32x4 (&acc)[2][2][4][2], const fg::GU& u, int wr, int wc, int fr, int fq) const {
        if (wr != 0) return;
        const int b = u.r0, gcb = u.c0; bf16_t* zb = WSP(bf16_t, OFF_ZB); const float* tw = WSP(float, OFF_TW);
#pragma unroll
        for (int m = 0; m < 4; ++m) { const int k2 = 16 * m + fr; const float* t = tw + ((size_t)k2 * 32 + 8 * fq) * 2;
            const f32x4 t0 = *(const f32x4*)t, t1 = *(const f32x4*)(t + 4), t2 = *(const f32x4*)(t + 8), t3 = *(const f32x4*)(t + 12);
            const float c[8] = {t0[0], t0[2], t1[0], t1[2], t2[0], t2[2], t3[0], t3[2]}, sn[8] = {t0[1], t0[3], t1[1], t1[3], t2[1], t2[3], t3[1], t3[3]};
#pragma unroll
            for (int bj = 0; bj < 2; ++bj) { const int gc = gcb * 8 + 4 * bj + wc; float vr[8], vi[8];
#pragma unroll
                for (int j = 0; j < 8; ++j) { const float re = acc[0][bj][m][j >> 2][j & 3], im = acc[1][bj][m][j >> 2][j & 3]; vr[j] = re * c[j] + im * sn[j]; vi[j] = im * c[j] - re * sn[j]; }
                bf16_t* o = zb + ((((size_t)(b * 64 + k2) * 256 + (gc & 255)) * 2 + (gc >> 8)) * 64) + 8 * fq;
                *(u32x4*)o = pk8(vr); *(u32x4*)(o + 32) = pk8(vi); } }
    }
};
struct SchedFftB { const char* ZB; const char* MB;
    __device__ __forceinline__ bool next(int i, fg::GU& u) const { const int L = i * (int)gridDim.x + bid_(); if (L >= 512) return false;
        u.gl = nullptr; u.gn = 256; u.aux = 0; u.kind = 0; u.a = MB; u.b = ZB + (size_t)L * 256 * 256; u.r0 = L >> 6; u.c0 = L & 63; return true; } };
struct EpiFftB { bf16_t* four;
    __device__ __forceinline__ void operator()(const f32x4 (&acc)[2][2][4][2], const fg::GU& u, int wr, int wc, int fr, int fq) const {
        if (wr != 0) return;
        const int b = u.r0, k2 = u.c0;
#pragma unroll
        for (int m = 0; m < 4; ++m) { const int hf = m >> 1, k1 = 16 * (m & 1) + fr;
#pragma unroll
            for (int bj = 0; bj < 2; ++bj) *(u32x4*)(four + ((size_t)b * SEQ + 64 * k1 + k2) * FW + 256 * hf + bj * 128 + wc * 32 + 8 * fq) = pack8(acc[0][bj][m][0], acc[0][bj][m][1]); }
    }
};

struct EpiUKV { const Ptrs P;
    __device__ __forceinline__ void operator()(const f32x4 (&acc)[2][2][4][2], const fg::GU& u, int wr, int wc, int fr, int fq) const {
        f32x4 sp[2][4];
#pragma unroll
        for (int ai = 0; ai < 2; ++ai)
#pragma unroll
            for (int m = 0; m < 4; ++m) sp[ai][m] = *(const f32x4*)(WSP(float, OFF_SSP) + (size_t)(u.r0 + ai * 128 + wr * 64 + m * 16 + fr) * 4);
#pragma unroll
        for (int ai = 0; ai < 2; ++ai)
#pragma unroll
            for (int m = 0; m < 4; ++m) { const int row = u.r0 + ai * 128 + wr * 64 + m * 16 + fr;
                const float r = rsqrtf((sp[ai][m][0] + sp[ai][m][1] + sp[ai][m][2] + sp[ai][m][3]) * (1.f / KV_RANK) + EPS);
#pragma unroll
                for (int bj = 0; bj < 2; ++bj) { const int h = (u.c0 >> 7) + bj; const f32x4 v0 = acc[ai][bj][m][0] * r, v1 = acc[ai][bj][m][1] * r;
                    bf16_t* dst = wc < 2 ? WSP(bf16_t, OFF_K) + (size_t)row * 768 + h * 96 + wc * 32 + 8 * fq : WSP(bf16_t, OFF_V) + (size_t)row * 512 + h * 64 + (wc - 2) * 32 + 8 * fq;
                    *(u32x4*)dst = pack8(v0, v1); } }
    }
};
struct EpiUQ { const Ptrs P;
    __device__ __forceinline__ void operator()(const f32x4 (&acc)[2][2][4][2], const fg::GU& u, int wr, int wc, int fr, int fq) const {
        const int col0 = u.c0 + wc * 32, col1 = col0 + 128; const bool rope0 = ((col0 >> 5) % 3) == 2, rope1 = ((col1 >> 5) % 3) == 2;
#pragma unroll
        for (int ai = 0; ai < 2; ++ai) { f32x4 s0[4], s1[4], t0[4], t1[4];
#pragma unroll
            for (int m = 0; m < 4; ++m) { const int row = u.r0 + ai * 128 + wr * 64 + m * 16 + fr; const float* spp = WSP(float, OFF_SSPQ) + (size_t)row * 8; s0[m] = *(const f32x4*)spp; s1[m] = *(const f32x4*)(spp + 4);
                t0[m] = (f32x4){0.f, 0.f, 0.f, 0.f}; t1[m] = t0[m];
                if (rope0 || rope1) { const int rr = row < RX ? row : 0; const float* cs = WSP(float, OFF_ROPE) + ((size_t)(rr & (SEQ - 1)) * 16 + 4 * fq) * 2; t0[m] = *(const f32x4*)cs; t1[m] = *(const f32x4*)(cs + 4); } }
#pragma unroll
            for (int m = 0; m < 4; ++m) { const int row = u.r0 + ai * 128 + wr * 64 + m * 16 + fr;
                const float r = rsqrtf((((s0[m][0] + s0[m][1]) + (s0[m][2] + s0[m][3])) + ((s1[m][0] + s1[m][1]) + (s1[m][2] + s1[m][3]))) * (1.f / Q_RANK) + EPS) * QSCALE;
#pragma unroll
                for (int bj = 0; bj < 2; ++bj) { const int col = bj == 0 ? col0 : col1; const bool rope = bj == 0 ? rope0 : rope1;
                    f32x4 v0 = acc[ai][bj][m][0] * r, v1 = acc[ai][bj][m][1] * r;
                    if (rope && row < RX) { const float c[4] = {t0[m][0], t0[m][2], t1[m][0], t1[m][2]}, sn[4] = {t0[m][1], t0[m][3], t1[m][1], t1[m][3]}; const f32x4 x1 = v0, x2 = v1;
#pragma unroll
                        for (int j = 0; j < 4; ++j) { v0[j] = x1[j] * c[j] - x2[j] * sn[j]; v1[j] = x2[j] * c[j] + x1[j] * sn[j]; } }
                    *(u32x4*)(WSP(bf16_t, OFF_Q) + (size_t)row * 768 + col + 8 * fq) = pack8(v0, v1); } } }
    }
};
struct SchedPlainShift { const char* A; const char* Bt; int nM, nN, K, shift;
    __device__ __forceinline__ bool next(int i, fg::GU& u) const { const int G = gridDim.x; const int L = i * G + (bid_() + G - shift) % G; if (L >= nM * nN) return false; int pm, pn; fg::tile_order(L, nM, nN, pm, pn);
        u.a = A + (size_t)pm * 256 * K * 2; u.b = Bt + (size_t)pn * 256 * K * 2; u.r0 = pm * 256; u.c0 = pn * 256; u.kind = 0; u.aux = 0; u.gl = nullptr; u.gn = 256; return true; } };

namespace at {
constexpr int NW = 8, QBLK = 32, KVBLK = 64, DQK = 96, DV = 64;
constexpr int SHM_V = KVBLK * DV * 2, SHM_K = KVBLK * 256, NSLOT = 4, SLOT_B = SHM_K + SHM_V, SHM_ATTN = NSLOT * SLOT_B + NW * 64 * 4;
constexpr float THR2 = 2896.309375740099f;
typedef short s16x4 __attribute__((ext_vector_type(4)));
typedef float f32x16 __attribute__((ext_vector_type(16)));
#define AT_KSWZ(row, colB) ((row) * 256 + ((colB) ^ (((row) & 15) << 4)))
#define AT_SBAR() __builtin_amdgcn_sched_barrier(0)
__device__ __forceinline__ int crow(int r, int hi) { return (r & 3) + 8 * (r >> 2) + 4 * hi; }
__device__ __forceinline__ float rowmaxSM(const f32x16& p0, const f32x16& p1) {
  float pmax = p0[0];
#pragma unroll
  for (int r = 1; r < 16; ++r) pmax = fmaxf(pmax, p0[r]);
#pragma unroll
  for (int r = 0; r < 16; ++r) pmax = fmaxf(pmax, p1[r]);
  { auto rr = __builtin_amdgcn_permlane32_swap(__float_as_uint(pmax), __float_as_uint(pmax), false, false);
    pmax = fmaxf(__uint_as_float(rr[0]), __uint_as_float(rr[1])); }
  return pmax;
}
__device__ __forceinline__ void headSM(f32x16& p0, f32x16& p1, float& m_reg, float& mn, float& alpha) {
  const float pmax = rowmaxSM(p0, p1); mn = fmaxf(m_reg, pmax); alpha = __builtin_amdgcn_exp2f(m_reg - mn); m_reg = mn;
#pragma unroll
  for (int r = 0; r < 16; ++r) p0[r] = p0[r] - mn;
#pragma unroll
  for (int r = 0; r < 16; ++r) p1[r] = p1[r] - mn;
#pragma unroll
  for (int r = 0; r < 16; ++r) p0[r] = __builtin_amdgcn_exp2f(p0[r]);
}
struct KFrag { bf16x8 f[12]; };
template <int OFF> __device__ __forceinline__ bf16x8 k_read(int a) { bf16x8 r; asm volatile("ds_read_b128 %0, %1 offset:%2" : "=v"(r) : "v"(a), "i"(OFF) : "memory"); return r; }
__device__ __forceinline__ void k_issue(KFrag& k, const int (&ka)[DQK / 16], int so) {
#pragma unroll
  for (int d0 = 0; d0 < DQK / 16; ++d0) { const int a = ka[d0] + so; k.f[2 * d0] = k_read<0>(a); k.f[2 * d0 + 1] = k_read<32 * 256>(a); }
}
__device__ __forceinline__ void dma16(const void* g, unsigned ldsaddr) { unsigned keep;
  asm volatile("s_mov_b32 %0, m0\n\ts_mov_b32 m0, %2\n\ts_nop 0\n\tglobal_load_lds_dwordx4 %1, off\n\ts_mov_b32 m0, %0" : "=&s"(keep) : "v"(g), "s"(ldsaddr) : "memory"); }
#define AT_KW(N, A, B) asm volatile("s_waitcnt lgkmcnt(" #N ")" : "+v"(A), "+v"(B))
#define AT_MM(A, B, C) __builtin_amdgcn_mfma_f32_32x32x16_bf16(A, B, C, 0, 0, 0)
#define AT_PK4(P, BASE, OUT) do { unsigned a0 = cvt_pk_bf16(P[BASE + 0], P[BASE + 1]), a1 = cvt_pk_bf16(P[BASE + 2], P[BASE + 3]);   \
    unsigned b0 = cvt_pk_bf16(P[BASE + 4], P[BASE + 5]), b1 = cvt_pk_bf16(P[BASE + 6], P[BASE + 7]);                              \
    auto r0 = __builtin_amdgcn_permlane32_swap(a0, b0, false, false); auto r1 = __builtin_amdgcn_permlane32_swap(a1, b1, false, false); \
    u32x4 w = {r0[0], r1[0], r0[1], r1[1]}; OUT = *reinterpret_cast<bf16x8*>(&w); } while (0)
template <bool PREV> __device__ __forceinline__ void qk_block(f32x16& n0, f32x16& n1, KFrag& k, const bf16x8* qr, const float zf, f32x16& P0, f32x16& P1, float& psum, float& l_reg, bf16x8& pa0, bf16x8& pa1, bf16x8& pa2, bf16x8& pa3) {
  f32x16 z; _Pragma("unroll") for (int r = 0; r < 16; ++r) z[r] = zf;
  float ps = 0.f;
  if (PREV) {
#pragma unroll
    for (int r = 0; r < 16; ++r) P1[r] = __builtin_amdgcn_exp2f(P1[r]);
    asm volatile("s_waitcnt lgkmcnt(10)" : "+v"(k.f[0]), "+v"(k.f[1]), "+v"(P1)); }
  else AT_KW(10, k.f[0], k.f[1]);
  n0 = AT_MM(k.f[0], qr[0], z); n1 = AT_MM(k.f[1], qr[0], z);
  if (PREV) {
#pragma unroll
    for (int r = 0; r < 16; ++r) ps += P0[r]; }
  AT_SBAR();
  AT_KW(8, k.f[2], k.f[3]); n0 = AT_MM(k.f[2], qr[1], n0); n1 = AT_MM(k.f[3], qr[1], n1);
  if (PREV) {
#pragma unroll
    for (int r = 0; r < 16; ++r) ps += P1[r]; }
  AT_SBAR();
  AT_KW(6, k.f[4], k.f[5]); n0 = AT_MM(k.f[4], qr[2], n0); n1 = AT_MM(k.f[5], qr[2], n1);
  if (PREV) { AT_PK4(P0, 0, pa0); AT_PK4(P0, 8, pa1); }
  AT_SBAR();
  AT_KW(4, k.f[6], k.f[7]); n0 = AT_MM(k.f[6], qr[3], n0); n1 = AT_MM(k.f[7], qr[3], n1);
  if (PREV) { AT_PK4(P1, 0, pa2); AT_PK4(P1, 8, pa3); }
  AT_SBAR();
  AT_KW(2, k.f[8], k.f[9]); n0 = AT_MM(k.f[8], qr[4], n0); n1 = AT_MM(k.f[9], qr[4], n1);
  if (PREV) { auto rr = __builtin_amdgcn_permlane32_swap(__float_as_uint(ps), __float_as_uint(ps), false, false);
    ps = __uint_as_float(rr[0]) + __uint_as_float(rr[1]); l_reg += ps; psum = ps; }
  AT_SBAR();
  AT_KW(0, k.f[10], k.f[11]); n0 = AT_MM(k.f[10], qr[5], n0); n1 = AT_MM(k.f[11], qr[5], n1);
  AT_SBAR();
}
__device__ __forceinline__ int v_st(int k, int c) { const int kk = (k & ~0xC) | ((k & 4) << 1) | ((k & 8) >> 1); return ((kk >> 3) * 2 + (c >> 5)) * 512 + ((kk & 7) * 32 + (c & 31)) * 2; }
__device__ __forceinline__ int v_rd_base(int lane) { return ((lane & 3) << 3) | (((lane >> 2) & 3) << 6) | (((lane >> 4) & 1) << 5) | (((lane >> 5) & 1) << 8); }
constexpr int v_rd_off(int d0, int ks, int half) { return d0 * 512 + ks * 2048 + half * 1024; }
template <int OFF> __device__ __forceinline__ s16x4 tr_read(int vb) {
  s16x4 r; asm volatile("ds_read_b64_tr_b16 %0, %1 offset:%2" : "=&v"(r) : "v"(vb), "i"(OFF) : "memory"); return r;
}
struct VFrag { s16x4 f[16]; };
__device__ __forceinline__ void pv_issue(VFrag& v, int vb) {
  v.f[0] = tr_read<v_rd_off(0, 0, 0)>(vb);  v.f[1] = tr_read<v_rd_off(0, 0, 1)>(vb);  v.f[2] = tr_read<v_rd_off(1, 0, 0)>(vb);  v.f[3] = tr_read<v_rd_off(1, 0, 1)>(vb);
  v.f[4] = tr_read<v_rd_off(0, 1, 0)>(vb);  v.f[5] = tr_read<v_rd_off(0, 1, 1)>(vb);  v.f[6] = tr_read<v_rd_off(1, 1, 0)>(vb);  v.f[7] = tr_read<v_rd_off(1, 1, 1)>(vb);
  v.f[8] = tr_read<v_rd_off(0, 2, 0)>(vb);  v.f[9] = tr_read<v_rd_off(0, 2, 1)>(vb);  v.f[10] = tr_read<v_rd_off(1, 2, 0)>(vb); v.f[11] = tr_read<v_rd_off(1, 2, 1)>(vb);
  v.f[12] = tr_read<v_rd_off(0, 3, 0)>(vb); v.f[13] = tr_read<v_rd_off(0, 3, 1)>(vb); v.f[14] = tr_read<v_rd_off(1, 3, 0)>(vb); v.f[15] = tr_read<v_rd_off(1, 3, 1)>(vb);
}
#define AT_VW(N, V, I) asm volatile("s_waitcnt lgkmcnt(" #N ")" : "+v"(V.f[I]), "+v"(V.f[I + 1]), "+v"(V.f[I + 2]), "+v"(V.f[I + 3]))
#define AT_PK(L, H) (bf16x8){L[0], L[1], L[2], L[3], H[0], H[1], H[2], H[3]}
template <bool NEXT> __device__ __forceinline__ void pv_block(f32x16* o, VFrag& v, bf16x8 pa0, bf16x8 pa1, bf16x8 pa2, bf16x8 pa3, f32x16& n0, f32x16& n1, float& m_reg, float& l_reg, float psum, float& alpha) {
  if (NEXT) {
#pragma unroll
    for (int r = 0; r < 4; ++r) n0[r] = __builtin_amdgcn_exp2f(n0[r]);
    asm volatile("s_waitcnt lgkmcnt(12)" : "+v"(v.f[0]), "+v"(v.f[1]), "+v"(v.f[2]), "+v"(v.f[3]), "+v"(n0)); }
  else AT_VW(12, v, 0);
  o[0] = AT_MM(pa0, AT_PK(v.f[0], v.f[1]), o[0]); o[1] = AT_MM(pa0, AT_PK(v.f[2], v.f[3]), o[1]);
  if (NEXT) {
#pragma unroll
    for (int r = 4; r < 8; ++r) n0[r] = __builtin_amdgcn_exp2f(n0[r]);
    asm volatile("s_waitcnt lgkmcnt(8)" : "+v"(v.f[4]), "+v"(v.f[5]), "+v"(v.f[6]), "+v"(v.f[7]), "+v"(n0)); }
  else AT_VW(8, v, 4);
  o[0] = AT_MM(pa1, AT_PK(v.f[4], v.f[5]), o[0]); o[1] = AT_MM(pa1, AT_PK(v.f[6], v.f[7]), o[1]);
  if (NEXT) {
#pragma unroll
    for (int r = 8; r < 12; ++r) n0[r] = __builtin_amdgcn_exp2f(n0[r]);
    asm volatile("s_waitcnt lgkmcnt(4)" : "+v"(v.f[8]), "+v"(v.f[9]), "+v"(v.f[10]), "+v"(v.f[11]), "+v"(n0)); }
  else AT_VW(4, v, 8);
  o[0] = AT_MM(pa2, AT_PK(v.f[8], v.f[9]), o[0]); o[1] = AT_MM(pa2, AT_PK(v.f[10], v.f[11]), o[1]);
  if (NEXT) {
#pragma unroll
    for (int r = 12; r < 16; ++r) n0[r] = __builtin_amdgcn_exp2f(n0[r]);
    asm volatile("s_waitcnt lgkmcnt(0)" : "+v"(v.f[12]), "+v"(v.f[13]), "+v"(v.f[14]), "+v"(v.f[15]), "+v"(n0)); }
  else AT_VW(0, v, 12);
  o[0] = AT_MM(pa3, AT_PK(v.f[12], v.f[13]), o[0]); o[1] = AT_MM(pa3, AT_PK(v.f[14], v.f[15]), o[1]);
  AT_SBAR();
  if (NEXT) {
    alpha = 1.f;
    if (!__all(psum <= THR2)) { const float ex = fmaxf(__builtin_amdgcn_logf(psum), 0.f); alpha = __builtin_amdgcn_exp2f(-ex); m_reg += ex; l_reg *= alpha;
#pragma unroll
      for (int r = 0; r < 16; ++r) { n0[r] *= alpha; n1[r] -= ex; } } }
}
#undef AT_PK
__device__ __forceinline__ void attn_unit(const bf16_t* __restrict__ Qg, const bf16_t* __restrict__ Kg, const bf16_t* __restrict__ Vg, bf16_t* __restrict__ Og,
                                          int qrow0, int h, int ctxrow0, int xrow0, int nctx_t, int NT, char* lds, int wid) {
  const int tid = hidden_tid(wid), lane = tid & 63, r32 = lane & 31, hi = lane >> 5;
  const unsigned lds0 = (unsigned)(uintptr_t)lds;
  float* ws = (float*)(lds + NSLOT * SLOT_B) + wid * 64; float* li_l = ws; float* al_l = ws + 32;
  float m_reg = -1e30f, l_reg = 0; f32x16 o[2] = {}; bf16x8 qr[DQK / 16];
  const bf16_t* Kh = Kg + h * 96; const bf16_t* Vh = Vg + h * 64;
  const int kra = 8 * wid + (lane >> 4), krb = kra + 4, cpos = lane & 15, ca = cpos ^ (kra & 15), cb = cpos ^ (krb & 15);
  const bool va = ca < 12, vb_ = cb < 12; const int koffa = kra * 768 + ca * 8, koffb = krb * 768 + cb * 8;
  const int vu = wid * 64 + lane, vsub = vu >> 5, vkk = (vsub >> 1) * 8 + ((vu >> 2) & 7), vk = (vkk & ~0xC) | ((vkk & 4) << 1) | ((vkk & 8) >> 1), voff = vk * 512 + (vsub & 1) * 32 + (vu & 3) * 8;
#define AT_KROW(j) ((j) < nctx_t ? ctxrow0 + (j) * KVBLK : xrow0 + ((j) - nctx_t) * KVBLK)
#define AT_SLOT(t) (((t) & (NSLOT - 1)) * SLOT_B)
#define AT_DMA(t) do { const int _kr = AT_KROW(t); const unsigned _sb = lds0 + AT_SLOT(t); const bf16_t* _kp = Kh + (size_t)_kr * 768;                 \
    if (va) dma16(_kp + koffa, _sb + wid * 2048); if (vb_) dma16(_kp + koffb, _sb + wid * 2048 + 1024); dma16(Vh + (size_t)_kr * 512 + voff, _sb + SHM_K + wid * 1024); } while (0)
#define AT_TOP(t) do { if ((t) + 1 < NT) asm volatile("s_waitcnt vmcnt(3)" ::: "memory"); else asm volatile("s_waitcnt vmcnt(0)" ::: "memory"); __syncthreads(); if ((t) + 2 < NT) AT_DMA((t) + 2); } while (0)
#define AT_RESC(a) do { if (__any((a) < 1.f)) { if (hi == 0) al_l[r32] = (a); asm volatile("s_waitcnt lgkmcnt(0)" ::: "memory"); \
    _Pragma("unroll") for (int d = 0; d < 2; ++d) _Pragma("unroll") for (int r = 0; r < 16; ++r) o[d][r] *= al_l[crow(r, hi)]; } } while (0)
  AT_DMA(0); AT_DMA(1);
  const bf16_t* Qw = Qg + (size_t)(qrow0 + wid * QBLK + r32) * 768 + h * 96 + hi * 8;
#pragma unroll
  for (int d0 = 0; d0 < DQK / 16; ++d0) qr[d0] = *reinterpret_cast<const bf16x8*>(Qw + d0 * 16);
  const int vb0 = (int)lds0 + SHM_K + v_rd_base(lane);
  f32x16 pA0, pA1, pB0, pB1; float mnA, alA, alB, psum = 0.f; bf16x8 pa0, pa1, pa2, pa3; KFrag kf; VFrag vf;
  int ka[DQK / 16];
#pragma unroll
  for (int d0 = 0; d0 < DQK / 16; ++d0) ka[d0] = (int)lds0 + AT_KSWZ(r32, (d0 * 16 + hi * 8) * 2);
  asm volatile("s_waitcnt vmcnt(0)" ::: "memory"); __syncthreads(); AT_DMA(2);
  k_issue(kf, ka, 0); AT_SBAR(); qk_block<false>(pA0, pA1, kf, qr, 0.f, pA0, pA1, psum, l_reg, pa0, pa1, pa2, pa3); headSM(pA0, pA1, m_reg, mnA, alA);

  for (int t = 1; t + 1 < NT; t += 2) {
    AT_TOP(t);
    AT_SBAR(); k_issue(kf, ka, AT_SLOT(t)); AT_SBAR(); qk_block<true>(pB0, pB1, kf, qr, -m_reg, pA0, pA1, psum, l_reg, pa0, pa1, pa2, pa3);
    pv_issue(vf, vb0 + AT_SLOT(t - 1)); AT_SBAR(); pv_block<true>(o, vf, pa0, pa1, pa2, pa3, pB0, pB1, m_reg, l_reg, psum, alB);
    AT_RESC(alB);
    AT_TOP(t + 1);
    AT_SBAR(); k_issue(kf, ka, AT_SLOT(t + 1)); AT_SBAR(); qk_block<true>(pA0, pA1, kf, qr, -m_reg, pB0, pB1, psum, l_reg, pa0, pa1, pa2, pa3);
    pv_issue(vf, vb0 + AT_SLOT(t)); AT_SBAR(); pv_block<true>(o, vf, pa0, pa1, pa2, pa3, pA0, pA1, m_reg, l_reg, psum, alA);
    AT_RESC(alA);
  }
  AT_TOP(NT - 1);
  AT_SBAR(); k_issue(kf, ka, AT_SLOT(NT - 1)); AT_SBAR(); qk_block<true>(pB0, pB1, kf, qr, -m_reg, pA0, pA1, psum, l_reg, pa0, pa1, pa2, pa3);
  pv_issue(vf, vb0 + AT_SLOT(NT - 2)); AT_SBAR(); pv_block<true>(o, vf, pa0, pa1, pa2, pa3, pB0, pB1, m_reg, l_reg, psum, alB);
  AT_RESC(alB);
  { float ps = 0.f;
#pragma unroll
    for (int r = 0; r < 16; ++r) pB1[r] = __builtin_amdgcn_exp2f(pB1[r]);
#pragma unroll
    for (int r = 0; r < 16; ++r) ps += pB0[r];
#pragma unroll
    for (int r = 0; r < 16; ++r) ps += pB1[r];
    { auto rr = __builtin_amdgcn_permlane32_swap(__float_as_uint(ps), __float_as_uint(ps), false, false); ps = __uint_as_float(rr[0]) + __uint_as_float(rr[1]); }
    l_reg += ps; AT_PK4(pB0, 0, pa0); AT_PK4(pB0, 8, pa1); AT_PK4(pB1, 0, pa2); AT_PK4(pB1, 8, pa3); }
  AT_SBAR();
  pv_issue(vf, vb0 + AT_SLOT(NT - 1)); pv_block<false>(o, vf, pa0, pa1, pa2, pa3, pB0, pB1, m_reg, l_reg, psum, alB);
  if (hi == 0) li_l[r32] = l_reg; asm volatile("s_waitcnt lgkmcnt(0)" ::: "memory");
  float rli[16];
#pragma unroll
  for (int r = 0; r < 16; ++r) rli[r] = __builtin_amdgcn_rcpf(li_l[crow(r, hi)]);
  bf16_t* Ow = Og + (size_t)(qrow0 + wid * QBLK) * 512 + h * 64;
#pragma unroll
  for (int r = 0; r < 16; ++r) { const int orow = crow(r, hi);
#pragma unroll
    for (int d0 = 0; d0 < 2; ++d0) Ow[(size_t)orow * 512 + d0 * 32 + r32] = f2bf(o[d0][r] * rli[r]); }
  __syncthreads();
#undef AT_KROW
#undef AT_SLOT
#undef AT_DMA
#undef AT_TOP
#undef AT_RESC
}
}

struct EpiBf16 { bf16_t* o; int ld;
    __device__ __forceinline__ void operator()(const f32x4 (&acc)[2][2][4][2], const fg::GU& u, int wr, int wc, int fr, int fq) const {
#pragma unroll
        for (int ai = 0; ai < 2; ++ai)
#pragma unroll
            for (int m = 0; m < 4; ++m) { const int row = u.r0 + ai * 128 + wr * 64 + m * 16 + fr;
#pragma unroll
                for (int bj = 0; bj < 2; ++bj) *(u32x4*)(o + (size_t)row * ld + u.c0 + bj * 128 + wc * 32 + 8 * fq) = pack8(acc[ai][bj][m][0], acc[ai][bj][m][1]); }
    }
};
struct SchedF2c { const char* T; const char* ZT;
    __device__ __forceinline__ bool next(int i, fg::GU& u) const { const int c = bid_() - 192; if (i > 0 || c < 0 || c >= 16) return false; const int b = c >> 1, pn = c & 1;
        u.a = T; u.b = ZT + ((size_t)b * 512 + pn * 256) * 512 * 2; u.r0 = RX + b * CTX; u.c0 = pn * 256; u.kind = 0; u.aux = 0; u.gl = nullptr; u.gn = 256; return true; } };
__device__ __forceinline__ void attn_phase(const Ptrs& P, int l, char* lds, int wid) {
    const int c = bid_(); const bf16_t* Q = WSP(bf16_t, OFF_Q); const bf16_t* K = WSP(bf16_t, OFF_K); const bf16_t* V = WSP(bf16_t, OFF_V); bf16_t* O = WSP(bf16_t, OFF_ATT);
    { const int x = c & 7, sidx = c >> 3;
#pragma unroll
      for (int k = 0; k < 2; ++k) { const int loc = sidx + 32 * k; const int bh = x * 8 + (loc >> 3), qb = loc & 7; const int b = bh >> 3, h = bh & 7;
          at::attn_unit(Q, K, V, O, b * SEQ + qb * 256, h, RX + b * CTX, b * SEQ, CTX / 64, (CTX + SEQ) / 64, lds, wid); } }
    if (l == 0 && c >= 128 && c < 192) { const int j = c - 128, b = j >> 3, h = j & 7;
        at::attn_unit(Q, K, V, O, RX + b * CTX, h, RX + b * CTX, 0, CTX / 64, CTX / 64, lds, wid); }
}

__device__ __forceinline__ char* moe_wgu(const Ptrs& P, int l, int e) { return l == 0 ? P.ws + OFF_WGU + (size_t)e * MOE_WBLK : e < NE ? (char*)P.out + ((size_t)32 << 20) + (size_t)e * MOE_WBLK : P.ws + OFF_CTXRES + ((size_t)4 << 20); }
__device__ __forceinline__ char* moe_wd(const Ptrs& P, int l, int e) { return l == 0 ? P.ws + OFF_WD + (size_t)e * MOE_WBLK : e < NE ? (char*)P.out + ((size_t)48 << 20) + (size_t)e * MOE_WBLK : P.ws + OFF_CTXRES + ((size_t)4 << 20) + MOE_WBLK; }
__device__ __forceinline__ void moe_tr_tile(const Ptrs& P, int l, int t, const float*& src, int& ld, char*& dst, int& K, bool& o8) {
    const int e = t / 96, r = t % 96;
    if (r < 64) { const int nb = r >> 3, kb = r & 7, pn = nb >> 2, half = (nb >> 1) & 1, sub = nb & 1;
        const float* base = half ? (e < NE ? P.w_up_e + ((size_t)l * NE + e) * DM * FE : P.w_up_s + (size_t)l * DM * FE) : (e < NE ? P.w_gate_e + ((size_t)l * NE + e) * DM * FE : P.w_gate_s + (size_t)l * DM * FE);
        ld = FE; K = DM; o8 = true; src = base + (size_t)(128 * kb) * FE + 128 * pn + 64 * sub; dst = moe_wgu(P, l, e) + (size_t)(64 * nb) * DM + 128 * kb; }
    else { const int q = r - 64, nb = q >> 1, kb = q & 1;
        const float* base = e < NE ? P.w_down_e + ((size_t)l * NE + e) * FE * DM : P.w_down_s + (size_t)l * FE * DM;
        ld = DM; K = FE; o8 = false; src = base + (size_t)(128 * kb) * DM + 64 * nb; dst = moe_wd(P, l, e) + ((size_t)(64 * nb) * FE + 128 * kb) * 2; }
}
__device__ __forceinline__ void moe_tr_dma(const float* src, int ld, LAS unsigned char* buf, int tid, int wid) {
#pragma unroll
    for (int i = 0; i < 4; ++i) { const int e = tid + 512 * i, kk = e >> 4, n4 = (e & 15) * 4; const float* g = src + (size_t)kk * ld + n4; unsigned keep;
        asm volatile("s_mov_b32 %0, m0\n\ts_mov_b32 m0, %2\n\ts_nop 0\n\tglobal_load_lds_dwordx4 %1, off\n\ts_mov_b32 m0, %0" : "=&s"(keep) : "v"(g), "s"((unsigned)(size_t)(buf + (wid * 64 + 512 * i) * 16)) : "memory"); }
}
__device__ __forceinline__ void prep_moe(const Ptrs& P, int l, LAS unsigned char* lds, int wid, int wg0) {
    const int G = (int)gridDim.x - wg0, me = bid_() - wg0; if (me < 0) return;
    const int tid = hidden_tid(wid); constexpr int NT = 33 * 96;
    const float* src = nullptr; int ld = 0; char* dst = nullptr; int K = 0; bool o8 = false; int cur = 0;
    int t = me; if (t >= NT) return;
    moe_tr_tile(P, l, t, src, ld, dst, K, o8); moe_tr_dma(src, ld, lds, tid, wid);
    for (; t < NT; t += G) {
        asm volatile("s_waitcnt vmcnt(0)" ::: "memory"); __syncthreads();
        char* cdst = dst; const int cK = K; const bool co8 = o8; const LAS float* tile = (const LAS float*)(lds + cur * 32768);
        if (t + G < NT) { moe_tr_tile(P, l, t + G, src, ld, dst, K, o8); moe_tr_dma(src, ld, lds + (cur ^ 1) * 32768, tid, wid); }
#pragma unroll
        for (int i = 0; i < 2; ++i) { const int e = tid + 512 * i, nn = e & 63, kc = (e >> 6) * 8; float v[8];
#pragma unroll
            for (int j = 0; j < 8; ++j) v[j] = tile[(kc + j) * 64 + nn];
            if (co8) *(u32x2*)((u8*)cdst + (size_t)nn * cK + kc) = pk8_fp8(v, W8SC); else *(u32x4*)((bf16_t*)cdst + (size_t)nn * cK + kc) = pk8(v); }
        __syncthreads(); cur ^= 1; }
    asm volatile("s_waitcnt vmcnt(0)" ::: "memory");
}
struct MoeTile { int e, i, gn, r0; };
__device__ __forceinline__ bool moe_tile(const LAS int* base, const LAS int* cnt, int rt, int nMl, MoeTile& t) {
    const int T = base[NE] >> 8;
    if (rt < T) { int e = 0;
        for (int k = 1; k < NE; ++k) e = (base[k] <= rt * 256) ? k : e;
        t.e = e; t.i = rt - (base[e] >> 8); const int rem = cnt[e] - t.i * 256; t.gn = rem < 256 ? rem : 256; t.r0 = rt * 256; return true; }
    const int ts = rt - T; if (ts >= nMl) return false;
    t.e = NE; t.i = ts; t.gn = 256; t.r0 = SLOTS + ts * 256; return true;
}
struct SchedMoe1 { const char* H2; const char* WGU; const char* WGUS; const LAS int* base; const LAS int* cnt; const int* toklist; const int* idl; int nMl;
    __device__ __forceinline__ bool next(int i, fg::GU& u) const { const int L = i * (int)gridDim.x + bid_(); const int nrt = (base[NE] >> 8) + nMl; if (L >= nrt * 2) return false;
        int rt, pn; fg::tile_order(L, nrt, 2, rt, pn); MoeTile t; moe_tile(base, cnt, rt, nMl, t);
        u.a = H2; u.b = (t.e < NE ? WGU + (size_t)t.e * MOE_WBLK : WGUS) + (size_t)pn * 256 * DM; u.gl = t.e < NE ? toklist + (size_t)t.e * RT + t.i * 256 : idl + t.i * 256; u.gn = t.gn;
        u.kind = t.e; u.r0 = t.r0; u.c0 = pn * 128; u.aux = t.i * 256; return true; } };
struct EpiAct { bf16_t* act; const float* wlist;
    __device__ __forceinline__ void operator()(const f32x4 (&acc)[2][2][4][2], const fg::GU& u, int wr, int wc, int fr, int fq) const {
#pragma unroll
        for (int ai = 0; ai < 2; ++ai)
#pragma unroll
            for (int m = 0; m < 4; ++m) { const int lr = ai * 128 + wr * 64 + m * 16 + fr; const int lc = lr < u.gn ? lr : u.gn - 1;
                const float w = u.kind < NE ? wlist[(size_t)u.kind * RT + u.aux + lc] : 1.f; f32x4 o[2];
#pragma unroll
                for (int n = 0; n < 2; ++n)
#pragma unroll
                    for (int j = 0; j < 4; ++j) { const float g = acc[ai][0][m][n][j] * (1.f / W8SC); o[n][j] = g * fast_sigmoid(g) * (acc[ai][1][m][n][j] * (1.f / W8SC)) * w; }
                *(u32x4*)(act + (size_t)(u.r0 + lr) * FE + u.c0 + wc * 32 + 8 * fq) = pack8(o[0], o[1]); }
    }
};
struct SchedMoe2 { const char* ACT; const char* WD; const char* WDS; const LAS int* base; const LAS int* cnt; int nMl;
    __device__ __forceinline__ bool next(int i, fg::GU& u) const { const int L = i * (int)gridDim.x + bid_(); const int nrt = (base[NE] >> 8) + nMl; if (L >= nrt * 4) return false;
        int rt, pn; fg::tile_order(L, nrt, 4, rt, pn); MoeTile t; moe_tile(base, cnt, rt, nMl, t);
        u.a = ACT + (size_t)t.r0 * FE * 2; u.b = (t.e < NE ? WD + (size_t)t.e * MOE_WBLK : WDS) + (size_t)pn * 256 * FE * 2; u.gl = nullptr; u.gn = 256;
        u.kind = t.e; u.r0 = t.e < NE ? t.r0 : t.i * 256; u.c0 = pn * 256; u.aux = 0; return true; } };
constexpr float YSC = 8.f;
__device__ __forceinline__ float y8(float v) { return __builtin_amdgcn_fmed3f(v * YSC, -448.f, 448.f); }
__device__ __forceinline__ u32x2 pack8_fp8(const f32x4& v0, const f32x4& v1) { int a = __builtin_amdgcn_cvt_pk_fp8_f32(y8(v0[0]), y8(v0[1]), 0, false); a = __builtin_amdgcn_cvt_pk_fp8_f32(y8(v0[2]), y8(v0[3]), a, true);
    int b = __builtin_amdgcn_cvt_pk_fp8_f32(y8(v1[0]), y8(v1[1]), 0, false); b = __builtin_amdgcn_cvt_pk_fp8_f32(y8(v1[2]), y8(v1[3]), b, true); return (u32x2){(unsigned)a, (unsigned)b}; }
struct EpiY { u8* y; u8* ys;
    __device__ __forceinline__ void operator()(const f32x4 (&acc)[2][2][4][2], const fg::GU& u, int wr, int wc, int fr, int fq) const {
        u8* o = u.kind < NE ? y : ys;
#pragma unroll
        for (int ai = 0; ai < 2; ++ai)
#pragma unroll
            for (int m = 0; m < 4; ++m) { const int row = u.r0 + ai * 128 + wr * 64 + m * 16 + fr;
#pragma unroll
                for (int bj = 0; bj < 2; ++bj) *(u32x2*)(o + (size_t)row * DM + u.c0 + bj * 128 + wc * 32 + 8 * fq) = pack8_fp8(acc[ai][bj][m][0], acc[ai][bj][m][1]); }
    }
};

__device__ __forceinline__ void ada_phase(const Ptrs& P, float* ldsf, int wid) {
    const int tid = hidden_tid(wid); float* sl = ldsf; float* red = ldsf + 9 * DM;
    { float cv[18];
#pragma unroll
      for (int i = 0; i < 18; ++i) { const int e = tid + 512 * i, ar = e >> 10, k = e & 1023; cv[i] = ar < NB ? P.c[ar * DM + k] : P.c_ctx[k]; }
#pragma unroll
      for (int i = 0; i < 18; ++i) sl[tid + 512 * i] = cv[i] * sigmoidf_(cv[i]); }
    __syncthreads();
    constexpr int CW = 48, NCH = 6144 / CW;
    for (int ch = bid_(); ch < 2 * NCH; ch += gridDim.x) { const int l = ch / NCH, c0 = (ch % NCH) * CW, cc = tid & 63, kg = tid >> 6; const bool act = cc < CW;
        const float* w = P.w_ada + (size_t)l * DM * 6144 + (size_t)(kg * 128) * 6144 + c0 + (act ? cc : 0); float acc[9];
#pragma unroll
        for (int r = 0; r < 9; ++r) acc[r] = 0.f;
#pragma unroll 1
        for (int k0 = 0; k0 < 128; k0 += 32) { float wv[32];
#pragma unroll
            for (int j = 0; j < 32; ++j) wv[j] = w[(size_t)(k0 + j) * 6144];
#pragma unroll
            for (int j4 = 0; j4 < 8; ++j4)
#pragma unroll
                for (int r = 0; r < 9; ++r) { const f32x4 s4 = *(const f32x4*)(sl + r * DM + kg * 128 + k0 + 4 * j4);
#pragma unroll
                    for (int q = 0; q < 4; ++q) acc[r] += s4[q] * wv[4 * j4 + q]; } }
        if (act) {
#pragma unroll
            for (int r = 0; r < 9; ++r) red[(kg * 9 + r) * 64 + cc] = acc[r]; }
        __syncthreads();
        for (int e = tid; e < 9 * CW; e += 512) { const int r = e / CW, c = e % CW; float s = 0.f;
#pragma unroll
            for (int g = 0; g < 8; ++g) s += red[(g * 9 + r) * 64 + c];
            WSP(float, OFF_ADA)[((size_t)l * 9 + r) * 6144 + c0 + c] = s + P.b_ada[l * 6144 + c0 + c]; }
        __syncthreads(); }
}
__device__ __forceinline__ void misc_prep(const Ptrs& P, int wid, int wg0 = 0) {
    if (bid_() < wg0) return;
    const size_t nthr = (size_t)((int)gridDim.x - wg0) * 512, gid = (size_t)(bid_() - wg0) * 512 + hidden_tid(wid);
    for (size_t idx = gid; idx < (size_t)SEQ * 16; idx += nthr) { const int n = idx / 16, i = idx % 16; const int r = n / 64, col = n % 64;
        const float inv = powf(10000.f, -(float)(i & 7) / 8.f); const float ang = (float)(i < 8 ? r : col) * inv;
        float* t = WSP(float, OFF_ROPE) + idx * 2; t[0] = (float)cos((double)ang); t[1] = (float)sin((double)ang); }
    for (size_t idx = gid; idx < (size_t)2 * NE * DM; idx += nthr) { const int k = idx & 1023, e = (idx >> 10) & 31, l = idx >> 15; const float w = P.w_router[(size_t)l * DM * NE + (size_t)k * NE + e];
        const bf16_t hi = f2bf(w); const bf16_t lo = f2bf(w - bf2f(hi)); bf16_t* wr = WSP(bf16_t, OFF_WR) + (size_t)l * 2 * NE * DM; wr[e * DM + k] = hi; wr[NE * DM + e * DM + k] = lo; }
}
__device__ __forceinline__ void ld16_f32(const float* p, int lane, float (&v)[16]) {
#pragma unroll
    for (int c = 0; c < 2; ++c) { const f32x4 a = *(const f32x4*)(p + c * 512 + lane * 8), b = *(const f32x4*)(p + c * 512 + lane * 8 + 4);
#pragma unroll
        for (int j = 0; j < 4; ++j) { v[c * 8 + j] = a[j]; v[c * 8 + 4 + j] = b[j]; } } }
__device__ __forceinline__ void ld16_bf16(const bf16_t* p, int lane, float (&v)[16]) {
#pragma unroll
    for (int c = 0; c < 2; ++c) { const u32x4 w = *(const u32x4*)(p + c * 512 + lane * 8);
#pragma unroll
        for (int t = 0; t < 4; ++t) { v[c * 8 + 2 * t] = bflo(w[t]); v[c * 8 + 2 * t + 1] = bfhi(w[t]); } } }
__device__ __forceinline__ void ld16_fp8(const u8* p, int lane, float (&v)[16]) {
#pragma unroll
    for (int c = 0; c < 2; ++c) { const u32x2 w = *(const u32x2*)(p + c * 512 + lane * 8);
#pragma unroll
        for (int t = 0; t < 2; ++t) { const auto lo = __builtin_amdgcn_cvt_pk_f32_fp8((int)w[t], false), hi = __builtin_amdgcn_cvt_pk_f32_fp8((int)w[t], true);
            v[c * 8 + 4 * t] = lo[0]; v[c * 8 + 4 * t + 1] = lo[1]; v[c * 8 + 4 * t + 2] = hi[0]; v[c * 8 + 4 * t + 3] = hi[1]; } } }
__device__ __forceinline__ void st16_f32(float* p, int lane, const float (&v)[16]) {
#pragma unroll
    for (int c = 0; c < 2; ++c) { *(f32x4*)(p + c * 512 + lane * 8) = (f32x4){v[c * 8], v[c * 8 + 1], v[c * 8 + 2], v[c * 8 + 3]}; *(f32x4*)(p + c * 512 + lane * 8 + 4) = (f32x4){v[c * 8 + 4], v[c * 8 + 5], v[c * 8 + 6], v[c * 8 + 7]}; } }
__device__ __forceinline__ void st16_fp8(u8* p, int lane, const float (&v)[16]) {
#pragma unroll
    for (int c = 0; c < 2; ++c) *(u32x2*)(p + c * 512 + lane * 8) = pk8_fp8(v + c * 8, 1.f); }
__device__ __forceinline__ void st16_bf16(bf16_t* p, int lane, const float (&v)[16]) {
#pragma unroll
    for (int c = 0; c < 2; ++c) *(u32x4*)(p + c * 512 + lane * 8) = pk8(v + c * 8); }
__device__ __forceinline__ void normmod0_phase(const Ptrs& P, int wid, int nwg) {
    constexpr int NR = 3;
    if (bid_() >= nwg) return;
    const int lane = hidden_tid(wid) & 63; const int stride = nwg * 8;
    float g[16]; ld16_f32(P.g_pre_mix, lane, g);
    for (int rowA = bid_() * 8 + wid; rowA < RT; rowA += NR * stride) {
        int rows[NR]; bool ok[NR];
#pragma unroll
        for (int q = 0; q < NR; ++q) { ok[q] = rowA + q * stride < RT; rows[q] = ok[q] ? rowA + q * stride : rowA; }
        float v[NR][16], sh[NR][16], sc[NR][16];
#pragma unroll
        for (int q = 0; q < NR; ++q) { const int row = rows[q]; const float* src = row < RX ? P.x + (size_t)row * DM : P.ctx + (size_t)(row - RX) * DM;
            const float* ada = WSP(float, OFF_ADA) + (size_t)row_arow(row) * 6144; ld16_f32(src, lane, v[q]); ld16_f32(ada, lane, sh[q]); ld16_f32(ada + 1024, lane, sc[q]); }
#pragma unroll
        for (int q = 0; q < NR; ++q) { float ss = 0.f;
#pragma unroll
            for (int i = 0; i < 16; ++i) ss += v[q][i] * v[q][i];
            ss = wave_sum(ss); const float r = rsqrtf(ss / DM + EPS);
#pragma unroll
            for (int i = 0; i < 16; ++i) v[q][i] = v[q][i] * r * g[i] * (1.f + sc[q][i]) + sh[q][i]; }
#pragma unroll
        for (int q = 0; q < NR; ++q) if (ok[q]) { st16_bf16(WSP(bf16_t, OFF_H) + (size_t)rows[q] * DM, lane, v[q]); st16_fp8(WSP(u8, OFF_H8) + (size_t)rows[q] * DM, lane, v[q]); } }
}
__device__ __forceinline__ void conv_phase(const Ptrs& P, int l, int nrows, int wid) {
    constexpr int NR = 3;
    const size_t nthr = (size_t)gridDim.x * 512, gid = (size_t)bid_() * 512 + hidden_tid(wid), total = (size_t)nrows * 64;
    const bf16_t* in = WSP(bf16_t, OFF_INNER); const bf16_t* cb = WSP(bf16_t, OFF_CB); bf16_t* out = WSP(bf16_t, OFF_CONV); const float* w = P.conv_w + (size_t)l * 3 * 512;
    const int j = (int)(gid & 63) * 8; float wv[3][8];
#pragma unroll
    for (int d = 0; d < 3; ++d) { const f32x4 w0 = *(const f32x4*)(w + d * 512 + j), w1 = *(const f32x4*)(w + d * 512 + j + 4);
#pragma unroll
        for (int t = 0; t < 4; ++t) { wv[d][t] = w0[t]; wv[d][4 + t] = w1[t]; } }
    for (size_t e0 = gid; e0 < total; e0 += NR * nthr) { u32x4 iv[NR][3], cv[NR]; float mk[NR][3]; int rows[NR]; bool ok[NR];
#pragma unroll
        for (int q = 0; q < NR; ++q) { const size_t e = e0 + q * nthr; ok[q] = e < total; const int row = ok[q] ? (int)(e >> 6) : (int)(gid >> 6); rows[q] = row;
            const bool isx = row < RX; const int len = isx ? SEQ : CTX; const int n = isx ? (row & (SEQ - 1)) : ((row - RX) & (CTX - 1));
#pragma unroll
            for (int d = 0; d < 3; ++d) { const int nn = n + d - 1; const bool val = nn >= 0 && nn < len; mk[q][d] = val ? 1.f : 0.f; iv[q][d] = *(const u32x4*)(in + (size_t)(val ? row + d - 1 : row) * 512 + j); }
            cv[q] = *(const u32x4*)(cb + (size_t)row * 512 + j); }
#pragma unroll
        for (int q = 0; q < NR; ++q) { float y[8];
#pragma unroll
            for (int t = 0; t < 8; ++t) y[t] = 0.f;
#pragma unroll
            for (int d = 0; d < 3; ++d)
#pragma unroll
                for (int t = 0; t < 4; ++t) { y[2 * t] += mk[q][d] * wv[d][2 * t] * bflo(iv[q][d][t]); y[2 * t + 1] += mk[q][d] * wv[d][2 * t + 1] * bfhi(iv[q][d][t]); }
            u32x4 o;
#pragma unroll
            for (int t = 0; t < 4; ++t) o[t] = cvt_pk_bf16(bflo(cv[q][t]) * y[2 * t], bfhi(cv[q][t]) * y[2 * t + 1]);
            if (ok[q]) *(u32x4*)(out + (size_t)rows[q] * 512 + j) = o; } }
}
template <int K> __device__ __forceinline__ int lane_xor_i(int v) { return __builtin_amdgcn_ds_swizzle(v, (K << 10) | 0x1f); }
__device__ __forceinline__ void post_mix_phase(const Ptrs& P, int l, int nrows, LAS unsigned char* lds, int wid) {
    constexpr int TS = 2064;
    const int tid = hidden_tid(wid), lane = tid & 63;
    LAS unsigned char* tHi = lds; LAS unsigned char* tLo = lds + 16 * TS; LAS float* red = (LAS float*)(lds + 32 * TS);
    LAS int* lcount = (LAS int*)(lds + 32 * TS + 16384); LAS int* gbase = lcount + 32; LAS int* pend = lcount + 64;
    if (tid < 64) lcount[tid] = 0;
    __syncthreads();
    int gi = 0;
    const bf16_t* wr = WSP(bf16_t, OFF_WR) + (size_t)l * 2 * NE * DM;
    bf16x8 bh[4][2], bl[4][2];
#pragma unroll
    for (int ks = 0; ks < 4; ++ks)
#pragma unroll
        for (int nt = 0; nt < 2; ++nt) { const size_t off = (size_t)(nt * 16 + (lane & 15)) * DM + wid * 128 + ks * 32 + 8 * (lane >> 4);
            bh[ks][nt] = *(const bf16x8*)(wr + off); bl[ks][nt] = *(const bf16x8*)(wr + (size_t)NE * DM + off); }
    const float* gpm = P.g_post_mix + l * DM; const float* gpf = P.g_pre_ffn + l * DM;
    const float brt = P.b_router[l * NE + (lane & 31)];
    int* cnt = WSP(int, OFF_CNT2) + l * 64; int* tl = WSP(int, OFF_TOKLIST); float* wl = WSP(float, OFF_WLIST);
    float gpmv[16], gpfv[16]; ld16_f32(gpm, lane, gpmv); ld16_f32(gpf, lane, gpfv);
    for (int g = bid_(); g < nrows / 16; g += gridDim.x, ++gi) {
        const int row0 = g * 16 + 2 * wid; const bool isx = row0 < RX;
        const float* ada = WSP(float, OFF_ADA) + ((size_t)l * 9 + row_arow(row0)) * 6144;
        float xv[2][16], yv[2][16], g1[16], sc2[16], sh2[16], ry[2];
        ld16_f32(ada + 2048, lane, g1); ld16_f32(ada + 4096, lane, sc2); ld16_f32(ada + 3072, lane, sh2);
#pragma unroll
        for (int rr = 0; rr < 2; ++rr) { const int row = row0 + rr;
            if (l == 0) ld16_f32(isx ? P.x + (size_t)row * DM : P.ctx + (size_t)(row - RX) * DM, lane, xv[rr]);
            else ld16_bf16(isx ? (const bf16_t*)P.out + (size_t)row * DM : WSP(bf16_t, OFF_CTXRES) + (size_t)(row - RX) * DM, lane, xv[rr]);
            ld16_bf16(WSP(bf16_t, OFF_YX) + (size_t)row * DM, lane, yv[rr]);
            const float* sp = WSP(float, OFF_SSPY) + (size_t)row * 16; const f32x4 s0 = *(const f32x4*)sp, s1 = *(const f32x4*)(sp + 4), s2 = *(const f32x4*)(sp + 8), s3 = *(const f32x4*)(sp + 12); float ssy = 0.f;
#pragma unroll
            for (int i = 0; i < 4; ++i) ssy += s0[i];
#pragma unroll
            for (int i = 0; i < 4; ++i) ssy += s1[i];
#pragma unroll
            for (int i = 0; i < 4; ++i) ssy += s2[i];
#pragma unroll
            for (int i = 0; i < 4; ++i) ssy += s3[i];
            ry[rr] = rsqrtf(ssy / DM + EPS); }
#pragma unroll
        for (int rr = 0; rr < 2; ++rr) { const int rl = 2 * wid + rr, row = row0 + rr; float ss = 0.f;
            bf16_t* dst = l == 1 ? WSP(bf16_t, OFF_X1B) + (size_t)row * DM : isx ? (bf16_t*)P.out + (size_t)row * DM : WSP(bf16_t, OFF_CTXRES) + (size_t)(row - RX) * DM;
#pragma unroll
            for (int i = 0; i < 16; ++i) { xv[rr][i] = xv[rr][i] + g1[i] * (yv[rr][i] * ry[rr] * gpmv[i]); ss += xv[rr][i] * xv[rr][i]; }
            st16_bf16(dst, lane, xv[rr]);
            ss = wave_sum(ss); const float r = rsqrtf(ss / DM + EPS);
            float hl[16];
#pragma unroll
            for (int i = 0; i < 16; ++i) { const float hv = xv[rr][i] * r * gpfv[i] * (1.f + sc2[i]) + sh2[i]; const float hh = bf2f(f2bf(hv)); yv[rr][i] = hh; hl[i] = hv - hh; }
            st16_fp8(WSP(u8, OFF_H) + (size_t)row * DM, lane, yv[rr]);
#pragma unroll
            for (int c = 0; c < 2; ++c) { *(LAS u32x4*)(tHi + rl * TS + (c * 512 + lane * 8) * 2) = pk8(yv[rr] + c * 8); *(LAS u32x4*)(tLo + rl * TS + (c * 512 + lane * 8) * 2) = pk8(hl + c * 8); } }
        __syncthreads();
        f32x4 acc[2] = {(f32x4){0.f, 0.f, 0.f, 0.f}, (f32x4){0.f, 0.f, 0.f, 0.f}};
#pragma unroll
        for (int ks = 0; ks < 4; ++ks) { const int ao = (lane & 15) * TS + (wid * 128 + ks * 32 + 8 * (lane >> 4)) * 2;
            const bf16x8 ah = *(const LAS bf16x8*)(tHi + ao), al = *(const LAS bf16x8*)(tLo + ao);
#pragma unroll
            for (int nt = 0; nt < 2; ++nt) { acc[nt] = __builtin_amdgcn_mfma_f32_16x16x32_bf16(ah, bh[ks][nt], acc[nt], 0, 0, 0);
                acc[nt] = __builtin_amdgcn_mfma_f32_16x16x32_bf16(ah, bl[ks][nt], acc[nt], 0, 0, 0); acc[nt] = __builtin_amdgcn_mfma_f32_16x16x32_bf16(al, bh[ks][nt], acc[nt], 0, 0, 0); } }
#pragma unroll
        for (int nt = 0; nt < 2; ++nt)
#pragma unroll
            for (int j = 0; j < 4; ++j) red[(wid * 16 + 4 * (lane >> 4) + j) * 32 + nt * 16 + (lane & 15)] = acc[nt][j];
        __syncthreads();
        {
            const int e = lane & 31, rl = 2 * wid + (lane >> 5), row = g * 16 + rl; float lg = 0.f;
#pragma unroll
            for (int w = 0; w < 8; ++w) lg += red[(w * 16 + rl) * 32 + e];
            const float sc = sigmoidf_(lg); float key = sc + brt; int sel[TOPK]; float selw[TOPK]; float ssum = 0.f;
#pragma unroll
            for (int j = 0; j < TOPK; ++j) { float bk = key, bs = sc; int bi = e;
#define PM_STEP(KX) { const float ok = lane_xor<KX>(bk), os = lane_xor<KX>(bs); const int oi = lane_xor_i<KX>(bi); const bool take = (ok > bk) || (ok == bk && oi < bi); bk = take ? ok : bk; bs = take ? os : bs; bi = take ? oi : bi; }
                PM_STEP(1) PM_STEP(2) PM_STEP(4) PM_STEP(8) PM_STEP(16)
#undef PM_STEP
                sel[j] = bi; selw[j] = bs; ssum += bs; key = (e == bi) ? -1e30f : key; }
#pragma unroll
            for (int j = 0; j < TOPK; ++j) if (e == sel[j]) { const int lr = __hip_atomic_fetch_add(lcount + e, 1, __ATOMIC_RELAXED, __HIP_MEMORY_SCOPE_WORKGROUP); LAS int* pe = pend + ((gi * 16 + rl) * TOPK + j) * 4;
                pe[0] = e; pe[1] = lr; pe[2] = __float_as_int(selw[j] / ssum * 2.5f); pe[3] = row; } }
        __syncthreads(); }
    if (tid < NE) gbase[tid] = atomicAdd(cnt + tid, lcount[tid]);
    __syncthreads();
    { int* ti = WSP(int, OFF_TOKINFO);
      for (int p = tid; p < gi * 16 * TOPK; p += 512) { const LAS int* pe = pend + p * 4; const int e = pe[0], rank = gbase[e] + pe[1], row = pe[3]; const int j = p & (TOPK - 1);
          tl[(size_t)e * RT + rank] = row; wl[(size_t)e * RT + rank] = __int_as_float(pe[2]); ti[(size_t)row * 8 + 2 * j] = e; ti[(size_t)row * 8 + 2 * j + 1] = rank; } }
    __syncthreads();
}
__device__ __forceinline__ void moe_setup(const Ptrs& P, int l, LAS int* lbase, LAS int* lcnt, int wid) {
    __syncthreads();
    if (wid == 0) {
        const int lane = hidden_lane(); const int* cnt = WSP(int, OFF_CNT2) + l * 64; const int c = lane < NE ? cnt[lane] : 0; const int pad = (c + 255) / 256 * 256; int v = pad;
        v += __builtin_amdgcn_update_dpp(0, v, 0x111, 0xf, 0xf, false); v += __builtin_amdgcn_update_dpp(0, v, 0x112, 0xf, 0xf, false);
        v += __builtin_amdgcn_update_dpp(0, v, 0x114, 0xf, 0xf, false); v += __builtin_amdgcn_update_dpp(0, v, 0x118, 0xf, 0xf, false);
        { const int r0 = __builtin_amdgcn_readlane(v, 15); if (lane >= 16) v += r0; }
        if (lane < NE) { lcnt[lane] = c; lbase[lane] = v - pad; }
        if (lane == NE - 1) lbase[NE] = v; }
    __syncthreads();
}
__device__ __forceinline__ void acc8_fp8(u32x2 w, float* v) {
#pragma unroll
    for (int t = 0; t < 2; ++t) { const auto lo = __builtin_amdgcn_cvt_pk_f32_fp8((int)w[t], false), hi = __builtin_amdgcn_cvt_pk_f32_fp8((int)w[t], true);
        v[4 * t] += lo[0]; v[4 * t + 1] += lo[1]; v[4 * t + 2] += hi[0]; v[4 * t + 3] += hi[1]; } }
template <int NR> __device__ __forceinline__ void post_moe_rows(const Ptrs& P, int l, int nrows, const LAS int* lbase, int wid) {
    const int lane = hidden_tid(wid) & 63; const int stride = (int)gridDim.x * 8;
    float gp[16]; ld16_f32(P.g_post_ffn + l * DM, lane, gp);
    for (int rowA = bid_() * 8 + wid; rowA < nrows; rowA += NR * stride) {
        int rows[NR]; bool ok[NR];
#pragma unroll
        for (int q = 0; q < NR; ++q) { ok[q] = rowA + q * stride < nrows; rows[q] = ok[q] ? rowA + q * stride : rowA; }
        u32x2 yr[NR][5][2]; float xv[NR][16], g2[NR][16]; bf16_t* xr[NR]; const float* ada[NR];
#pragma unroll
        for (int q = 0; q < NR; ++q) { const int row = rows[q]; const bool isx = row < RX; xr[q] = l == 1 ? WSP(bf16_t, OFF_X1B) + (size_t)row * DM : isx ? (bf16_t*)P.out + (size_t)row * DM : WSP(bf16_t, OFF_CTXRES) + (size_t)(row - RX) * DM;
            ada[q] = WSP(float, OFF_ADA) + ((size_t)l * 9 + row_arow(row)) * 6144;
            const int* ti = WSP(int, OFF_TOKINFO) + (size_t)row * 8; const u8* Y = WSP(u8, OFF_Y);
            const u32x4 ta = *(const u32x4*)ti, tb = *(const u32x4*)(ti + 4);
            const int sl[4] = {lbase[ta[0]] + (int)ta[1], lbase[ta[2]] + (int)ta[3], lbase[tb[0]] + (int)tb[1], lbase[tb[2]] + (int)tb[3]};
            const u8* ys = WSP(u8, OFF_YS) + (size_t)row * DM;
#pragma unroll
            for (int c = 0; c < 2; ++c) { yr[q][0][c] = *(const u32x2*)(ys + c * 512 + lane * 8);
#pragma unroll
                for (int j = 0; j < 4; ++j) yr[q][1 + j][c] = *(const u32x2*)(Y + (size_t)sl[j] * DM + c * 512 + lane * 8); }
            ld16_bf16(xr[q], lane, xv[q]);
            ld16_f32(ada[q] + 5120, lane, g2[q]); }
        float v[NR][16], r[NR], ss2[NR];
#pragma unroll
        for (int q = 0; q < NR; ++q) { float ss = 0.f;
#pragma unroll
            for (int i = 0; i < 16; ++i) v[q][i] = 0.f;
#pragma unroll
            for (int j = 0; j < 5; ++j)
#pragma unroll
                for (int c = 0; c < 2; ++c) acc8_fp8(yr[q][j][c], v[q] + c * 8);
#pragma unroll
            for (int i = 0; i < 16; ++i) { v[q][i] *= (1.f / YSC); ss += v[q][i] * v[q][i]; }
            ss = wave_sum(ss); r[q] = rsqrtf(ss / DM + EPS); ss2[q] = 0.f;
#pragma unroll
            for (int i = 0; i < 16; ++i) { v[q][i] = xv[q][i] + g2[q][i] * (v[q][i] * r[q] * gp[i]); ss2[q] += v[q][i] * v[q][i]; } }
#pragma unroll
        for (int q = 0; q < NR; ++q) if (ok[q]) { if (l == 1) st16_f32(P.out + (size_t)rows[q] * DM, lane, v[q]); else st16_bf16(xr[q], lane, v[q]);
            if (l == 0) { const float s2 = wave_sum(ss2[q]); const float r2 = rsqrtf(s2 / DM + EPS); const float* ada1 = ada[q] + 9 * 6144; float t0[16], t1[16], t2[16];
                ld16_f32(P.g_pre_mix + DM, lane, t0); ld16_f32(ada1 + 1024, lane, t1); ld16_f32(ada1, lane, t2);
#pragma unroll
                for (int i = 0; i < 16; ++i) v[q][i] = v[q][i] * r2 * t0[i] * (1.f + t1[i]) + t2[i];
                st16_bf16(WSP(bf16_t, OFF_H) + (size_t)rows[q] * DM, lane, v[q]); st16_fp8(WSP(u8, OFF_H8) + (size_t)rows[q] * DM, lane, v[q]); } }
    }
}
__device__ __forceinline__ void post_moe_phase(const Ptrs& P, int l, int nrows, const LAS int* lbase, int wid) {
    if (l == 0) post_moe_rows<3>(P, l, nrows, lbase, wid); else post_moe_rows<4>(P, l, nrows, lbase, wid);
}

#define XB_TMO      128
#define XB_XCNT(j)  (256  + 64 * (j))
#define XB_XSUB(j)  (1280 + 64 * (j))
#define XB_XGEN(j)  (2304 + 64 * (j))
#define XB_TOP      3328
#define XB_TOPGEN   3392
#define XCD_BAR_WORDS 3456
#define XB_SPIN_CAP (1u << 18)
#define LAS __attribute__((address_space(3)))

__device__ __forceinline__ unsigned xb_ld(unsigned* p)              { return __hip_atomic_load(p, __ATOMIC_RELAXED, __HIP_MEMORY_SCOPE_AGENT); }
__device__ __forceinline__ unsigned xb_add(unsigned* p, unsigned v) { return __hip_atomic_fetch_add(p, v, __ATOMIC_RELAXED, __HIP_MEMORY_SCOPE_AGENT); }
__device__ __forceinline__ unsigned xb_xcc_id() { return (unsigned)__builtin_amdgcn_s_getreg((3 << 11) | 20) & 0xFu; }
#define XB_SPIN(cond, bar) do { unsigned _sp = 0; while (cond) { __builtin_amdgcn_s_sleep(1); \
    if ((++_sp & 255u) == 0u) { if (xb_ld(&(bar)[XB_TMO])) break; if (_sp > XB_SPIN_CAP) { atomicAdd(&(bar)[XB_TMO], 1u); break; } } } } while (0)

struct XcdBarrier {
    int wid;
    unsigned* bar; unsigned x;
    volatile LAS unsigned* st;
};

__device__ __forceinline__ XcdBarrier xcd_barrier_post(unsigned* bar, volatile LAS unsigned* st) {
    XcdBarrier b; b.wid = uni((int)threadIdx.x >> 6); b.bar = bar; b.x = xb_xcc_id(); b.st = st;
    if (b.wid == 0 && hidden_lane() == 0) (void)xb_add(&bar[XB_XCNT(b.x)], 1u);
    return b;
}
__device__ __forceinline__ void xcd_barrier_complete(unsigned* bar, unsigned x, unsigned& nloc, unsigned& nx) {
    const unsigned G = gridDim.x * gridDim.y * gridDim.z;
    unsigned sum, cnt, mine, sp = 0u;
    for (;;) {
        sum = 0u; cnt = 0u; mine = 0u;
#pragma unroll
        for (unsigned j = 0; j < 16; ++j) { const unsigned c = xb_ld(&bar[XB_XCNT(j)]); sum += c; cnt += (c > 0u) ? 1u : 0u; mine = (j == x) ? c : mine; }
        if (sum == G) break;
        __builtin_amdgcn_s_sleep(1);
        if ((++sp & 255u) == 0u) { if (xb_ld(&bar[XB_TMO])) break; if (sp > XB_SPIN_CAP) { atomicAdd(&bar[XB_TMO], 1u); break; } }
    }
    nloc = mine > 0u ? mine : 1u; nx = cnt > 0u ? cnt : 1u;
}

__device__ __forceinline__ void xcd_barrier(const XcdBarrier& b) {
    asm volatile("s_waitcnt vmcnt(0)" ::: "memory");
    __syncthreads();
    if (b.wid == 0 && hidden_lane() == 0) {
        unsigned* bar = b.bar;
        __builtin_amdgcn_s_waitcnt(0);
        unsigned nloc = b.st[0], nx = b.st[1];
        if (nloc == 0u) { xcd_barrier_complete(bar, b.x, nloc, nx); b.st[0] = nloc; b.st[1] = nx; }
        const unsigned old = xb_add(&bar[XB_XSUB(b.x)], 1u);
        const unsigned gen = old / nloc;
        if (old + 1u == (gen + 1u) * nloc) {
            __builtin_amdgcn_fence(__ATOMIC_RELEASE, "agent");
            asm volatile("s_waitcnt vmcnt(0)" ::: "memory");
            const unsigned og = xb_add(&bar[XB_TOP], 1u);
            const unsigned tg = og / nx;
            if (og + 1u == (tg + 1u) * nx) xb_add(&bar[XB_TOPGEN], 1u);
            else XB_SPIN(xb_ld(&bar[XB_TOPGEN]) == tg, bar);
            __builtin_amdgcn_fence(__ATOMIC_ACQUIRE, "agent");
            xb_add(&bar[XB_XGEN(b.x)], 1u);
            asm volatile("s_waitcnt vmcnt(0)" ::: "memory");
        } else {
            XB_SPIN(xb_ld(&bar[XB_XGEN(b.x)]) == gen, bar);
            __builtin_amdgcn_fence(__ATOMIC_ACQUIRE, "agent");
            asm volatile("s_waitcnt vmcnt(0)" ::: "memory");
        }
    }
    __syncthreads();
}

constexpr int N_PHASES = 20;
constexpr int MISC_OFF = fg::STAGE_BYTES;
constexpr int MK_LDS = fg::STAGE_BYTES + 1024 + 16384;
__global__ void __launch_bounds__(512, 2) mk_fwd(Args a) {
    extern __shared__ __attribute__((aligned(16))) unsigned char lds_raw[];
    LAS unsigned char* lds = (LAS unsigned char*)lds_raw;
    const Ptrs& P = a.P; const int lo = a.ph_lo, hi = a.ph_hi;
    const int wid_s = __builtin_amdgcn_readfirstlane((int)threadIdx.x >> 6);
    { const int t0 = hidden_tid(wid_s); if (t0 < 4) ((LAS unsigned*)(lds + MISC_OFF))[t0] = 0u; }
    __syncthreads();
    XcdBarrier bar; bar.wid = wid_s; bar.bar = WSP(unsigned, OFF_CTL); bar.x = 0; bar.st = nullptr;
    if (hi - lo > 1) bar = xcd_barrier_post(WSP(unsigned, OFF_CTL), (volatile LAS unsigned*)(lds + MISC_OFF));
#define IN(k) (lo <= (k) && (k) < hi)
#define SEAM(k) do { if (IN(k) && IN((k) + 1)) { XcdBarrier _b = bar; asm volatile("" : "+s"(_b.bar), "+s"(_b.x)); xcd_barrier(_b); } } while (0)
#define PHASE_P(Q) Ptrs Q = P; { char* _w = Q.ws; asm volatile("" : "+s"(_w)); Q.ws = _w; } LAS unsigned char* ldq = lds; asm volatile("" : "+s"(ldq)); int wq = wid_s; asm volatile("" : "+s"(wq)); \
    char* const ldg = (char*)ldq; LAS int* const lbase = (LAS int*)(ldq + MISC_OFF + 64); LAS int* const lcnt = (LAS int*)(ldq + MISC_OFF + 256); (void)ldg; (void)lbase; (void)lcnt
    constexpr int NSPLIT = 160;
    if (IN(0)) { PHASE_P(Q); (void)lbase; (void)lcnt; ada_phase(Q, (float*)ldg, wq); }
    SEAM(0);
    if (IN(1)) { PHASE_P(Q); (void)lbase; (void)lcnt; normmod0_phase(Q, wq, NSPLIT);
        int tbase = 0; prep_mix(Q, 0, (float*)ldg, tbase, wq, NSPLIT); prep_wz(Q, 0, (float*)ldg, tbase, wq, NSPLIT); prep_dft(Q, wq, NSPLIT); misc_prep(Q, wq, NSPLIT); }
    SEAM(1);
    for (int l = 0; l < 2; ++l) {
        const int pb = 2 + 9 * l; const int nMl = (l == 0 ? RT : RX) / 256, Rl = l == 0 ? RT : RX;
        if (IN(pb + 0)) { PHASE_P(Q); char* wm = Q.ws + OFF_WMIX + (size_t)l * WMIX_BYTES; EpiProj E{Q, l};
            { SchedW1 S{Q.ws + OFF_H, wm + WMIX_W1, l}; fg::gemm_phase<SchedW1, EpiProj, 0>(ldq, DM, S, E, wq); }
            { SchedGate S{Q.ws + OFF_H8, Q.ws + OFF_W1G8 + (size_t)l * 3072 * 1024, l}; EpiGate EG{Q, l}; fg::gemm_phase<SchedGate, EpiGate, 0, 0, true>(ldq, DM, S, EG, wq); }
            { SchedZx S{Q.ws + OFF_H8, wm + WMIX_WZ}; EpiZ EZ{Q}; fg::gemm_phase<SchedZx, EpiZ, 0, 1, true>(ldq, DM, S, EZ, wq); }
            if (l == 0) { SchedZc S{Q.ws + OFF_H8, wm + WMIX_WZ}; EpiZ EZ{Q}; fg::gemm_phase<SchedZc, EpiZ, 0, 0, true>(ldq, DM, S, EZ, wq); } }
        SEAM(pb + 0);
        if (IN(pb + 1)) { PHASE_P(Q); char* wm = Q.ws + OFF_WMIX + (size_t)l * WMIX_BYTES;
            { SchedPlainShift S{Q.ws + OFF_CKV, wm + WMIX_WUKV, RT / 256, 4, KV_RANK, 0}; EpiUKV E{Q}; fg::gemm_phase<SchedPlainShift, EpiUKV, 0>(ldq, KV_RANK, S, E, wq); }
            { SchedPlainShift S{Q.ws + OFF_CQ, wm + WMIX_WUQ, nMl, 3, Q_RANK, 32}; EpiUQ E{Q}; fg::gemm_phase<SchedPlainShift, EpiUQ, 0>(ldq, Q_RANK, S, E, wq); }
            { SchedFftA S{Q.ws + OFF_ZA, Q.ws + OFF_MA}; EpiFftA E{Q}; fg::gemm_phase<SchedFftA, EpiFftA, 0, 2>(ldq, 128, S, E, wq); }
            conv_phase(Q, l, Rl, wq); }
        SEAM(pb + 1);
        if (IN(pb + 2)) { PHASE_P(Q);
            { SchedFftB S{Q.ws + OFF_ZB, Q.ws + OFF_MB}; EpiFftB E{(bf16_t*)(Q.ws + OFF_FOUR)}; fg::gemm_phase<SchedFftB, EpiFftB, 0>(ldq, 128, S, E, wq); }
            if (l == 0) { SchedF2c S{Q.ws + OFF_TC, Q.ws + OFF_ZTC}; EpiBf16 E{(bf16_t*)(Q.ws + OFF_FOUR), FW}; fg::gemm_phase<SchedF2c, EpiBf16, 0>(ldq, 2 * CTX, S, E, wq); }
            attn_phase(Q, l, ldg, wq); }
        SEAM(pb + 2);
        if (IN(pb + 3)) { PHASE_P(Q); char* wm = Q.ws + OFF_WMIX + (size_t)l * WMIX_BYTES;
            SchedMerge S{Q.ws + OFF_ATT, Q.ws + OFF_CONV, Q.ws + OFF_FOUR, wm + WMIX_WA, nMl}; EpiMerge E{(bf16_t*)(Q.ws + OFF_MERGED), (const u8*)(Q.ws + OFF_GATES)};
            fg::gemm_phase<SchedMerge, EpiMerge, 0, 0, false, true>(ldq, 1536, S, E, wq);
            if (l == 0) { int tbase = 0; prep_mix(Q, 1, (float*)ldg, tbase, wq, 32); prep_wz(Q, 1, (float*)ldg, tbase, wq, 32); __syncthreads(); prep_moe(Q, 1, ldq, wq, 32); } }
        SEAM(pb + 3);
        if (IN(pb + 4)) { PHASE_P(Q); char* wm = Q.ws + OFF_WMIX + (size_t)l * WMIX_BYTES;
            SchedPlain S{Q.ws + OFF_MERGED, wm + WMIX_WO, nMl, 4, DM}; EpiYX E{(bf16_t*)(Q.ws + OFF_YX), (float*)(Q.ws + OFF_SSPY)}; fg::gemm_phase<SchedPlain, EpiYX, 0>(ldq, DM, S, E, wq);
            if (l == 0) prep_moe(Q, 0, ldq, wq, 32); }
        SEAM(pb + 4);
        if (IN(pb + 5)) { PHASE_P(Q); post_mix_phase(Q, l, Rl, ldq, wq); }
        SEAM(pb + 5);
        if (IN(pb + 6)) { PHASE_P(Q); moe_setup(Q, l, lbase, lcnt, wq);
            SchedMoe1 S{Q.ws + OFF_H, moe_wgu(Q, l, 0), moe_wgu(Q, l, NE), lbase, lcnt, (const int*)(Q.ws + OFF_TOKLIST), (const int*)(Q.ws + OFF_IDL), nMl}; EpiAct E{(bf16_t*)(Q.ws + OFF_ACT), (const float*)(Q.ws + OFF_WLIST)};
            fg::gemm_phase<SchedMoe1, EpiAct, 1, 0, true>(ldq, DM, S, E, wq); }
        SEAM(pb + 6);
        if (IN(pb + 7)) { PHASE_P(Q); moe_setup(Q, l, lbase, lcnt, wq);
            SchedMoe2 S{Q.ws + OFF_ACT, moe_wd(Q, l, 0), moe_wd(Q, l, NE), lbase, lcnt, nMl}; EpiY E{(u8*)(Q.ws + OFF_Y), (u8*)(Q.ws + OFF_YS)}; fg::gemm_phase<SchedMoe2, EpiY, 0>(ldq, FE, S, E, wq); }
        SEAM(pb + 7);
        if (IN(pb + 8)) { PHASE_P(Q); moe_setup(Q, l, lbase, lcnt, wq); post_moe_phase(Q, l, Rl, lbase, wq); }
        if (l == 0) SEAM(pb + 8);
    }
#undef PHASE_P
#undef IN
#undef SEAM
}

#ifndef MK_N_LAUNCHES
#define MK_N_LAUNCHES 1
#endif
extern "C" void kernel_launch(void* const* d_in, const int* in_sizes, int n_in, void* d_out, int out_size, void* d_ws, size_t ws_size, hipStream_t stream) {
    static int ready = 0;
    if (ready == 0) {
        if (n_in != 29 || out_size != RX * DM || ws_size < OFF_END_MIX) { fprintf(stderr, "kernel_launch: unexpected shapes (n_in %d out %d ws %zu need %zu)\n", n_in, out_size, ws_size, (size_t)OFF_END_MIX); ready = -1; return; }
        if (hipFuncSetAttribute((const void*)mk_fwd, hipFuncAttributeMaxDynamicSharedMemorySize, MK_LDS) != hipSuccess) { fprintf(stderr, "kernel_launch: hipFuncSetAttribute failed\n"); ready = -1; return; }
        int dev = 0, cus = 0, per_cu = 0;
        if (hipGetDevice(&dev) != hipSuccess || hipDeviceGetAttribute(&cus, hipDeviceAttributeMultiprocessorCount, dev) != hipSuccess) { ready = -1; return; }
        if (hipOccupancyMaxActiveBlocksPerMultiprocessor(&per_cu, (const void*)mk_fwd, 512, MK_LDS) != hipSuccess || per_cu < 1) { fprintf(stderr, "kernel_launch: occupancy query says %d blocks per CU\n", per_cu); }
        (void)hipGetLastError();
        if (cus != 256) fprintf(stderr, "kernel_launch: %d CUs (built for 256)\n", cus);
        ready = 1;
    }
    if (ready < 0) return;
    Ptrs P{};
    const float** pp = (const float**)&P; for (int i = 0; i < 29; ++i) pp[i] = (const float*)d_in[i];
    P.out = (float*)d_out; P.ws = (char*)d_ws;
    if (hipMemsetAsync((char*)d_ws + OFF_CTL, 0, CTL_BYTES, stream) != hipSuccess) { fprintf(stderr, "kernel_launch: memset failed\n"); return; }
    Args a{}; a.P = P;
    if (MK_N_LAUNCHES == 1) { a.ph_lo = 0; a.ph_hi = N_PHASES; hipLaunchKernelGGL(mk_fwd, dim3(256), dim3(512), MK_LDS, stream, a); }
    else for (int p = 0; p < N_PHASES; ++p) { a.ph_lo = p; a.ph_hi = p + 1; hipLaunchKernelGGL(mk_fwd, dim3(256), dim3(512), MK_LDS, stream, a); }
    const hipError_t le = hipPeekAtLastError(); if (le != hipSuccess) fprintf(stderr, "kernel_launch: launch failed: %s\n", hipGetErrorName(le));
}
```
